# Optimizing an MI355X kernel written in HIP

```python
import math
import jax, jax.numpy as jnp
from jax import lax
import numpy as np

D_MODEL = 2048
BATCH = 8
SEQ = 2048
DEPTH = 1

GRID_W = 64
CTX_LEN = 256

ATT_HEADS = 8
ATT_DIM = 64
ATT_WIDTH = ATT_HEADS * 2 * ATT_DIM
SSM_GROUP = 16
SSM_GROUPS = 32
SSM_WIDTH = SSM_GROUP * SSM_GROUPS
SSM_STATE = 64

Q_BLOCK = 128
ROPE_BASE = 10000.0
NORM_EPS = 1e-6

SPLITS = [ATT_WIDTH, 2 * ATT_WIDTH, 3 * ATT_WIDTH, 4 * ATT_WIDTH,
          4 * ATT_WIDTH + SSM_WIDTH, 4 * ATT_WIDTH + 2 * SSM_WIDTH]
IN_WIDTH = 4 * ATT_WIDTH + 2 * SSM_WIDTH + 2 * D_MODEL

kernel_name = "hybrid_diffattn_s5_prefix_dit"


def rmsnorm(x, g):
    xf = x.astype(jnp.float32)
    y = xf * lax.rsqrt(jnp.mean(xf * xf, axis=-1, keepdims=True) + NORM_EPS)
    return (y * g.astype(jnp.float32)).astype(x.dtype)


def rope_axis(xp, pos):
    nf = xp.shape[-1] // 2
    inv = ROPE_BASE ** (-jnp.arange(nf, dtype=jnp.float32) / nf)
    ang = pos[:, None] * inv[None, :]
    cos = jnp.cos(ang)[None, :, None, None, :].astype(xp.dtype)
    sin = jnp.sin(ang)[None, :, None, None, :].astype(xp.dtype)
    x1, x2 = xp[..., :nf], xp[..., nf:]
    return jnp.concatenate([x1 * cos - x2 * sin, x2 * cos + x1 * sin], axis=-1)


def rope2d(x, row, col):
    half = x.shape[-1] // 2
    return jnp.concatenate([rope_axis(x[..., :half], row), rope_axis(x[..., half:], col)], axis=-1)


def diff_attend(qb, k, v, lam):
    s = jnp.einsum('bqhsd,bkhsd->bhsqk', qb, k).astype(jnp.float32) * (ATT_DIM ** -0.5)
    p = jax.nn.softmax(s, axis=-1)
    a = p[:, :, 0] - lam * p[:, :, 1]
    return jnp.einsum('bhqk,bkhe->bqhe', a.astype(v.dtype), v)


def attn_post(o, subln_g, lam_init, gate):
    B, L = o.shape[0], o.shape[1]
    o = rmsnorm(o, subln_g) * (1.0 - lam_init)
    return o.reshape(B, L, ATT_WIDTH) * jax.nn.silu(gate)


def discretize(lre, lim, log_step, b_re, b_im):
    lre = lre.astype(jnp.float32); lim = lim.astype(jnp.float32)
    dt = jnp.exp(log_step.astype(jnp.float32))[:, None]
    mag = jnp.exp(lre * dt)
    ar, ai = mag * jnp.cos(lim * dt), mag * jnp.sin(lim * dt)
    den = lre * lre + lim * lim
    fr = ((ar - 1.0) * lre + ai * lim) / den
    fi = (ai * lre - (ar - 1.0) * lim) / den
    br, bi = b_re.astype(jnp.float32), b_im.astype(jnp.float32)
    bbr = fr[..., None] * br - fi[..., None] * bi
    bbi = fr[..., None] * bi + fi[..., None] * br
    return ar, ai, bbr, bbi


def _lin_combine(e1, e2):
    a1r, a1i, b1r, b1i = e1
    a2r, a2i, b2r, b2i = e2
    return (a1r * a2r - a1i * a2i,
            a1r * a2i + a1i * a2r,
            a2r * b1r - a2i * b1i + b2r,
            a2r * b1i + a2i * b1r + b2i)


def ssm_scan(u, disc, h0, reverse):
    ar, ai, bbr, bbi = disc
    bu_r = jnp.einsum('blgc,gpc->blgp', u, bbr)
    bu_i = jnp.einsum('blgc,gpc->blgp', u, bbi)
    if reverse:
        bu_r, bu_i = jnp.flip(bu_r, axis=1), jnp.flip(bu_i, axis=1)
    if h0 is not None:
        h0r, h0i = h0
        bu_r = bu_r.at[:, 0].add(ar * h0r - ai * h0i)
        bu_i = bu_i.at[:, 0].add(ar * h0i + ai * h0r)
    L = u.shape[1]
    a_r = jnp.broadcast_to(ar, (1, L) + ar.shape)
    a_i = jnp.broadcast_to(ai, (1, L) + ai.shape)
    _, _, hr, hi = lax.associative_scan(_lin_combine, (a_r, a_i, bu_r, bu_i), axis=1)
    if reverse:
        hr, hi = jnp.flip(hr, axis=1), jnp.flip(hi, axis=1)
    return hr, hi


def ssm_readout(u, st_f, st_b, c_re, c_im, d, w_glu, b_glu, gate, out_dtype):
    B, L = u.shape[0], u.shape[1]
    cr, ci = c_re.astype(jnp.float32), c_im.astype(jnp.float32)
    y = d.astype(jnp.float32) * u
    for di, (hr, hi) in enumerate((st_f, st_b)):
        y = y + jnp.einsum('gcp,blgp->blgc', cr[di], hr) - jnp.einsum('gcp,blgp->blgc', ci[di], hi)
    y = jax.nn.gelu(y.reshape(B, L, SSM_WIDTH).astype(out_dtype))
    y = y * jax.nn.sigmoid(y @ w_glu + b_glu)
    return y * jax.nn.silu(gate)


def merge_out(a_br, s_br, gm, w_pa, w_ps, w_out):
    g_a, g_s = jnp.split(jax.nn.sigmoid(gm), 2, axis=-1)
    return (g_a * (a_br @ w_pa) + g_s * (s_br @ w_ps)) @ w_out


def _layer(x, xc, c, c_ctx, p, lam_init, update_ctx):
    B, L, _ = x.shape
    Lc = xc.shape[1]
    shift, scale, gate = jnp.split(jax.nn.silu(c) @ p['w_ada'] + p['b_ada'], 3, axis=-1)
    shift_c, scale_c, gate_c = jnp.split(jax.nn.silu(c_ctx) @ p['w_ada'] + p['b_ada'], 3, axis=-1)
    h = rmsnorm(x, p['norm_g']) * (1.0 + scale[:, None]) + shift[:, None]
    hc = rmsnorm(xc, p['norm_g']) * (1.0 + scale_c) + shift_c

    q, k, v, ga, u, gs, gm = jnp.split(h @ p['w_in'], SPLITS, axis=-1)
    qc, kc, vc, gac, uc, gsc, gmc = jnp.split(hc @ p['w_in'], SPLITS, axis=-1)

    rows = L // GRID_W
    row = jnp.repeat(jnp.arange(rows), GRID_W).astype(jnp.float32)
    col = jnp.tile(jnp.arange(GRID_W), rows).astype(jnp.float32)
    q = rope2d(q.reshape(B, L, ATT_HEADS, 2, ATT_DIM), row, col)
    k = rope2d(k.reshape(B, L, ATT_HEADS, 2, ATT_DIM), row, col)
    v = v.reshape(B, L, ATT_HEADS, 2 * ATT_DIM)
    kc = kc.reshape(B, Lc, ATT_HEADS, 2, ATT_DIM)
    vc = vc.reshape(B, Lc, ATT_HEADS, 2 * ATT_DIM)
    lam = (jnp.exp(jnp.sum(p['lambda_q1'].astype(jnp.float32) * p['lambda_k1'].astype(jnp.float32)))
           - jnp.exp(jnp.sum(p['lambda_q2'].astype(jnp.float32) * p['lambda_k2'].astype(jnp.float32)))
           + lam_init)
    k_all = jnp.concatenate([k, kc], axis=1)
    v_all = jnp.concatenate([v, vc], axis=1)
    nblk = L // Q_BLOCK
    q_blocks = jnp.moveaxis(q.reshape(B, nblk, Q_BLOCK, ATT_HEADS, 2, ATT_DIM), 1, 0)
    o = lax.map(lambda qb: diff_attend(qb, k_all, v_all, lam), q_blocks)
    o = jnp.moveaxis(o, 0, 1).reshape(B, L, ATT_HEADS, 2 * ATT_DIM)
    a_br = attn_post(o, p['subln_g'], lam_init, ga)

    u = u.reshape(B, L, SSM_GROUPS, SSM_GROUP).astype(jnp.float32)
    uc = uc.reshape(B, Lc, SSM_GROUPS, SSM_GROUP).astype(jnp.float32)
    disc_f = discretize(p['ssm_lambda_re'][0], p['ssm_lambda_im'][0], p['ssm_log_step'][0],
                        p['ssm_b_re'][0], p['ssm_b_im'][0])
    disc_b = discretize(p['ssm_lambda_re'][1], p['ssm_lambda_im'][1], p['ssm_log_step'][1],
                        p['ssm_b_re'][1], p['ssm_b_im'][1])
    hcf = ssm_scan(uc, disc_f, None, reverse=False)
    hcb = ssm_scan(uc, disc_b, None, reverse=True)
    hf = ssm_scan(u, disc_f, (hcf[0][:, -1], hcf[1][:, -1]), reverse=False)
    hb = ssm_scan(u, disc_b, (hcb[0][:, 0], hcb[1][:, 0]), reverse=True)
    s_br = ssm_readout(u, hf, hb, p['ssm_c_re'], p['ssm_c_im'], p['ssm_d'],
                       p['w_glu'], p['b_glu'], gs, x.dtype)

    out = merge_out(a_br, s_br, gm, p['w_pa'], p['w_ps'], p['w_out'])
    x_new = x + gate[:, None] * out

    if update_ctx:
        qc = qc.reshape(B, Lc, ATT_HEADS, 2, ATT_DIM)
        a_c = attn_post(diff_attend(qc, kc, vc, lam), p['subln_g'], lam_init, gac)
        s_c = ssm_readout(uc, hcf, hcb, p['ssm_c_re'], p['ssm_c_im'], p['ssm_d'],
                          p['w_glu'], p['b_glu'], gsc, xc.dtype)
        xc = xc + gate_c * merge_out(a_c, s_c, gmc, p['w_pa'], p['w_ps'], p['w_out'])
    return x_new, xc


def setup_inputs(seed: int = 0) -> dict:
    key = jax.random.key(seed)
    ks = jax.random.split(key, 26)
    f32 = jnp.float32

    def nrm(k, shape, s):
        return jax.random.normal(k, shape, f32) * s

    G, P = SSM_GROUPS, SSM_STATE
    return {
        "x": nrm(ks[0], (BATCH, SEQ, D_MODEL), 1.0),
        "c": nrm(ks[1], (BATCH, D_MODEL), 1.0),
        "ctx": nrm(ks[2], (BATCH, CTX_LEN, D_MODEL), 1.0),
        "c_ctx": nrm(ks[3], (D_MODEL,), 1.0),
        "w_ada": nrm(ks[4], (DEPTH, D_MODEL, 3 * D_MODEL), 0.5 * D_MODEL ** -0.5),
        "b_ada": nrm(ks[5], (DEPTH, 3 * D_MODEL), 0.01),
        "norm_g": 1.0 + nrm(ks[6], (DEPTH, D_MODEL), 0.02),
        "w_in": nrm(ks[7], (DEPTH, D_MODEL, IN_WIDTH), D_MODEL ** -0.5),
        "lambda_q1": nrm(ks[8], (DEPTH, ATT_DIM), 0.1),
        "lambda_k1": nrm(ks[9], (DEPTH, ATT_DIM), 0.1),
        "lambda_q2": nrm(ks[10], (DEPTH, ATT_DIM), 0.1),
        "lambda_k2": nrm(ks[11], (DEPTH, ATT_DIM), 0.1),
        "subln_g": 1.0 + nrm(ks[12], (DEPTH, 2 * ATT_DIM), 0.02),
        "ssm_lambda_re": -0.5 + nrm(ks[13], (DEPTH, 2, G, P), 0.01),
        "ssm_lambda_im": jnp.pi * jnp.arange(P, dtype=f32) + nrm(ks[14], (DEPTH, 2, G, P), 0.01),
        "ssm_log_step": jax.random.uniform(ks[15], (DEPTH, 2, G), f32, math.log(1e-3), math.log(1e-1)),
        "ssm_b_re": nrm(ks[16], (DEPTH, 2, G, P, SSM_GROUP), (2 * SSM_GROUP) ** -0.5),
        "ssm_b_im": nrm(ks[17], (DEPTH, 2, G, P, SSM_GROUP), (2 * SSM_GROUP) ** -0.5),
        "ssm_c_re": nrm(ks[18], (DEPTH, 2, G, SSM_GROUP, P), P ** -0.5),
        "ssm_c_im": nrm(ks[19], (DEPTH, 2, G, SSM_GROUP, P), P ** -0.5),
        "ssm_d": nrm(ks[20], (DEPTH, G, SSM_GROUP), 1.0),
        "w_glu": nrm(ks[21], (DEPTH, SSM_WIDTH, SSM_WIDTH), SSM_WIDTH ** -0.5),
        "b_glu": nrm(ks[22], (DEPTH, SSM_WIDTH), 0.01),
        "w_pa": nrm(ks[23], (DEPTH, ATT_WIDTH, D_MODEL), ATT_WIDTH ** -0.5),
        "w_ps": nrm(ks[24], (DEPTH, SSM_WIDTH, D_MODEL), SSM_WIDTH ** -0.5),
        "w_out": nrm(ks[25], (DEPTH, D_MODEL, D_MODEL), D_MODEL ** -0.5),
        "final_g": 1.0 + nrm(jax.random.fold_in(key, 99), (D_MODEL,), 0.02),
    }


def reference(x, c, ctx, c_ctx, w_ada, b_ada, norm_g, w_in, lambda_q1, lambda_k1, lambda_q2,
              lambda_k2, subln_g, ssm_lambda_re, ssm_lambda_im, ssm_log_step, ssm_b_re, ssm_b_im,
              ssm_c_re, ssm_c_im, ssm_d, w_glu, b_glu, w_pa, w_ps, w_out, final_g):
    xc = ctx
    for i in range(DEPTH):
        p = dict(w_ada=w_ada[i], b_ada=b_ada[i], norm_g=norm_g[i], w_in=w_in[i],
                 lambda_q1=lambda_q1[i], lambda_k1=lambda_k1[i],
                 lambda_q2=lambda_q2[i], lambda_k2=lambda_k2[i], subln_g=subln_g[i],
                 ssm_lambda_re=ssm_lambda_re[i], ssm_lambda_im=ssm_lambda_im[i],
                 ssm_log_step=ssm_log_step[i], ssm_b_re=ssm_b_re[i], ssm_b_im=ssm_b_im[i],
                 ssm_c_re=ssm_c_re[i], ssm_c_im=ssm_c_im[i], ssm_d=ssm_d[i],
                 w_glu=w_glu[i], b_glu=b_glu[i], w_pa=w_pa[i], w_ps=w_ps[i], w_out=w_out[i])
        lam_init = 0.8 - 0.6 * math.exp(-0.3 * i)
        x, xc = _layer(x, xc, c, c_ctx, p, lam_init, update_ctx=(i < DEPTH - 1))
    return rmsnorm(x, final_g)
```

```cpp
#include <hip/hip_runtime.h>
#include <hip/hip_bf16.h>
#include <cstdio>
#include <cstdint>
#include <cmath>

constexpr size_t MiB = 1u << 20;
constexpr size_t WS_CTL = 0, CTL_ZERO_BYTES = 1 * MiB;
constexpr int CW_BAR = 4096;
constexpr size_t CTL_MOD = 262144, CTL_ROWSQ = 524288;
constexpr size_t WS_WIN = 2 * MiB;
constexpr size_t WS_WCAT = 38 * MiB;
constexpr size_t WS_WOUT = 44 * MiB;
constexpr size_t WS_WGLU = 52 * MiB;
constexpr size_t WS_ROPE = 52 * MiB + 512 * 1024;
constexpr size_t WS_SSMP = 53 * MiB;
constexpr size_t WS_SSMM = 54 * MiB;
constexpr size_t WS_UCH = 70 * MiB;
constexpr size_t WS_GS = 90 * MiB;
constexpr size_t WS_GA = 106 * MiB;
constexpr size_t WS_Q = 138 * MiB;
constexpr size_t WS_KALL = 170 * MiB;
constexpr size_t WS_VALL = 206 * MiB;
constexpr size_t WS_GM = 242 * MiB;
constexpr size_t WS_XN = 370 * MiB;
constexpr size_t WS_O1 = 370 * MiB, WS_O2 = 402 * MiB;
constexpr size_t WS_YF = 370 * MiB, WS_YB = 402 * MiB;
constexpr size_t WS_MG = 370 * MiB;
constexpr size_t WS_Y = 442 * MiB;
constexpr size_t WS_AS = 138 * MiB;
constexpr size_t WS_END = 458 * MiB;


namespace pg8 {
#define PG8_LAS __attribute__((address_space(3)))
typedef unsigned short bf16_t;
typedef short bf16x8 __attribute__((ext_vector_type(8)));
typedef float f32x4 __attribute__((ext_vector_type(4)));
typedef unsigned u32x4 __attribute__((ext_vector_type(4)));
constexpr int BM = 256, BK = 64, HALF = 128, HTB = HALF * BK * 2  , STAGE_BYTES = 8 * HTB, NXCD = 8, WGM = 8;

__host__ __device__ __forceinline__ int lds_byte(int r, int c) { const int st = (r >> 4) * 2 + (c >> 5), rr = r & 15, cc = c & 31, ob = rr * 64 + cc * 2; return st * 1024 + (ob ^ (((ob >> 9) & 1) << 5)); }
__host__ __device__ __forceinline__ void stage_rc(int b, int& R, int& C) { const int st = b / 1024, sb = b % 1024, swz = sb ^ (((sb >> 9) & 1) << 5); R = (st >> 1) * 16 + swz / 64; C = (st & 1) * 32 + (swz % 64) / 2; }
__host__ __device__ __forceinline__ int perm32(int rho) { const int n = rho >> 4, i = rho & 15; return 8 * (i >> 2) + 4 * n + (i & 3); }

struct Unit { int pm, pn; };
struct Gemm { const bf16_t* A; const bf16_t* Bt; int M, N, K; };

struct StaticOrder {
    int nM, nN, nwg, G, c;
    __host__ __device__ void init(int M, int N, int G_, int c_) { nM = M / BM; nN = N / BM; nwg = nM * nN; G = G_; c = c_; }
    __host__ __device__ bool next(int i, Unit& u) const {
        const long L = (long)i * G + c; if (L >= nwg) return false;
        int wgid = (int)L; { const int q = nwg / NXCD, r = nwg % NXCD, xcd = wgid % NXCD, off = wgid / NXCD; wgid = (xcd < r ? xcd * (q + 1) : r * (q + 1) + (xcd - r) * q) + off; }
        const int nig = WGM * nN, gid = wgid / nig, fm = gid * WGM, gsz = (nM - fm) < WGM ? (nM - fm) : WGM;
        u.pm = fm + ((wgid % nig) % gsz); u.pn = (wgid % nig) / gsz; return true;
    }
    __device__ __forceinline__ void a_ready(const Unit&) const {}
    __device__ __forceinline__ void done(const Unit&) const {}
};


__device__ __forceinline__ unsigned cvt_pk_bf16(float lo, float hi) { unsigned r; asm volatile("v_cvt_pk_bf16_f32 %0, %1, %2" : "=v"(r) : "v"(lo), "v"(hi)); return r; }
__device__ __forceinline__ float bf_lo(unsigned u) { return __uint_as_float(u << 16); }
__device__ __forceinline__ float bf_hi(unsigned u) { return __uint_as_float(u & 0xffff0000u); }
__device__ __forceinline__ void unpack8(const u32x4 w, f32x4& a, f32x4& b) { a = (f32x4){bf_lo(w.x), bf_hi(w.x), bf_lo(w.y), bf_hi(w.y)}; b = (f32x4){bf_lo(w.z), bf_hi(w.z), bf_lo(w.w), bf_hi(w.w)}; }
__device__ __forceinline__ u32x4 pack8(const f32x4 a, const f32x4 b) { u32x4 w; w.x = cvt_pk_bf16(a[0], a[1]); w.y = cvt_pk_bf16(a[2], a[3]); w.z = cvt_pk_bf16(b[0], b[1]); w.w = cvt_pk_bf16(b[2], b[3]); return w; }
__device__ __forceinline__ float sigmoid_f(float x) { return __builtin_amdgcn_rcpf(1.0f + __builtin_amdgcn_exp2f(-1.4426950408889634f * x)); }
__device__ __forceinline__ f32x4 sigmoid4(f32x4 v) { return (f32x4){sigmoid_f(v[0]), sigmoid_f(v[1]), sigmoid_f(v[2]), sigmoid_f(v[3])}; }
__device__ __forceinline__ f32x4 silu4(f32x4 v) { return v * sigmoid4(v); }
__device__ __forceinline__ f32x4 shflx32(f32x4 v) { return (f32x4){__shfl_xor(v[0], 32), __shfl_xor(v[1], 32), __shfl_xor(v[2], 32), __shfl_xor(v[3], 32)}; }

struct EpiInProj {
    static constexpr bool PERM = true, AFTER_DRAIN = false, HAS_MID = false;
    unsigned char* ws; float c2; int tmid;
    __device__ __forceinline__ void mid(f32x4 (&)[2][2][4][2], const Unit&, int, int, int, int) const {}
    __device__ __forceinline__ void operator()(const f32x4 (&acc)[2][2][4][2], const Unit& u, int wr, int wc, int fr, int fq) const {
        const int pn = u.pn, pm = u.pm;
        const bool isctx = pm >= 64;
        const int b = isctx ? pm - 64 : pm >> 3;
        const int t0 = isctx ? 0 : (pm & 7) * 256;
        const int colw = wc * 32 + 8 * fq;
        if (pn < 8) {
            const bool isq = pn < 4;
            bf16_t* base = (bf16_t*)(ws + (isq ? WS_Q : WS_KALL));
            const float* rope_c = (const float*)(ws + WS_ROPE); const float* rope_s = rope_c + 1024;
            const int ct = (isq ? pn : pn - 4) * 256 + colw;
            const float sgn = fq < 2 ? -1.f : 1.f, osc = isq ? c2 : 1.f;
#pragma unroll
            for (int ai = 0; ai < 2; ++ai)
#pragma unroll
                for (int m = 0; m < 4; ++m) {
                    const int rl = ai * HALF + wr * 64 + m * 16 + fr, t = t0 + rl;
                    const size_t grow = isq ? (size_t)(b * 2048 + t) : (size_t)(b * 2304 + (isctx ? 2048 : 0) + t);
                    f32x4 c0 = (f32x4){1.f, 1.f, 1.f, 1.f}, c1 = c0, s0 = (f32x4){0.f, 0.f, 0.f, 0.f}, s1 = s0;
                    if (!isctx) { const int pos = (wc & 1) ? (t & 63) : (t >> 6); const float* pc = rope_c + pos * 16 + 8 * (fq & 1); const float* ps = rope_s + pos * 16 + 8 * (fq & 1);
                        c0 = *(const f32x4*)pc; c1 = *(const f32x4*)(pc + 4); s0 = *(const f32x4*)ps * sgn; s1 = *(const f32x4*)(ps + 4) * sgn; }
#pragma unroll
                    for (int bj = 0; bj < 2; ++bj) {
                        const f32x4 v0 = acc[ai][bj][m][0], v1 = acc[ai][bj][m][1];
                        const f32x4 p0 = shflx32(v0), p1 = shflx32(v1);
                        const f32x4 o0 = (v0 * c0 + p0 * s0) * osc, o1 = (v1 * c1 + p1 * s1) * osc;
                        *(u32x4*)(base + grow * 1024 + ct + bj * HALF) = pack8(o0, o1);
                    }
                    asm volatile("" ::: "memory");
                }
        } else if (pn < 12) {
            const int ct = (pn - 8) * 256 + colw;
#pragma unroll
            for (int ai = 0; ai < 2; ++ai)
#pragma unroll
                for (int m = 0; m < 4; ++m) {
                    const int rl = ai * HALF + wr * 64 + m * 16 + fr, t = t0 + rl;
                    const size_t grow = (size_t)(b * 2304 + (isctx ? 2048 : 0) + t);
#pragma unroll
                    for (int bj = 0; bj < 2; ++bj) *(u32x4*)((bf16_t*)(ws + WS_VALL) + grow * 1024 + ct + bj * HALF) = pack8(acc[ai][bj][m][0], acc[ai][bj][m][1]);
                }
        } else if (pn == 16 || pn == 17) {
#pragma unroll
            for (int ai = 0; ai < 2; ++ai)
#pragma unroll
                for (int m = 0; m < 4; ++m) {
                    const int rl = ai * HALF + wr * 64 + m * 16 + fr, t = t0 + rl;
                    const int R = isctx ? 1024 + b * 16 + (t >> 4) : b * 128 + (t >> 4), tl = t & 15;
#pragma unroll
                    for (int bj = 0; bj < 2; ++bj) {
                        const int g = (pn - 16) * 16 + bj * 8 + wc * 2 + (fq >> 1), c0 = 8 * (fq & 1);
                        *(u32x4*)((bf16_t*)(ws + WS_UCH) + ((size_t)(g * 1280 + R) * 256 + tl * 16 + c0)) = pack8(acc[ai][bj][m][0], acc[ai][bj][m][1]);
                    }
                }
        } else {
            size_t boff; int pitch, ct; bool sil;
            if (pn < 16) { boff = WS_GA; pitch = 1024; ct = (pn - 12) * 256; sil = true; }
            else if (pn < 20) { boff = WS_GS; pitch = 512; ct = (pn - 18) * 256; sil = true; }
            else { boff = WS_GM; pitch = 4096; ct = (pn - 20) * 256; sil = false; }
            bf16_t* base = (bf16_t*)(ws + boff);
            ct += colw;
#pragma unroll
            for (int ai = 0; ai < 2; ++ai)
#pragma unroll
                for (int m = 0; m < 4; ++m) {
                    const size_t grow = (size_t)pm * 256 + ai * HALF + wr * 64 + m * 16 + fr;
#pragma unroll
                    for (int bj = 0; bj < 2; ++bj) {
                        const f32x4 v0 = acc[ai][bj][m][0], v1 = acc[ai][bj][m][1];
                        const f32x4 g0 = sigmoid4(v0), g1 = sigmoid4(v1);
                        const f32x4 o0 = sil ? v0 * g0 : g0, o1 = sil ? v1 * g1 : g1;
                        *(u32x4*)(base + grow * pitch + ct + bj * HALF) = pack8(o0, o1);
                    }
                    asm volatile("" ::: "memory");
                }
        }
    }
};

struct EpiGlu {
    static constexpr bool PERM = true, AFTER_DRAIN = false, HAS_MID = false;
    const bf16_t *Y, *GS; const float* bglu; bf16_t* AS; int tmid;
    __device__ __forceinline__ void mid(f32x4 (&)[2][2][4][2], const Unit&, int, int, int, int) const {}
    __device__ __forceinline__ void operator()(const f32x4 (&acc)[2][2][4][2], const Unit& u, int wr, int wc, int fr, int fq) const {
        const int col0 = u.pn * BM + wc * 32 + 8 * fq;
        f32x4 bv[2][2];
#pragma unroll
        for (int bj = 0; bj < 2; ++bj)
#pragma unroll
            for (int n = 0; n < 2; ++n) bv[bj][n] = *(const f32x4*)(bglu + col0 + bj * HALF + 4 * n);
#pragma unroll
        for (int ai = 0; ai < 2; ++ai)
#pragma unroll
            for (int m = 0; m < 4; ++m) {
                const size_t row = (size_t)u.pm * BM + ai * HALF + wr * 64 + m * 16 + fr;
#pragma unroll
                for (int bj = 0; bj < 2; ++bj) {
                    const int col = col0 + bj * HALF;
                    f32x4 y0, y1, g0, g1; unpack8(*(const u32x4*)(Y + row * 512 + col), y0, y1); unpack8(*(const u32x4*)(GS + row * 512 + col), g0, g1);
                    const f32x4 o0 = y0 * sigmoid4(acc[ai][bj][m][0] + bv[bj][0]) * g0, o1 = y1 * sigmoid4(acc[ai][bj][m][1] + bv[bj][1]) * g1;
                    *(u32x4*)(AS + row * 1536 + 1024 + col) = pack8(o0, o1);
                }
                asm volatile("" ::: "memory");
            }
    }
};

struct EpiMerged {
    static constexpr bool PERM = true, AFTER_DRAIN = false, HAS_MID = true;
    const bf16_t* GM; bf16_t* MG; int tmid;
    __device__ __forceinline__ void mid(f32x4 (&acc)[2][2][4][2], const Unit& u, int wr, int wc, int fr, int fq) const {
        unsigned opq = 0; asm volatile("" : "+v"(opq));
        const unsigned col0 = u.pn * BM + wc * 32 + 8 * fq + opq;
#pragma unroll
        for (int ai = 0; ai < 2; ++ai)
#pragma unroll
            for (int m = 0; m < 4; ++m) {
                const unsigned row = u.pm * BM + ai * HALF + wr * 64 + m * 16 + fr;
#pragma unroll
                for (int bj = 0; bj < 2; ++bj) {
                    const unsigned col = col0 + bj * HALF;
                    f32x4 a0, a1, s0, s1; unpack8(*(const u32x4*)(GM + (row * 4096u + col)), a0, a1); unpack8(*(const u32x4*)(GM + (row * 4096u + 2048u + col)), s0, s1);
#pragma unroll
                    for (int e = 0; e < 4; ++e) { acc[ai][bj][m][0][e] *= a0[e] * __builtin_amdgcn_rcpf(fmaxf(s0[e], 1e-30f)); acc[ai][bj][m][1][e] *= a1[e] * __builtin_amdgcn_rcpf(fmaxf(s1[e], 1e-30f)); }
                }
                asm volatile("" ::: "memory");
            }
    }
    __device__ __forceinline__ void operator()(const f32x4 (&acc)[2][2][4][2], const Unit& u, int wr, int wc, int fr, int fq) const {
        const int col0 = u.pn * BM + wc * 32 + 8 * fq;
#pragma unroll
        for (int ai = 0; ai < 2; ++ai)
#pragma unroll
            for (int m = 0; m < 4; ++m) {
                const size_t row = (size_t)u.pm * BM + ai * HALF + wr * 64 + m * 16 + fr;
#pragma unroll
                for (int bj = 0; bj < 2; ++bj) {
                    const int col = col0 + bj * HALF;
                    f32x4 s0, s1; unpack8(*(const u32x4*)(GM + row * 4096 + 2048 + col), s0, s1);
                    *(u32x4*)(MG + row * 2048 + col) = pack8(acc[ai][bj][m][0] * s0, acc[ai][bj][m][1] * s1);
                }
                asm volatile("" ::: "memory");
            }
    }
};

struct EpiOut {
    static constexpr bool PERM = false, AFTER_DRAIN = false, HAS_MID = false;
    const float *x, *mod, *bada; float* out; float* rowsq; int tmid;
    __device__ __forceinline__ void mid(f32x4 (&)[2][2][4][2], const Unit&, int, int, int, int) const {}
    __device__ __forceinline__ void operator()(const f32x4 (&acc)[2][2][4][2], const Unit& u, int wr, int wc, int fr, int fq) const {
        const int col0 = u.pn * BM + wc * 32 + 4 * fq, b = u.pm >> 3;
        f32x4 gv[2][2];
#pragma unroll
        for (int bj = 0; bj < 2; ++bj)
#pragma unroll
            for (int n = 0; n < 2; ++n) gv[bj][n] = *(const f32x4*)(mod + b * 6144 + 4096 + col0 + bj * HALF + n * 16) + *(const f32x4*)(bada + 4096 + col0 + bj * HALF + n * 16);
#pragma unroll
        for (int ai = 0; ai < 2; ++ai)
#pragma unroll
            for (int m = 0; m < 4; ++m) {
                const size_t row = (size_t)u.pm * BM + ai * HALF + wr * 64 + m * 16 + fr; float ss = 0.f;
#pragma unroll
                for (int bj = 0; bj < 2; ++bj)
#pragma unroll
                    for (int n = 0; n < 2; ++n) {
                        const size_t off = row * 2048 + col0 + bj * HALF + n * 16;
                        const f32x4 o = *(const f32x4*)(x + off) + gv[bj][n] * acc[ai][bj][m][n];
                        *(f32x4*)(out + off) = o; ss += (o[0] * o[0] + o[1] * o[1]) + (o[2] * o[2] + o[3] * o[3]);
                    }
                ss += __shfl_xor(ss, 16); ss += __shfl_xor(ss, 32);
                if (fq == 0) atomicAdd(rowsq + row, ss);
                asm volatile("" ::: "memory");
            }
    }
};
template <class Epi, class Sched, bool ALIGN_EPI = false, bool SP2 = false>
__device__ __forceinline__ void gemm_phase(PG8_LAS unsigned char* lds, const Gemm g, const Sched& S, const Epi& E) {
    const int tid = threadIdx.x, wid = __builtin_amdgcn_readfirstlane(tid >> 6), lane = tid & 63, wr = wid >> 2, wc = wid & 3, fr = lane & 15, fq = lane >> 4;
    const int K = g.K, nt = K / BK;
    unsigned voffA[2], voffB[2];
#pragma unroll
    for (int i = 0; i < 2; ++i) { int R, C; stage_rc(tid * 16 + i * 8192, R, C); const int Rb = Epi::PERM ? ((R & ~31) + perm32(R & 31)) : R;
        voffA[i] = (unsigned)(R * K + C) * 2u; voffB[i] = (unsigned)(Rb * K + C) * 2u; }
    const size_t kstep = (size_t)(BK * 2);
    const size_t hstep = (size_t)HALF * K * 2;
    const size_t tstep = 2 * hstep;
    const unsigned ldsw = (unsigned)wid * 1024u;
    const int aoff = lds_byte(wr * 64 + fr, fq * 8), boff = lds_byte(wc * 32 + fr, fq * 8);
#define PG8_SA(b, h) (((b) * 2 + (h)) * HTB)
#define PG8_SB(b, h) ((4 + (b) * 2 + (h)) * HTB)
#define PG8_STAGE(bufoff, gbase, voff) do { _Pragma("unroll") for (int _i = 0; _i < 2; ++_i) \
        __builtin_amdgcn_global_load_lds((const unsigned*)((const char*)(gbase) + (voff)[_i]), (PG8_LAS unsigned*)(lds + (bufoff) + ldsw + _i * 8192), 16, 0, 0); } while (0)
#define PG8_LDA(dst, b, h) do { _Pragma("unroll") for (int m = 0; m < 4; ++m) _Pragma("unroll") for (int k = 0; k < 2; ++k) dst[m][k] = *(const PG8_LAS bf16x8*)(lds + PG8_SA(b, h) + aoff + m * 2048 + k * 1024); } while (0)
#define PG8_LDB(dst, b, h) do { _Pragma("unroll") for (int n = 0; n < 2; ++n) _Pragma("unroll") for (int k = 0; k < 2; ++k) dst[n][k] = *(const PG8_LAS bf16x8*)(lds + PG8_SB(b, h) + boff + n * 2048 + k * 1024); } while (0)
#define PG8_MMA(ai, bj, At, Bt) do { __builtin_amdgcn_s_setprio(1); _Pragma("unroll") for (int m = 0; m < 4; ++m) _Pragma("unroll") for (int n = 0; n < 2; ++n) _Pragma("unroll") for (int k = 0; k < 2; ++k) \
        acc[ai][bj][m][n] = __builtin_amdgcn_mfma_f32_16x16x32_bf16(Bt[n][k], At[m][k], acc[ai][bj][m][n], 0, 0, 0); __builtin_amdgcn_s_setprio(0); } while (0)
#define PG8_WAIT_V(n) asm volatile("s_waitcnt vmcnt(" #n ")" ::: "memory")
#define PG8_WAIT_L(n) asm volatile("s_waitcnt lgkmcnt(" #n ")" ::: "memory")
#define PG8_BAR __builtin_amdgcn_s_barrier()
#define PG8_SCHED __builtin_amdgcn_sched_barrier(0)
    Unit cur, nxt; int ui = 0;
    if (!S.next(0, cur)) return;
    f32x4 acc[2][2][4][2];
#pragma unroll
    for (int a = 0; a < 2; ++a)
#pragma unroll
        for (int b = 0; b < 2; ++b)
#pragma unroll
            for (int m = 0; m < 4; ++m)
#pragma unroll
                for (int n = 0; n < 2; ++n) acc[a][b][m][n] = (f32x4){0.f, 0.f, 0.f, 0.f};
    bf16x8 At[4][2], B0[2][2], B1[2][2];
    const char* cA = (const char*)g.A + (size_t)cur.pm * tstep; const char* cB = (const char*)g.Bt + (size_t)cur.pn * tstep;
    S.a_ready(cur);
    if constexpr (SP2) {
        PG8_STAGE(PG8_SB(0, 0), cB, voffB); PG8_STAGE(PG8_SB(0, 1), cB + hstep, voffB); PG8_STAGE(PG8_SA(0, 0), cA, voffA); PG8_STAGE(PG8_SA(0, 1), cA + hstep, voffA);
        if (wr == 1) PG8_BAR;
        PG8_WAIT_V(2); PG8_BAR;
        PG8_STAGE(PG8_SB(1, 0), cB + kstep, voffB); PG8_STAGE(PG8_SA(1, 0), cA + kstep, voffA); PG8_STAGE(PG8_SB(1, 1), cB + hstep + kstep, voffB);
        PG8_WAIT_V(6); PG8_BAR;
    } else {
        PG8_STAGE(PG8_SB(0, 0), cB, voffB); PG8_STAGE(PG8_SA(0, 0), cA, voffA); PG8_STAGE(PG8_SB(0, 1), cB + hstep, voffB); PG8_STAGE(PG8_SA(0, 1), cA + hstep, voffA);
        if (wr == 1) PG8_BAR;
        PG8_WAIT_V(4); PG8_BAR;
        PG8_STAGE(PG8_SB(1, 0), cB + kstep, voffB); PG8_STAGE(PG8_SA(1, 0), cA + kstep, voffA); PG8_STAGE(PG8_SB(1, 1), cB + hstep + kstep, voffB);
        PG8_WAIT_V(6); PG8_BAR;
    }
    for (;;) {
        const bool has_next = S.next(ui + 1, nxt);
        const char* nA = has_next ? (const char*)g.A + (size_t)nxt.pm * tstep : cA; const char* nB = has_next ? (const char*)g.Bt + (size_t)nxt.pn * tstep : cB;
        for (int t = 0; t < nt; t += 2) {
            const bool last = (t == nt - 2);
            const char* a1 = cA + (size_t)(t + 1) * kstep;
            const char* a2 = last ? nA : cA + (size_t)(t + 2) * kstep; const char* b2 = last ? nB : cB + (size_t)(t + 2) * kstep;
            const char* a3 = a2 + kstep; const char* b3 = b2 + kstep;
            if (last && has_next) S.a_ready(nxt);
            if constexpr (Epi::HAS_MID) { if (t == E.tmid) E.mid(acc, cur, wr, wc, fr, fq); }
            if constexpr (SP2) {
            PG8_LDB(B0, 0, 0); PG8_LDB(B1, 0, 1); PG8_SCHED; PG8_LDA(At, 0, 0); PG8_STAGE(PG8_SA(1, 1), a1 + hstep, voffA);
            PG8_WAIT_V(8); PG8_WAIT_L(0); PG8_BAR; PG8_MMA(0, 0, At, B0); PG8_MMA(0, 1, At, B1); PG8_BAR; PG8_SCHED;
            PG8_LDA(At, 0, 1); PG8_STAGE(PG8_SB(0, 0), b2, voffB); PG8_STAGE(PG8_SB(0, 1), b2 + hstep, voffB); PG8_STAGE(PG8_SA(0, 0), a2, voffA);
            PG8_WAIT_V(8); PG8_WAIT_L(0); PG8_BAR; PG8_MMA(1, 0, At, B0); PG8_MMA(1, 1, At, B1); PG8_BAR; PG8_SCHED;
            PG8_LDB(B0, 1, 0); PG8_LDB(B1, 1, 1); PG8_SCHED; PG8_LDA(At, 1, 0); PG8_STAGE(PG8_SA(0, 1), a2 + hstep, voffA);
            PG8_WAIT_V(8); PG8_WAIT_L(0); PG8_BAR; PG8_MMA(0, 0, At, B0); PG8_MMA(0, 1, At, B1); PG8_BAR; PG8_SCHED;
            PG8_LDA(At, 1, 1); PG8_STAGE(PG8_SB(1, 0), b3, voffB); PG8_STAGE(PG8_SB(1, 1), b3 + hstep, voffB); PG8_STAGE(PG8_SA(1, 0), a3, voffA);
            PG8_WAIT_V(8); PG8_WAIT_L(0); PG8_BAR; PG8_MMA(1, 0, At, B0); PG8_MMA(1, 1, At, B1); PG8_BAR; PG8_SCHED;
            } else {
            PG8_LDB(B0, 0, 0); PG8_SCHED; PG8_LDA(At, 0, 0); PG8_STAGE(PG8_SA(1, 1), a1 + hstep, voffA);
            PG8_WAIT_L(8); PG8_BAR; PG8_WAIT_L(0); PG8_MMA(0, 0, At, B0); PG8_BAR; PG8_SCHED;
            PG8_LDB(B1, 0, 1); PG8_STAGE(PG8_SB(0, 0), b2, voffB);
            PG8_BAR; PG8_WAIT_L(0); PG8_MMA(0, 1, At, B1); PG8_BAR;
            PG8_LDA(At, 0, 1); PG8_STAGE(PG8_SA(0, 0), a2, voffA);
            PG8_BAR; PG8_WAIT_L(0); PG8_MMA(1, 0, At, B0); PG8_BAR; PG8_SCHED;
            PG8_STAGE(PG8_SB(0, 1), b2 + hstep, voffB);
            PG8_WAIT_V(6); PG8_BAR; PG8_MMA(1, 1, At, B1); PG8_BAR;
            PG8_LDB(B0, 1, 0); PG8_SCHED; PG8_LDA(At, 1, 0); PG8_STAGE(PG8_SA(0, 1), a2 + hstep, voffA);
            PG8_WAIT_L(8); PG8_BAR; PG8_WAIT_L(0); PG8_MMA(0, 0, At, B0); PG8_BAR; PG8_SCHED;
            PG8_LDB(B1, 1, 1); PG8_STAGE(PG8_SB(1, 0), b3, voffB);
            PG8_BAR; PG8_WAIT_L(0); PG8_MMA(0, 1, At, B1); PG8_BAR;
            PG8_LDA(At, 1, 1); PG8_STAGE(PG8_SA(1, 0), a3, voffA);
            PG8_BAR; PG8_WAIT_L(0); PG8_MMA(1, 0, At, B0); PG8_BAR; PG8_SCHED;
            PG8_STAGE(PG8_SB(1, 1), b3 + hstep, voffB);
            PG8_WAIT_V(6); PG8_BAR; PG8_MMA(1, 1, At, B1); PG8_BAR;
            }
        }
        if constexpr (ALIGN_EPI) { if (wr == 0) PG8_BAR; }
        if constexpr (!Epi::AFTER_DRAIN) { E(acc, cur, wr, wc, fr, fq); S.done(cur); }
        if (!has_next) break;
#pragma unroll
        for (int a = 0; a < 2; ++a)
#pragma unroll
            for (int b = 0; b < 2; ++b)
#pragma unroll
                for (int m = 0; m < 4; ++m)
#pragma unroll
                    for (int n = 0; n < 2; ++n) acc[a][b][m][n] = (f32x4){0.f, 0.f, 0.f, 0.f};
        cur = nxt; cA = nA; cB = nB; ++ui;
        if constexpr (ALIGN_EPI) { if (wr == 1) PG8_BAR; }
    }
    PG8_WAIT_V(0);
    if constexpr (!ALIGN_EPI) { if (wr == 0) PG8_BAR; }
    PG8_BAR;
    if constexpr (Epi::AFTER_DRAIN) { E.fused(acc, cur, wr, wc, fr, fq, lds, wid, lane); S.done(cur); }
#undef PG8_SA
#undef PG8_SB
#undef PG8_STAGE
#undef PG8_LDA
#undef PG8_LDB
#undef PG8_MMA
#undef PG8_WAIT_V
#undef PG8_WAIT_L
#undef PG8_BAR
#undef PG8_SCHED
}
}

#ifndef PG8_SP2
#define PG8_SP2 true
#endif
#ifndef PG8_ALIGN
#define PG8_ALIGN true
#endif
#define GAS __attribute__((address_space(1)))
#define LAS __attribute__((address_space(3)))
typedef unsigned short bf16;
typedef unsigned v4u __attribute__((ext_vector_type(4)));
typedef float f32x4 __attribute__((ext_vector_type(4)));
typedef short bf16x8 __attribute__((ext_vector_type(8)));
typedef GAS unsigned gu32;
typedef GAS unsigned long long gu64;
#define RLX_AGENT __ATOMIC_RELAXED, __HIP_MEMORY_SCOPE_AGENT
#define LDS_WAIT() asm volatile("s_waitcnt lgkmcnt(0)" ::: "memory")
#define VM_WAIT() asm volatile("s_waitcnt vmcnt(0)" ::: "memory")
__device__ __forceinline__ unsigned long long rt() { return __builtin_amdgcn_s_memrealtime(); }
__device__ __forceinline__ unsigned f2bf(float f) { unsigned u = __builtin_bit_cast(unsigned, f); return (u + 0x7fffu + ((u >> 16) & 1u)) >> 16; }
__device__ __forceinline__ unsigned pk2(float lo, float hi) { return f2bf(lo) | (f2bf(hi) << 16); }

#define XB_TMO      128
#define XB_XCNT(j)  (256  + 64 * (j))
#define XB_XSUB(j)  (1280 + 64 * (j))
#define XB_XGEN(j)  (2304 + 64 * (j))
#define XB_TOP      3328
#define XB_TOPGEN   3392
#define XCD_BAR_WORDS 3456
#define XB_SPIN_CAP (1u << 18)

__device__ __forceinline__ unsigned xb_ld(unsigned* p)              { return __hip_atomic_load(p, __ATOMIC_RELAXED, __HIP_MEMORY_SCOPE_AGENT); }
__device__ __forceinline__ unsigned xb_add(unsigned* p, unsigned v) { return __hip_atomic_fetch_add(p, v, __ATOMIC_RELAXED, __HIP_MEMORY_SCOPE_AGENT); }
__device__ __forceinline__ unsigned xb_xcc_id() { return (unsigned)__builtin_amdgcn_s_getreg((3 << 11) | 20) & 0xFu; }
#define XB_SPIN(cond, bar) do { unsigned _sp = 0; while (cond) { __builtin_amdgcn_s_sleep(1); \
    if ((++_sp & 255u) == 0u) { if (xb_ld(&(bar)[XB_TMO])) break; if (_sp > XB_SPIN_CAP) { atomicAdd(&(bar)[XB_TMO], 1u); break; } } } } while (0)

struct XcdBarrier {
    unsigned* bar; unsigned x;
    volatile LAS unsigned* st;
};

__device__ __forceinline__ XcdBarrier xcd_barrier_post(unsigned* bar, volatile LAS unsigned* st) {
    XcdBarrier b; b.bar = bar; b.x = xb_xcc_id(); b.st = st;
    if (threadIdx.x == 0) (void)xb_add(&bar[XB_XCNT(b.x)], 1u);
    return b;
}
__device__ __forceinline__ void xcd_barrier_complete(unsigned* bar, unsigned x, unsigned& nloc, unsigned& nx) {
    const unsigned G = gridDim.x * gridDim.y * gridDim.z;
    unsigned sum, cnt, mine, sp = 0u;
    for (;;) {
        sum = 0u; cnt = 0u; mine = 0u;
#pragma unroll
        for (unsigned j = 0; j < 16; ++j) { const unsigned c = xb_ld(&bar[XB_XCNT(j)]); sum += c; cnt += (c > 0u) ? 1u : 0u; mine = (j == x) ? c : mine; }
        if (sum == G) break;
        __builtin_amdgcn_s_sleep(1);
        if ((++sp & 255u) == 0u) { if (xb_ld(&bar[XB_TMO])) break; if (sp > XB_SPIN_CAP) { atomicAdd(&bar[XB_TMO], 1u); break; } }
    }
    nloc = mine > 0u ? mine : 1u; nx = cnt > 0u ? cnt : 1u;
}

__device__ __forceinline__ void xcd_barrier(const XcdBarrier& b) {
    asm volatile("s_waitcnt vmcnt(0)" ::: "memory");
    __syncthreads();
    if (threadIdx.x == 0) {
        unsigned* bar = b.bar;
        __builtin_amdgcn_s_waitcnt(0);
        unsigned nloc = b.st[0], nx = b.st[1];
        if (nloc == 0u) { xcd_barrier_complete(bar, b.x, nloc, nx); b.st[0] = nloc; b.st[1] = nx; }
        const unsigned old = xb_add(&bar[XB_XSUB(b.x)], 1u);
        const unsigned gen = old / nloc;
        if (old + 1u == (gen + 1u) * nloc) {
            __builtin_amdgcn_fence(__ATOMIC_RELEASE, "agent");
            asm volatile("s_waitcnt vmcnt(0)" ::: "memory");
            const unsigned og = xb_add(&bar[XB_TOP], 1u);
            const unsigned tg = og / nx;
            if (og + 1u == (tg + 1u) * nx) xb_add(&bar[XB_TOPGEN], 1u);
            else XB_SPIN(xb_ld(&bar[XB_TOPGEN]) == tg, bar);
            __builtin_amdgcn_fence(__ATOMIC_ACQUIRE, "agent");
            xb_add(&bar[XB_XGEN(b.x)], 1u);
            asm volatile("s_waitcnt vmcnt(0)" ::: "memory");
        } else {
            XB_SPIN(xb_ld(&bar[XB_XGEN(b.x)]) == gen, bar);
            __builtin_amdgcn_fence(__ATOMIC_ACQUIRE, "agent");
            asm volatile("s_waitcnt vmcnt(0)" ::: "memory");
        }
    }
    __syncthreads();
}


constexpr int NWAVES = 8;
#ifndef MK_PER_PHASE
#define MK_PER_PHASE 1
#endif

constexpr int BATCH = 8, SEQ = 2048, DM = 2048, CTXL = 256;
constexpr int MLAT = BATCH * SEQ, MCTX = BATCH * CTXL, MALL = MLAT + MCTX;
constexpr int INW = 9216, KVROWS = SEQ + CTXL;
constexpr float NORM_EPS = 1e-6f, LAM_INIT = 0.2f;
constexpr float QSCALE = 0.125f * 1.4426950408889634f;

constexpr int RING_BYTES = 131072;
constexpr int LDSCTL_OFF = RING_BYTES, MISC_OFF = LDSCTL_OFF + 320;
constexpr int LDS_BYTES = 147456;

struct Args { const float* in[27]; float* out; unsigned char* ws; int ph_lo, ph_hi, li, pad; };
enum In { I_X = 0, I_C, I_CTX, I_CCTX, I_WADA, I_BADA, I_NORMG, I_WIN, I_LQ1, I_LK1, I_LQ2, I_LK2, I_SUBLN, I_LRE, I_LIM, I_LSTEP, I_BRE, I_BIM, I_CRE, I_CIM, I_SSMD, I_WGLU, I_BGLU, I_WPA, I_WPS, I_WOUT, I_FING };

__device__ __forceinline__ float wave_sum(float v) {
#pragma unroll
    for (int o = 1; o < 64; o <<= 1) v += __shfl_xor(v, o);
    return v;
}
using pg8::bf_lo; using pg8::bf_hi; using pg8::unpack8; using pg8::pack8; using pg8::sigmoid_f;
typedef pg8::u32x4 u32x4;

__device__ __forceinline__ void p0_transpose_item(const float* W, int N, bf16* WT, int dpitch, int dcol, LAS float* scr, int item, int lane) {
    const int nblk = N / 32, kb = item / nblk, nb = item % nblk, k0 = 64 * kb, n0 = 32 * nb;
#pragma unroll 8
    for (int i = 0; i < 32; ++i) { const int kk = 2 * i + (lane >> 5); scr[kk * 33 + (lane & 31)] = W[(size_t)(k0 + kk) * N + n0 + (lane & 31)]; }
    LDS_WAIT(); asm volatile("" ::: "memory");
    const int c = lane & 7;
#pragma unroll
    for (int j = 0; j < 4; ++j) { const int n = (lane >> 3) + 8 * j; const LAS float* s = scr + (8 * c) * 33 + n;
        v4u o; o.x = pk2(s[0 * 33], s[1 * 33]); o.y = pk2(s[2 * 33], s[3 * 33]); o.z = pk2(s[4 * 33], s[5 * 33]); o.w = pk2(s[6 * 33], s[7 * 33]);
        *(GAS v4u*)(WT + (size_t)(n0 + n) * dpitch + dcol + k0 + 8 * c) = o; }
    LDS_WAIT(); asm volatile("" ::: "memory");
}

__device__ __forceinline__ void p0_prologue(const Args& a, LAS unsigned char* lds, int vcu, int G, int wave, int lane) {
    unsigned char* ws = a.ws;
    const int gw = vcu * NWAVES + wave, NGW = G * NWAVES;
    {
        float* mod = (float*)(ws + WS_CTL + CTL_MOD);
        const float* wada = a.in[I_WADA]; const float* cc = a.in[I_C]; const float* cctx = a.in[I_CCTX];
        for (int it = gw; it < 1536; it += NGW) {
            const int kc = it / 24, nc = it % 24, k0 = kc * 32, n0 = nc * 256 + 4 * lane;
            f32x4 acc[9];
#pragma unroll
            for (int r = 0; r < 9; ++r) acc[r] = (f32x4){0.f, 0.f, 0.f, 0.f};
            for (int kk = 0; kk < 32; ++kk) {
                const f32x4 w = *(const f32x4*)(wada + (size_t)(k0 + kk) * 6144 + n0);
#pragma unroll
                for (int r = 0; r < 9; ++r) { const float cv = (r < 8) ? cc[r * 2048 + k0 + kk] : cctx[k0 + kk]; const float s = cv * sigmoid_f(cv); acc[r] += w * s; }
            }
#pragma unroll
            for (int r = 0; r < 9; ++r)
#pragma unroll
                for (int e = 0; e < 4; ++e) atomicAdd(mod + r * 6144 + n0 + e, acc[r][e]);
        }
    }
    {
        LAS float* scr = (LAS float*)(lds + wave * 16384);
        constexpr int I_IN = (2048 / 64) * (9216 / 32), I_PA = (1024 / 64) * (2048 / 32), I_PS = (512 / 64) * (2048 / 32), I_OUT = (2048 / 64) * (2048 / 32), I_GLU = (512 / 64) * (512 / 32);
        constexpr int NITEMS = I_IN + I_PA + I_PS + I_OUT + I_GLU;
        for (int it = gw; it < NITEMS; it += NGW) {
            int r = it;
            if (r < I_IN) { p0_transpose_item(a.in[I_WIN], 9216, (bf16*)(ws + WS_WIN), 2048, 0, scr, r, lane); continue; } r -= I_IN;
            if (r < I_PA) { p0_transpose_item(a.in[I_WPA], 2048, (bf16*)(ws + WS_WCAT), 1536, 0, scr, r, lane); continue; } r -= I_PA;
            if (r < I_PS) { p0_transpose_item(a.in[I_WPS], 2048, (bf16*)(ws + WS_WCAT), 1536, 1024, scr, r, lane); continue; } r -= I_PS;
            if (r < I_OUT) { p0_transpose_item(a.in[I_WOUT], 2048, (bf16*)(ws + WS_WOUT), 2048, 0, scr, r, lane); continue; } r -= I_OUT;
            p0_transpose_item(a.in[I_WGLU], 512, (bf16*)(ws + WS_WGLU), 512, 0, scr, r, lane);
        }
    }
    const int gt = gw * 64 + lane;
    if (gt < 1024) {
        const int pos = gt >> 4, i = gt & 15;
        const float inv = exp2f(-(float)i * 0.8304820237218406f);
        const float ang = (float)pos * inv;
        float* rc = (float*)(ws + WS_ROPE); rc[gt] = cosf(ang); rc[1024 + gt] = sinf(ang);
    }
    if (gt >= 4096 && gt < 8192) {
        const int idx = gt - 4096, dg = idx >> 6;
        const float lre = a.in[I_LRE][idx], lim = a.in[I_LIM][idx], dt = expf(a.in[I_LSTEP][dg]);
        const float mag = expf(lre * dt), ar = mag * cosf(lim * dt), ai = mag * sinf(lim * dt);
        const float den = lre * lre + lim * lim;
        const float fr = ((ar - 1.0f) * lre + ai * lim) / den, fi = (ai * lre - (ar - 1.0f) * lim) / den;
        float* P = (float*)(ws + WS_SSMP);
        P[idx] = ar; P[4096 + idx] = ai;
        const float* br = a.in[I_BRE] + (size_t)idx * 16; const float* bi = a.in[I_BIM] + (size_t)idx * 16;
#pragma unroll
        for (int c = 0; c < 16; ++c) { P[8192 + idx * 16 + c] = fr * br[c] - fi * bi[c]; P[8192 + 65536 + idx * 16 + c] = fr * bi[c] + fi * br[c]; }
    }
}

__device__ __forceinline__ void p1_xn(const Args& a, int vcu, int G, int wave, int lane) {
    unsigned char* ws = a.ws;
    const int gw = vcu * NWAVES + wave, NGW = G * NWAVES;
    const float* mod = (const float*)(ws + WS_CTL + CTL_MOD); const float* bada = a.in[I_BADA]; const float* ng = a.in[I_NORMG];
    bf16* XN = (bf16*)(ws + WS_XN);
    for (int m = gw; m < MALL; m += NGW) {
        const float* src = m < MLAT ? a.in[I_X] + (size_t)m * DM : a.in[I_CTX] + (size_t)(m - MLAT) * DM;
        const int mr = m < MLAT ? (m >> 11) : 8;
        const f32x4* xr = (const f32x4*)src + lane;
        f32x4 v[8]; float s = 0.f;
#pragma unroll
        for (int j = 0; j < 8; ++j) { v[j] = xr[64 * j]; s += (v[j][0] * v[j][0] + v[j][1] * v[j][1]) + (v[j][2] * v[j][2] + v[j][3] * v[j][3]); }
        const float rstd = 1.0f / sqrtf(wave_sum(s) * (1.0f / DM) + NORM_EPS);
        unsigned long long* o8 = (unsigned long long*)(XN + (size_t)m * DM) + lane;
#pragma unroll
        for (int j = 0; j < 8; ++j) {
            const int col = 4 * lane + 256 * j;
            const f32x4 sh = *(const f32x4*)(mod + mr * 6144 + col) + *(const f32x4*)(bada + col);
            const f32x4 sc = *(const f32x4*)(mod + mr * 6144 + 2048 + col) + *(const f32x4*)(bada + 2048 + col);
            const f32x4 g = *(const f32x4*)(ng + col);
            const f32x4 h = (v[j] * rstd) * g * (sc + 1.0f) + sh;
            o8[64 * j] = (unsigned long long)pg8::cvt_pk_bf16(h[0], h[1]) | ((unsigned long long)pg8::cvt_pk_bf16(h[2], h[3]) << 32);
        }
    }
}

struct InProjOrder {
    pg8::StaticOrder so; int G, c;
    __device__ __forceinline__ void init(int G_, int c_) { so.init(MLAT, INW, G_, c_); G = G_; c = c_; }
    __device__ __forceinline__ bool next(int i, pg8::Unit& u) const {
        const long L = (long)i * G + c;
        if (L < 2304) return so.next(i, u);
        const int j = (int)(L - 2304); if (j >= 80) return false;
        const int jj = j % 10; u.pm = 64 + j / 10; u.pn = jj < 8 ? 4 + jj : 8 + jj; return true;
    }
    __device__ __forceinline__ void a_ready(const pg8::Unit&) const {}
    __device__ __forceinline__ void done(const pg8::Unit&) const {}
};

__device__ __forceinline__ void p3_attn_naive(const Args& a, int vcu, int G, int wave, int lane) {
    unsigned char* ws = a.ws;
    const int gw = vcu * NWAVES + wave, NGW = G * NWAVES;
    const bf16* Q = (const bf16*)(ws + WS_Q); const bf16* KALL = (const bf16*)(ws + WS_KALL); const bf16* VALL = (const bf16*)(ws + WS_VALL);
    for (int it = gw; it < 8192; it += NGW) {
        const int qblk = it & 63, s = (it >> 6) & 1, h = (it >> 7) & 7, b = it >> 10;
        const int r = lane & 31, vh = lane >> 5;
        const size_t tok = (size_t)b * SEQ + qblk * 32 + r;
        float q[64];
        { const u32x4* qp = (const u32x4*)(Q + tok * 1024 + h * 128 + s * 64);
#pragma unroll
          for (int j = 0; j < 8; ++j) { const u32x4 w = qp[j]; q[8 * j] = bf_lo(w.x); q[8 * j + 1] = bf_hi(w.x); q[8 * j + 2] = bf_lo(w.y); q[8 * j + 3] = bf_hi(w.y); q[8 * j + 4] = bf_lo(w.z); q[8 * j + 5] = bf_hi(w.z); q[8 * j + 6] = bf_lo(w.w); q[8 * j + 7] = bf_hi(w.w); } }
        const bf16* Kp = KALL + (size_t)b * KVROWS * 1024 + h * 128 + s * 64;
        const bf16* Vp = VALL + (size_t)b * KVROWS * 1024 + h * 128 + vh * 64;
        float mx = -3.0e38f;
        for (int key = 0; key < KVROWS; ++key) {
            const u32x4* kr = (const u32x4*)(Kp + (size_t)key * 1024); float sc = 0.f;
#pragma unroll
            for (int j = 0; j < 8; ++j) { const u32x4 w = kr[j];
                sc += q[8 * j] * bf_lo(w.x) + q[8 * j + 1] * bf_hi(w.x) + q[8 * j + 2] * bf_lo(w.y) + q[8 * j + 3] * bf_hi(w.y) + q[8 * j + 4] * bf_lo(w.z) + q[8 * j + 5] * bf_hi(w.z) + q[8 * j + 6] * bf_lo(w.w) + q[8 * j + 7] * bf_hi(w.w); }
            mx = fmaxf(mx, sc);
        }
        float l = 0.f, o[64];
#pragma unroll
        for (int e = 0; e < 64; ++e) o[e] = 0.f;
        for (int key = 0; key < KVROWS; ++key) {
            const u32x4* kr = (const u32x4*)(Kp + (size_t)key * 1024); float sc = 0.f;
#pragma unroll
            for (int j = 0; j < 8; ++j) { const u32x4 w = kr[j];
                sc += q[8 * j] * bf_lo(w.x) + q[8 * j + 1] * bf_hi(w.x) + q[8 * j + 2] * bf_lo(w.y) + q[8 * j + 3] * bf_hi(w.y) + q[8 * j + 4] * bf_lo(w.z) + q[8 * j + 5] * bf_hi(w.z) + q[8 * j + 6] * bf_lo(w.w) + q[8 * j + 7] * bf_hi(w.w); }
            const float p = exp2f(sc - mx); l += p;
            const u32x4* vr = (const u32x4*)(Vp + (size_t)key * 1024);
#pragma unroll
            for (int j = 0; j < 8; ++j) { const u32x4 w = vr[j];
                o[8 * j] += p * bf_lo(w.x); o[8 * j + 1] += p * bf_hi(w.x); o[8 * j + 2] += p * bf_lo(w.y); o[8 * j + 3] += p * bf_hi(w.y); o[8 * j + 4] += p * bf_lo(w.z); o[8 * j + 5] += p * bf_hi(w.z); o[8 * j + 6] += p * bf_lo(w.w); o[8 * j + 7] += p * bf_hi(w.w); }
        }
        const float rl = 1.0f / l;
        u32x4* op = (u32x4*)((bf16*)(ws + (s ? WS_O2 : WS_O1)) + tok * 1024 + h * 128 + vh * 64);
#pragma unroll
        for (int j = 0; j < 8; ++j) { u32x4 w; w.x = pg8::cvt_pk_bf16(o[8 * j] * rl, o[8 * j + 1] * rl); w.y = pg8::cvt_pk_bf16(o[8 * j + 2] * rl, o[8 * j + 3] * rl); w.z = pg8::cvt_pk_bf16(o[8 * j + 4] * rl, o[8 * j + 5] * rl); w.w = pg8::cvt_pk_bf16(o[8 * j + 6] * rl, o[8 * j + 7] * rl); op[j] = w; }
    }
}

__device__ __forceinline__ void p4_combine(const Args& a, int vcu, int G, int wave, int lane) {
    unsigned char* ws = a.ws;
    const int gw = vcu * NWAVES + wave, NGW = G * NWAVES;
    const float l1 = wave_sum(a.in[I_LQ1][lane] * a.in[I_LK1][lane]), l2 = wave_sum(a.in[I_LQ2][lane] * a.in[I_LK2][lane]);
    const float lam = expf(l1) - expf(l2) + LAM_INIT;
    const bf16* O1 = (const bf16*)(ws + WS_O1); const bf16* O2 = (const bf16*)(ws + WS_O2); const bf16* GA = (const bf16*)(ws + WS_GA); bf16* AS = (bf16*)(ws + WS_AS);
    const int col = 16 * lane;
    f32x4 sg[4];
#pragma unroll
    for (int j = 0; j < 4; ++j) sg[j] = *(const f32x4*)(a.in[I_SUBLN] + (col & 127) + 4 * j) * (1.0f - LAM_INIT);
    for (int tok = gw; tok < MLAT; tok += NGW) {
        f32x4 o[4], p[4], g[4];
        unpack8(*(const u32x4*)(O1 + (size_t)tok * 1024 + col), o[0], o[1]); unpack8(*(const u32x4*)(O1 + (size_t)tok * 1024 + col + 8), o[2], o[3]);
        unpack8(*(const u32x4*)(O2 + (size_t)tok * 1024 + col), p[0], p[1]); unpack8(*(const u32x4*)(O2 + (size_t)tok * 1024 + col + 8), p[2], p[3]);
        unpack8(*(const u32x4*)(GA + (size_t)tok * 1024 + col), g[0], g[1]); unpack8(*(const u32x4*)(GA + (size_t)tok * 1024 + col + 8), g[2], g[3]);
        float ss = 0.f;
#pragma unroll
        for (int j = 0; j < 4; ++j) { o[j] = o[j] - p[j] * lam; ss += (o[j][0] * o[j][0] + o[j][1] * o[j][1]) + (o[j][2] * o[j][2] + o[j][3] * o[j][3]); }
        ss += __shfl_xor(ss, 1); ss += __shfl_xor(ss, 2); ss += __shfl_xor(ss, 4);
        const float rs = 1.0f / sqrtf(ss * (1.0f / 128.0f) + NORM_EPS);
#pragma unroll
        for (int j = 0; j < 4; ++j) o[j] = o[j] * rs * sg[j] * g[j];
        *(u32x4*)(AS + (size_t)tok * 1536 + col) = pack8(o[0], o[1]); *(u32x4*)(AS + (size_t)tok * 1536 + col + 8) = pack8(o[2], o[3]);
    }
}

__device__ __forceinline__ void p5_ssm_naive(const Args& a, int vcu, int G, int wave, int lane) {
    unsigned char* ws = a.ws;
    const int gw = vcu * NWAVES + wave, NGW = G * NWAVES;
    const float* P = (const float*)(ws + WS_SSMP); const bf16* UCH = (const bf16*)(ws + WS_UCH);
    for (int it = gw; it < 512; it += NGW) {
        const int dir = it & 1, g = (it >> 1) & 31, b = it >> 6;
        const int idx = (dir * 32 + g) * 64 + lane;
        const float ar = P[idx], ai = P[4096 + idx];
        float bbr[16], bbi[16], cr[16], ci[16];
#pragma unroll
        for (int c = 0; c < 16; ++c) { bbr[c] = P[8192 + idx * 16 + c]; bbi[c] = P[8192 + 65536 + idx * 16 + c];
            cr[c] = a.in[I_CRE][((dir * 32 + g) * 16 + c) * 64 + lane]; ci[c] = a.in[I_CIM][((dir * 32 + g) * 16 + c) * 64 + lane]; }
        float* YD = (float*)(ws + (dir ? WS_YB : WS_YF));
        float hr = 0.f, hi = 0.f;
        for (int step = 0; step < KVROWS; ++step) {
            const bool isctx = step < CTXL; const int tt = isctx ? step : step - CTXL;
            const int t = dir ? ((isctx ? CTXL - 1 : SEQ - 1) - tt) : tt;
            const int R = isctx ? 1024 + b * 16 + (t >> 4) : b * 128 + (t >> 4), tl = t & 15;
            const u32x4* up = (const u32x4*)(UCH + ((size_t)(g * 1280 + R) * 256 + tl * 16));
            f32x4 u0, u1, u2, u3; unpack8(up[0], u0, u1); unpack8(up[1], u2, u3);
            float bur = 0.f, bui = 0.f;
#pragma unroll
            for (int e = 0; e < 4; ++e) { bur += bbr[e] * u0[e] + bbr[4 + e] * u1[e] + bbr[8 + e] * u2[e] + bbr[12 + e] * u3[e]; bui += bbi[e] * u0[e] + bbi[4 + e] * u1[e] + bbi[8 + e] * u2[e] + bbi[12 + e] * u3[e]; }
            const float nhr = ar * hr - ai * hi + bur, nhi = ar * hi + ai * hr + bui; hr = nhr; hi = nhi;
            if (!isctx) {
                float yv = 0.f;
#pragma unroll
                for (int c = 0; c < 16; ++c) { const float v = wave_sum(cr[c] * hr - ci[c] * hi); if (lane == c) yv = v; }
                if (lane < 16) YD[((size_t)b * SEQ + t) * 512 + g * 16 + lane] = yv;
            }
        }
    }
}

__device__ __forceinline__ float gelu_tanh(float x) {
    const float z = 0.7978845608028654f * (x + 0.044715f * x * x * x);
    const float th = 1.0f - 2.0f * __builtin_amdgcn_rcpf(1.0f + __builtin_amdgcn_exp2f(2.8853900817779268f * z));
    return 0.5f * x * (1.0f + th);
}
__device__ __forceinline__ void p6_ycombine(const Args& a, int vcu, int G, int wave, int lane) {
    unsigned char* ws = a.ws;
    const int gt = (vcu * NWAVES + wave) * 64 + lane, NGT = G * NWAVES * 64;
    const float* YF = (const float*)(ws + WS_YF); const float* YB = (const float*)(ws + WS_YB); const bf16* UCH = (const bf16*)(ws + WS_UCH); bf16* Y = (bf16*)(ws + WS_Y);
    for (int i = gt; i < MLAT * 64; i += NGT) {
        const int tok = i >> 6, c8 = (i & 63) * 8, g = c8 >> 4, c0 = c8 & 15, b = tok >> 11, t = tok & 2047, R = b * 128 + (t >> 4), tl = t & 15;
        f32x4 u0, u1; unpack8(*(const u32x4*)(UCH + ((size_t)(g * 1280 + R) * 256 + tl * 16 + c0)), u0, u1);
        const f32x4 d0 = *(const f32x4*)(a.in[I_SSMD] + g * 16 + c0), d1 = *(const f32x4*)(a.in[I_SSMD] + g * 16 + c0 + 4);
        f32x4 y0 = *(const f32x4*)(YF + (size_t)tok * 512 + c8) + *(const f32x4*)(YB + (size_t)tok * 512 + c8) + d0 * u0;
        f32x4 y1 = *(const f32x4*)(YF + (size_t)tok * 512 + c8 + 4) + *(const f32x4*)(YB + (size_t)tok * 512 + c8 + 4) + d1 * u1;
#pragma unroll
        for (int e = 0; e < 4; ++e) { y0[e] = gelu_tanh(y0[e]); y1[e] = gelu_tanh(y1[e]); }
        *(u32x4*)(Y + (size_t)tok * 512 + c8) = pack8(y0, y1);
    }
}

__device__ __forceinline__ void p10_final(const Args& a, int vcu, int G, int wave, int lane) {
    const int gw = vcu * NWAVES + wave, NGW = G * NWAVES;
    const float* rowsq = (const float*)(a.ws + WS_CTL + CTL_ROWSQ); const float* fg = a.in[I_FING];
    for (int m = gw; m < MLAT; m += NGW) {
        const float rstd = 1.0f / sqrtf(rowsq[m] * (1.0f / DM) + NORM_EPS);
        f32x4* o = (f32x4*)(a.out + (size_t)m * DM) + lane;
#pragma unroll
        for (int j = 0; j < 8; ++j) { const f32x4 g = *(const f32x4*)(fg + 4 * lane + 256 * j); o[64 * j] = o[64 * j] * rstd * g; }
    }
}

constexpr int N_PHASES = 11;
__global__ void __launch_bounds__(NWAVES * 64, 2) skel_fwd(Args args) {
    extern __shared__ __attribute__((aligned(16))) unsigned char lds_raw[];
    LAS unsigned char* lds = (LAS unsigned char*)lds_raw;
    volatile LAS unsigned* MISC = (volatile LAS unsigned*)(lds + MISC_OFF);
    const int tid = threadIdx.x, lane = tid & 63, wave = __builtin_amdgcn_readfirstlane(tid >> 6);
    const int G = gridDim.x; const int bx = blockIdx.x; const int vcu = (G % 8 == 0) ? (bx % 8) * (G / 8) + bx / 8 : bx;
    unsigned char* ws = args.ws;
    gu32* ctl = (gu32*)(ws + WS_CTL);
    for (int u = tid; u < (LDS_BYTES - LDSCTL_OFF) / 4; u += NWAVES * 64) ((LAS unsigned*)(lds + LDSCTL_OFF))[u] = 0u;
    __syncthreads();
    XcdBarrier bar; bar.bar = (unsigned*)(ctl + CW_BAR); bar.x = 0; bar.st = nullptr;
    if (!MK_PER_PHASE) bar = xcd_barrier_post((unsigned*)(ctl + CW_BAR), MISC + 8);
    const int lo = args.ph_lo, hi = args.ph_hi;
#ifndef ONLY_PHASE
#define ONLY_PHASE -1
#endif
#define IN(k) ((ONLY_PHASE < 0 || ONLY_PHASE == (k)) && lo <= (k) && (k) < hi)
#define SEAM(k) do { if (IN(k) && IN((k) + 1)) xcd_barrier(bar); } while (0)

    if (IN(0)) { p0_prologue(args, lds, vcu, G, wave, lane); } SEAM(0);
    if (IN(1)) { p1_xn(args, vcu, G, wave, lane); } SEAM(1);
    if (IN(2)) {
        pg8::Gemm g{(const pg8::bf16_t*)(ws + WS_XN), (const pg8::bf16_t*)(ws + WS_WIN), MALL, INW, DM};
        InProjOrder S; S.init(G, bx);
        pg8::EpiInProj E{ws, QSCALE, -1};
        pg8::gemm_phase<pg8::EpiInProj, InProjOrder, PG8_ALIGN, PG8_SP2>(lds, g, S, E);
    } SEAM(2);
    if (IN(3)) { p3_attn_naive(args, vcu, G, wave, lane); } SEAM(3);
    if (IN(4)) { p4_combine(args, vcu, G, wave, lane); } SEAM(4);
    if (IN(5)) { p5_ssm_naive(args, vcu, G, wave, lane); } SEAM(5);
    if (IN(6)) { p6_ycombine(args, vcu, G, wave, lane); } SEAM(6);
    if (IN(7)) {
        pg8::Gemm g{(const pg8::bf16_t*)(ws + WS_Y), (const pg8::bf16_t*)(ws + WS_WGLU), MLAT, 512, 512};
        pg8::StaticOrder S; S.init(MLAT, 512, G, bx);
        pg8::EpiGlu E{(const pg8::bf16_t*)(ws + WS_Y), (const pg8::bf16_t*)(ws + WS_GS), args.in[I_BGLU], (pg8::bf16_t*)(ws + WS_AS), -1};
        pg8::gemm_phase<pg8::EpiGlu, pg8::StaticOrder, PG8_ALIGN, PG8_SP2>(lds, g, S, E);
    } SEAM(7);
    if (IN(8)) {
        pg8::Gemm g{(const pg8::bf16_t*)(ws + WS_AS), (const pg8::bf16_t*)(ws + WS_WCAT), MLAT, DM, 1536};
        pg8::StaticOrder S; S.init(MLAT, DM, G, bx);
        pg8::EpiMerged E{(const pg8::bf16_t*)(ws + WS_GM), (pg8::bf16_t*)(ws + WS_MG), 16};
        pg8::gemm_phase<pg8::EpiMerged, pg8::StaticOrder, PG8_ALIGN, PG8_SP2>(lds, g, S, E);
    } SEAM(8);
    if (IN(9)) {
        pg8::Gemm g{(const pg8::bf16_t*)(ws + WS_MG), (const pg8::bf16_t*)(ws + WS_WOUT), MLAT, DM, DM};
        pg8::StaticOrder S; S.init(MLAT, DM, G, bx);
        pg8::EpiOut E{args.in[I_X], (const float*)(ws + WS_CTL + CTL_MOD), args.in[I_BADA], args.out, (float*)(ws + WS_CTL + CTL_ROWSQ), -1};
        pg8::gemm_phase<pg8::EpiOut, pg8::StaticOrder, PG8_ALIGN, PG8_SP2>(lds, g, S, E);
    } SEAM(9);
    if (IN(10)) { p10_final(args, vcu, G, wave, lane); }
#undef IN
#undef SEAM
}

extern "C" void kernel_launch(void* const* d_in, const int* in_sizes, int n_in, void* d_out, int out_size, void* d_ws, size_t ws_size, hipStream_t stream) {
    static int grid = 0;
    if (grid == 0) {
        if (n_in != 27 || out_size != MLAT * DM || ws_size < WS_END) { fprintf(stderr, "kernel_launch: unexpected shapes (n_in %d, out %d, ws %zu); nothing launched\n", n_in, out_size, ws_size); grid = -1; return; }
        int dev = 0, cus = 0, per_cu = 0;
        if (hipGetDevice(&dev) != hipSuccess || hipDeviceGetAttribute(&cus, hipDeviceAttributeMultiprocessorCount, dev) != hipSuccess) { grid = -1; return; }
        if (hipFuncSetAttribute((const void*)skel_fwd, hipFuncAttributeMaxDynamicSharedMemorySize, LDS_BYTES) != hipSuccess) { fprintf(stderr, "kernel_launch: hipFuncSetAttribute failed\n"); grid = -1; return; }
        if (hipOccupancyMaxActiveBlocksPerMultiprocessor(&per_cu, (const void*)skel_fwd, NWAVES * 64, LDS_BYTES) != hipSuccess || per_cu < 1) { fprintf(stderr, "kernel_launch: occupancy query says %d blocks per CU\n", per_cu); }
        (void)hipGetLastError();
        grid = cus;
    }
    if (grid < 0) return;
    if (hipMemsetAsync((char*)d_ws + WS_CTL, 0, CTL_ZERO_BYTES, stream) != hipSuccess) { fprintf(stderr, "kernel_launch: hipMemsetAsync failed\n"); return; }
    Args a{};
    for (int i = 0; i < 27; ++i) a.in[i] = (const float*)d_in[i];
    a.out = (float*)d_out; a.ws = (unsigned char*)d_ws;
#if MK_PER_PHASE
    for (int p = 0; p < N_PHASES; ++p) { a.ph_lo = p; a.ph_hi = p + 1; a.li = 0; hipLaunchKernelGGL(skel_fwd, dim3(grid), dim3(NWAVES * 64), LDS_BYTES, stream, a); }
#else
    a.ph_lo = 0; a.ph_hi = N_PHASES; a.li = 0;
    hipLaunchKernelGGL(skel_fwd, dim3(grid), dim3(NWAVES * 64), LDS_BYTES, stream, a);
#endif
    const hipError_t le = hipPeekAtLastError();
    if (le != hipSuccess) fprintf(stderr, "kernel_launch: launch failed: %s\n", hipGetErrorName(le));
}
```

```cpp
#include <hip/hip_runtime.h>
#include <hip/hip_bf16.h>
#include <cstdio>
#include <cstdint>
#include <cmath>

constexpr size_t MiB = 1u << 20;
constexpr size_t WS_CTL = 0, CTL_ZERO_BYTES = 1 * MiB;
constexpr int CW_BAR = 4096;
constexpr size_t CTL_MOD = 262144, CTL_ROWSQ = 524288;
constexpr size_t WS_WIN = 2 * MiB;
constexpr size_t WS_WCAT = 38 * MiB;
constexpr size_t WS_WOUT = 44 * MiB;
constexpr size_t WS_WGLU = 52 * MiB;
constexpr size_t WS_ROPE = 52 * MiB + 512 * 1024;
constexpr size_t WS_SSMP = 53 * MiB;
constexpr size_t WS_SSMM = 54 * MiB;
constexpr size_t WS_UCH = 70 * MiB;
constexpr size_t WS_GS = 90 * MiB;
constexpr size_t WS_GA = 106 * MiB;
constexpr size_t WS_Q = 138 * MiB;
constexpr size_t WS_KALL = 170 * MiB;
constexpr size_t WS_VALL = 206 * MiB;
constexpr size_t WS_GM = 242 * MiB;
constexpr size_t WS_XN = 370 * MiB;
constexpr size_t WS_O1 = 370 * MiB, WS_O2 = 402 * MiB;
constexpr size_t WS_YF = 370 * MiB, WS_YB = 402 * MiB;
constexpr size_t WS_MG = 370 * MiB;
constexpr size_t WS_Y = 442 * MiB;
constexpr size_t WS_AS = 138 * MiB;
constexpr size_t WS_END = 458 * MiB;


namespace pg8 {
#define PG8_LAS __attribute__((address_space(3)))
typedef unsigned short bf16_t;
typedef short bf16x8 __attribute__((ext_vector_type(8)));
typedef float f32x4 __attribute__((ext_vector_type(4)));
typedef unsigned u32x4 __attribute__((ext_vector_type(4)));
constexpr int BM = 256, BK = 64, HALF = 128, HTB = HALF * BK * 2  , STAGE_BYTES = 8 * HTB, NXCD = 8, WGM = 8;

__host__ __device__ __forceinline__ int lds_byte(int r, int c) { const int st = (r >> 4) * 2 + (c >> 5), rr = r & 15, cc = c & 31, ob = rr * 64 + cc * 2; return st * 1024 + (ob ^ (((ob >> 9) & 1) << 5)); }
__host__ __device__ __forceinline__ void stage_rc(int b, int& R, int& C) { const int st = b / 1024, sb = b % 1024, swz = sb ^ (((sb >> 9) & 1) << 5); R = (st >> 1) * 16 + swz / 64; C = (st & 1) * 32 + (swz % 64) / 2; }
__host__ __device__ __forceinline__ int perm32(int rho) { const int n = rho >> 4, i = rho & 15; return 8 * (i >> 2) + 4 * n + (i & 3); }

struct Unit { int pm, pn; };
struct Gemm { const bf16_t* A; const bf16_t* Bt; int M, N, K; };

struct StaticOrder {
    int nM, nN, nwg, G, c;
    __host__ __device__ void init(int M, int N, int G_, int c_) { nM = M / BM; nN = N / BM; nwg = nM * nN; G = G_; c = c_; }
    __host__ __device__ bool next(int i, Unit& u) const {
        const long L = (long)i * G + c; if (L >= nwg) return false;
        int wgid = (int)L; { const int q = nwg / NXCD, r = nwg % NXCD, xcd = wgid % NXCD, off = wgid / NXCD; wgid = (xcd < r ? xcd * (q + 1) : r * (q + 1) + (xcd - r) * q) + off; }
        const int nig = WGM * nN, gid = wgid / nig, fm = gid * WGM, gsz = (nM - fm) < WGM ? (nM - fm) : WGM;
        u.pm = fm + ((wgid % nig) % gsz); u.pn = (wgid % nig) / gsz; return true;
    }
    __device__ __forceinline__ void a_ready(const Unit&) const {}
    __device__ __forceinline__ void done(const Unit&) const {}
};


__device__ __forceinline__ unsigned cvt_pk_bf16(float lo, float hi) { unsigned r; asm volatile("v_cvt_pk_bf16_f32 %0, %1, %2" : "=v"(r) : "v"(lo), "v"(hi)); return r; }
__device__ __forceinline__ int lane_id_v() { int l; asm volatile("v_mbcnt_lo_u32_b32 %0, -1, 0\n\tv_mbcnt_hi_u32_b32 %0, -1, %0" : "=v"(l)); return l; }
__device__ __forceinline__ float bf_lo(unsigned u) { return __uint_as_float(u << 16); }
__device__ __forceinline__ float bf_hi(unsigned u) { return __uint_as_float(u & 0xffff0000u); }
__device__ __forceinline__ void unpack8(const u32x4 w, f32x4& a, f32x4& b) { a = (f32x4){bf_lo(w.x), bf_hi(w.x), bf_lo(w.y), bf_hi(w.y)}; b = (f32x4){bf_lo(w.z), bf_hi(w.z), bf_lo(w.w), bf_hi(w.w)}; }
__device__ __forceinline__ u32x4 pack8(const f32x4 a, const f32x4 b) { u32x4 w; w.x = cvt_pk_bf16(a[0], a[1]); w.y = cvt_pk_bf16(a[2], a[3]); w.z = cvt_pk_bf16(b[0], b[1]); w.w = cvt_pk_bf16(b[2], b[3]); return w; }
__device__ __forceinline__ float sigmoid_f(float x) { return __builtin_amdgcn_rcpf(1.0f + __builtin_amdgcn_exp2f(-1.4426950408889634f * x)); }
__device__ __forceinline__ f32x4 sigmoid4(f32x4 v) { return (f32x4){sigmoid_f(v[0]), sigmoid_f(v[1]), sigmoid_f(v[2]), sigmoid_f(v[3])}; }
__device__ __forceinline__ f32x4 silu4(f32x4 v) { return v * sigmoid4(v); }
__device__ __forceinline__ f32x4 shflx32(f32x4 v) { return (f32x4){__shfl_xor(v[0], 32), __shfl_xor(v[1], 32), __shfl_xor(v[2], 32), __shfl_xor(v[3], 32)}; }

struct EpiInProj {
    static constexpr bool PERM = true, AFTER_DRAIN = false, HAS_MID = false;
    unsigned char* ws; float c2; int tmid;
    __device__ __forceinline__ void mid(f32x4 (&)[2][2][4][2], const Unit&, int, int, int, int) const {}
    __device__ __forceinline__ void operator()(const f32x4 (&acc)[2][2][4][2], const Unit& u, int wr, int wc, int fr, int fq) const {
        const int pn = u.pn, pm = u.pm;
        const bool isctx = pm >= 64;
        const int b = isctx ? pm - 64 : pm >> 3;
        const int t0 = isctx ? 0 : (pm & 7) * 256;
        const int colw = wc * 32 + 8 * fq;
        if (pn < 8) {
            const bool isq = pn < 4;
            bf16_t* base = (bf16_t*)(ws + (isq ? WS_Q : WS_KALL));
            const float* rope_c = (const float*)(ws + WS_ROPE); const float* rope_s = rope_c + 1024;
            const int ct = (isq ? pn : pn - 4) * 256 + colw;
            const float sgn = fq < 2 ? -1.f : 1.f, osc = isq ? c2 : 1.f;
#pragma unroll
            for (int ai = 0; ai < 2; ++ai)
#pragma unroll
                for (int m = 0; m < 4; ++m) {
                    const int rl = ai * HALF + wr * 64 + m * 16 + fr, t = t0 + rl;
                    const size_t grow = isq ? (size_t)(b * 2048 + t) : (size_t)(b * 2304 + (isctx ? 2048 : 0) + t);
                    f32x4 c0 = (f32x4){1.f, 1.f, 1.f, 1.f}, c1 = c0, s0 = (f32x4){0.f, 0.f, 0.f, 0.f}, s1 = s0;
                    if (!isctx) { const int pos = (wc & 1) ? (t & 63) : (t >> 6); const float* pc = rope_c + pos * 16 + 8 * (fq & 1); const float* ps = rope_s + pos * 16 + 8 * (fq & 1);
                        c0 = *(const f32x4*)pc; c1 = *(const f32x4*)(pc + 4); s0 = *(const f32x4*)ps * sgn; s1 = *(const f32x4*)(ps + 4) * sgn; }
#pragma unroll
                    for (int bj = 0; bj < 2; ++bj) {
                        const f32x4 v0 = acc[ai][bj][m][0], v1 = acc[ai][bj][m][1];
                        const f32x4 p0 = shflx32(v0), p1 = shflx32(v1);
                        const f32x4 o0 = (v0 * c0 + p0 * s0) * osc, o1 = (v1 * c1 + p1 * s1) * osc;
                        *(u32x4*)(base + grow * 1024 + ct + bj * HALF) = pack8(o0, o1);
                    }
                    asm volatile("" ::: "memory");
                }
        } else if (pn < 12) {
            const int ct = (pn - 8) * 256 + colw;
#pragma unroll
            for (int ai = 0; ai < 2; ++ai)
#pragma unroll
                for (int m = 0; m < 4; ++m) {
                    const int rl = ai * HALF + wr * 64 + m * 16 + fr, t = t0 + rl;
                    const size_t grow = (size_t)(b * 2304 + (isctx ? 2048 : 0) + t);
#pragma unroll
                    for (int bj = 0; bj < 2; ++bj) *(u32x4*)((bf16_t*)(ws + WS_VALL) + grow * 1024 + ct + bj * HALF) = pack8(acc[ai][bj][m][0], acc[ai][bj][m][1]);
                }
        } else if (pn == 16 || pn == 17) {
#pragma unroll
            for (int ai = 0; ai < 2; ++ai)
#pragma unroll
                for (int m = 0; m < 4; ++m) {
                    const int rl = ai * HALF + wr * 64 + m * 16 + fr, t = t0 + rl;
                    const int R = isctx ? 1024 + b * 16 + (t >> 4) : b * 128 + (t >> 4), tl = t & 15;
#pragma unroll
                    for (int bj = 0; bj < 2; ++bj) {
                        const int g = (pn - 16) * 16 + bj * 8 + wc * 2 + (fq >> 1), c0 = 8 * (fq & 1);
                        *(u32x4*)((bf16_t*)(ws + WS_UCH) + ((size_t)(g * 1280 + R) * 256 + tl * 16 + c0)) = pack8(acc[ai][bj][m][0], acc[ai][bj][m][1]);
                    }
                }
        } else {
            size_t boff; int pitch, ct; bool sil;
            if (pn < 16) { boff = WS_GA; pitch = 1024; ct = (pn - 12) * 256; sil = true; }
            else if (pn < 20) { boff = WS_GS; pitch = 512; ct = (pn - 18) * 256; sil = true; }
            else { boff = WS_GM; pitch = 4096; ct = (pn - 20) * 256; sil = false; }
            bf16_t* base = (bf16_t*)(ws + boff);
            ct += colw;
#pragma unroll
            for (int ai = 0; ai < 2; ++ai)
#pragma unroll
                for (int m = 0; m < 4; ++m) {
                    const size_t grow = (size_t)pm * 256 + ai * HALF + wr * 64 + m * 16 + fr;
#pragma unroll
                    for (int bj = 0; bj < 2; ++bj) {
                        const f32x4 v0 = acc[ai][bj][m][0], v1 = acc[ai][bj][m][1];
                        const f32x4 g0 = sigmoid4(v0), g1 = sigmoid4(v1);
                        const f32x4 o0 = sil ? v0 * g0 : g0, o1 = sil ? v1 * g1 : g1;
                        *(u32x4*)(base + grow * pitch + ct + bj * HALF) = pack8(o0, o1);
                    }
                    asm volatile("" ::: "memory");
                }
        }
    }
};

struct EpiGlu {
    static constexpr bool PERM = true, AFTER_DRAIN = false, HAS_MID = false;
    const bf16_t *Y, *GS; const float* bglu; bf16_t* AS; int tmid;
    __device__ __forceinline__ void mid(f32x4 (&)[2][2][4][2], const Unit&, int, int, int, int) const {}
    __device__ __forceinline__ void operator()(const f32x4 (&acc)[2][2][4][2], const Unit& u, int wr, int wc, int fr, int fq) const {
        const int col0 = u.pn * BM + wc * 32 + 8 * fq;
        f32x4 bv[2][2];
#pragma unroll
        for (int bj = 0; bj < 2; ++bj)
#pragma unroll
            for (int n = 0; n < 2; ++n) bv[bj][n] = *(const f32x4*)(bglu + col0 + bj * HALF + 4 * n);
#pragma unroll
        for (int ai = 0; ai < 2; ++ai)
#pragma unroll
            for (int m = 0; m < 4; ++m) {
                const size_t row = (size_t)u.pm * BM + ai * HALF + wr * 64 + m * 16 + fr;
#pragma unroll
                for (int bj = 0; bj < 2; ++bj) {
                    const int col = col0 + bj * HALF;
                    f32x4 y0, y1, g0, g1; unpack8(*(const u32x4*)(Y + row * 512 + col), y0, y1); unpack8(*(const u32x4*)(GS + row * 512 + col), g0, g1);
                    const f32x4 o0 = y0 * sigmoid4(acc[ai][bj][m][0] + bv[bj][0]) * g0, o1 = y1 * sigmoid4(acc[ai][bj][m][1] + bv[bj][1]) * g1;
                    *(u32x4*)(AS + row * 1536 + 1024 + col) = pack8(o0, o1);
                }
                asm volatile("" ::: "memory");
            }
    }
};

struct EpiMerged {
    static constexpr bool PERM = true, AFTER_DRAIN = false, HAS_MID = true;
    const bf16_t* GM; bf16_t* MG; int tmid;
    __device__ __forceinline__ void mid(f32x4 (&acc)[2][2][4][2], const Unit& u, int wr, int wc, int fr, int fq) const {
        unsigned opq = 0; asm volatile("" : "+v"(opq));
        const unsigned col0 = u.pn * BM + wc * 32 + 8 * fq + opq;
#pragma unroll
        for (int ai = 0; ai < 2; ++ai)
#pragma unroll
            for (int m = 0; m < 4; ++m) {
                const unsigned row = u.pm * BM + ai * HALF + wr * 64 + m * 16 + fr;
#pragma unroll
                for (int bj = 0; bj < 2; ++bj) {
                    const unsigned col = col0 + bj * HALF;
                    f32x4 a0, a1, s0, s1; unpack8(*(const u32x4*)(GM + (row * 4096u + col)), a0, a1); unpack8(*(const u32x4*)(GM + (row * 4096u + 2048u + col)), s0, s1);
#pragma unroll
                    for (int e = 0; e < 4; ++e) { acc[ai][bj][m][0][e] *= a0[e] * __builtin_amdgcn_rcpf(fmaxf(s0[e], 1e-30f)); acc[ai][bj][m][1][e] *= a1[e] * __builtin_amdgcn_rcpf(fmaxf(s1[e], 1e-30f)); }
                }
                asm volatile("" ::: "memory");
            }
    }
    __device__ __forceinline__ void operator()(const f32x4 (&acc)[2][2][4][2], const Unit& u, int wr, int wc, int fr, int fq) const {
        const int col0 = u.pn * BM + wc * 32 + 8 * fq;
#pragma unroll
        for (int ai = 0; ai < 2; ++ai)
#pragma unroll
            for (int m = 0; m < 4; ++m) {
                const size_t row = (size_t)u.pm * BM + ai * HALF + wr * 64 + m * 16 + fr;
#pragma unroll
                for (int bj = 0; bj < 2; ++bj) {
                    const int col = col0 + bj * HALF;
                    f32x4 s0, s1; unpack8(*(const u32x4*)(GM + row * 4096 + 2048 + col), s0, s1);
                    *(u32x4*)(MG + row * 2048 + col) = pack8(acc[ai][bj][m][0] * s0, acc[ai][bj][m][1] * s1);
                }
                asm volatile("" ::: "memory");
            }
    }
};

struct EpiOut {
    static constexpr bool PERM = false, AFTER_DRAIN = false, HAS_MID = false;
    const float *x, *mod, *bada; float* out; float* rowsq; int tmid;
    __device__ __forceinline__ void mid(f32x4 (&)[2][2][4][2], const Unit&, int, int, int, int) const {}
    __device__ __forceinline__ void operator()(const f32x4 (&acc)[2][2][4][2], const Unit& u, int wr, int wc, int fr, int fq) const {
        const int col0 = u.pn * BM + wc * 32 + 4 * fq, b = u.pm >> 3;
        f32x4 gv[2][2];
#pragma unroll
        for (int bj = 0; bj < 2; ++bj)
#pragma unroll
            for (int n = 0; n < 2; ++n) gv[bj][n] = *(const f32x4*)(mod + b * 6144 + 4096 + col0 + bj * HALF + n * 16) + *(const f32x4*)(bada + 4096 + col0 + bj * HALF + n * 16);
#pragma unroll
        for (int ai = 0; ai < 2; ++ai)
#pragma unroll
            for (int m = 0; m < 4; ++m) {
                const size_t row = (size_t)u.pm * BM + ai * HALF + wr * 64 + m * 16 + fr; float ss = 0.f;
#pragma unroll
                for (int bj = 0; bj < 2; ++bj)
#pragma unroll
                    for (int n = 0; n < 2; ++n) {
                        const size_t off = row * 2048 + col0 + bj * HALF + n * 16;
                        const f32x4 o = *(const f32x4*)(x + off) + gv[bj][n] * acc[ai][bj][m][n];
                        *(f32x4*)(out + off) = o; ss += (o[0] * o[0] + o[1] * o[1]) + (o[2] * o[2] + o[3] * o[3]);
                    }
                ss += __shfl_xor(ss, 16); ss += __shfl_xor(ss, 32);
                if (fq == 0) atomicAdd(rowsq + row, ss);
                asm volatile("" ::: "memory");
            }
    }
};
template <class Epi, class Sched, bool ALIGN_EPI = false, bool SP2 = false>
__device__ __forceinline__ void gemm_phase(PG8_LAS unsigned char* lds, const Gemm g, const Sched& S, const Epi& E, const int wid) {
    const int lane = lane_id_v(), tid = wid * 64 + lane, wr = wid >> 2, wc = wid & 3, fr = lane & 15, fq = lane >> 4;
    const int K = g.K, nt = K / BK;
    unsigned voffA[2], voffB[2];
#pragma unroll
    for (int i = 0; i < 2; ++i) { int R, C; stage_rc(tid * 16 + i * 8192, R, C); const int Rb = Epi::PERM ? ((R & ~31) + perm32(R & 31)) : R;
        voffA[i] = (unsigned)(R * K + C) * 2u; voffB[i] = (unsigned)(Rb * K + C) * 2u; }
    const size_t kstep = (size_t)(BK * 2);
    const size_t hstep = (size_t)HALF * K * 2;
    const size_t tstep = 2 * hstep;
    const unsigned ldsw = (unsigned)wid * 1024u;
    const int aoff = lds_byte(wr * 64 + fr, fq * 8), boff = lds_byte(wc * 32 + fr, fq * 8);
#define PG8_SA(b, h) (((b) * 2 + (h)) * HTB)
#define PG8_SB(b, h) ((4 + (b) * 2 + (h)) * HTB)
#define PG8_STAGE(bufoff, gbase, voff) do { _Pragma("unroll") for (int _i = 0; _i < 2; ++_i) \
        __builtin_amdgcn_global_load_lds((const unsigned*)((const char*)(gbase) + (voff)[_i]), (PG8_LAS unsigned*)(lds + (bufoff) + ldsw + _i * 8192), 16, 0, 0); } while (0)
#define PG8_LDA(dst, b, h) do { _Pragma("unroll") for (int m = 0; m < 4; ++m) _Pragma("unroll") for (int k = 0; k < 2; ++k) dst[m][k] = *(const PG8_LAS bf16x8*)(lds + PG8_SA(b, h) + aoff + m * 2048 + k * 1024); } while (0)
#define PG8_LDB(dst, b, h) do { _Pragma("unroll") for (int n = 0; n < 2; ++n) _Pragma("unroll") for (int k = 0; k < 2; ++k) dst[n][k] = *(const PG8_LAS bf16x8*)(lds + PG8_SB(b, h) + boff + n * 2048 + k * 1024); } while (0)
#define PG8_MMA(ai, bj, At, Bt) do { __builtin_amdgcn_s_setprio(1); _Pragma("unroll") for (int m = 0; m < 4; ++m) _Pragma("unroll") for (int n = 0; n < 2; ++n) _Pragma("unroll") for (int k = 0; k < 2; ++k) \
        acc[ai][bj][m][n] = __builtin_amdgcn_mfma_f32_16x16x32_bf16(Bt[n][k], At[m][k], acc[ai][bj][m][n], 0, 0, 0); __builtin_amdgcn_s_setprio(0); } while (0)
#define PG8_WAIT_V(n) asm volatile("s_waitcnt vmcnt(" #n ")" ::: "memory")
#define PG8_WAIT_L(n) asm volatile("s_waitcnt lgkmcnt(" #n ")" ::: "memory")
#define PG8_BAR __builtin_amdgcn_s_barrier()
#define PG8_SCHED __builtin_amdgcn_sched_barrier(0)
    Unit cur, nxt; int ui = 0;
    if (!S.next(0, cur)) return;
    f32x4 acc[2][2][4][2];
#pragma unroll
    for (int a = 0; a < 2; ++a)
#pragma unroll
        for (int b = 0; b < 2; ++b)
#pragma unroll
            for (int m = 0; m < 4; ++m)
#pragma unroll
                for (int n = 0; n < 2; ++n) acc[a][b][m][n] = (f32x4){0.f, 0.f, 0.f, 0.f};
    bf16x8 At[4][2], B0[2][2], B1[2][2];
    const char* cA = (const char*)g.A + (size_t)cur.pm * tstep; const char* cB = (const char*)g.Bt + (size_t)cur.pn * tstep;
    S.a_ready(cur);
    if constexpr (SP2) {
        PG8_STAGE(PG8_SB(0, 0), cB, voffB); PG8_STAGE(PG8_SB(0, 1), cB + hstep, voffB); PG8_STAGE(PG8_SA(0, 0), cA, voffA); PG8_STAGE(PG8_SA(0, 1), cA + hstep, voffA);
        if (wr == 1) PG8_BAR;
        PG8_WAIT_V(2); PG8_BAR;
        PG8_STAGE(PG8_SB(1, 0), cB + kstep, voffB); PG8_STAGE(PG8_SA(1, 0), cA + kstep, voffA); PG8_STAGE(PG8_SB(1, 1), cB + hstep + kstep, voffB);
        PG8_WAIT_V(6); PG8_BAR;
    } else {
        PG8_STAGE(PG8_SB(0, 0), cB, voffB); PG8_STAGE(PG8_SA(0, 0), cA, voffA); PG8_STAGE(PG8_SB(0, 1), cB + hstep, voffB); PG8_STAGE(PG8_SA(0, 1), cA + hstep, voffA);
        if (wr == 1) PG8_BAR;
        PG8_WAIT_V(4); PG8_BAR;
        PG8_STAGE(PG8_SB(1, 0), cB + kstep, voffB); PG8_STAGE(PG8_SA(1, 0), cA + kstep, voffA); PG8_STAGE(PG8_SB(1, 1), cB + hstep + kstep, voffB);
        PG8_WAIT_V(6); PG8_BAR;
    }
    for (;;) {
        const bool has_next = S.next(ui + 1, nxt);
        const char* nA = has_next ? (const char*)g.A + (size_t)nxt.pm * tstep : cA; const char* nB = has_next ? (const char*)g.Bt + (size_t)nxt.pn * tstep : cB;
        for (int t = 0; t < nt; t += 2) {
            const bool last = (t == nt - 2);
            const char* a1 = cA + (size_t)(t + 1) * kstep;
            const char* a2 = last ? nA : cA + (size_t)(t + 2) * kstep; const char* b2 = last ? nB : cB + (size_t)(t + 2) * kstep;
            const char* a3 = a2 + kstep; const char* b3 = b2 + kstep;
            if (last && has_next) S.a_ready(nxt);
            if constexpr (Epi::HAS_MID) { if (t == E.tmid) E.mid(acc, cur, wr, wc, fr, fq); }
            if constexpr (SP2) {
            PG8_LDB(B0, 0, 0); PG8_LDB(B1, 0, 1); PG8_SCHED; PG8_LDA(At, 0, 0); PG8_STAGE(PG8_SA(1, 1), a1 + hstep, voffA);
            PG8_WAIT_V(8); PG8_WAIT_L(0); PG8_BAR; PG8_MMA(0, 0, At, B0); PG8_MMA(0, 1, At, B1); PG8_BAR; PG8_SCHED;
            PG8_LDA(At, 0, 1); PG8_STAGE(PG8_SB(0, 0), b2, voffB); PG8_STAGE(PG8_SB(0, 1), b2 + hstep, voffB); PG8_STAGE(PG8_SA(0, 0), a2, voffA);
            PG8_WAIT_V(8); PG8_WAIT_L(0); PG8_BAR; PG8_MMA(1, 0, At, B0); PG8_MMA(1, 1, At, B1); PG8_BAR; PG8_SCHED;
            PG8_LDB(B0, 1, 0); PG8_LDB(B1, 1, 1); PG8_SCHED; PG8_LDA(At, 1, 0); PG8_STAGE(PG8_SA(0, 1), a2 + hstep, voffA);
            PG8_WAIT_V(8); PG8_WAIT_L(0); PG8_BAR; PG8_MMA(0, 0, At, B0); PG8_MMA(0, 1, At, B1); PG8_BAR; PG8_SCHED;
            PG8_LDA(At, 1, 1); PG8_STAGE(PG8_SB(1, 0), b3, voffB); PG8_STAGE(PG8_SB(1, 1), b3 + hstep, voffB); PG8_STAGE(PG8_SA(1, 0), a3, voffA);
            PG8_WAIT_V(8); PG8_WAIT_L(0); PG8_BAR; PG8_MMA(1, 0, At, B0); PG8_MMA(1, 1, At, B1); PG8_BAR; PG8_SCHED;
            } else {
            PG8_LDB(B0, 0, 0); PG8_SCHED; PG8_LDA(At, 0, 0); PG8_STAGE(PG8_SA(1, 1), a1 + hstep, voffA);
            PG8_WAIT_L(8); PG8_BAR; PG8_WAIT_L(0); PG8_MMA(0, 0, At, B0); PG8_BAR; PG8_SCHED;
            PG8_LDB(B1, 0, 1); PG8_STAGE(PG8_SB(0, 0), b2, voffB);
            PG8_BAR; PG8_WAIT_L(0); PG8_MMA(0, 1, At, B1); PG8_BAR;
            PG8_LDA(At, 0, 1); PG8_STAGE(PG8_SA(0, 0), a2, voffA);
            PG8_BAR; PG8_WAIT_L(0); PG8_MMA(1, 0, At, B0); PG8_BAR; PG8_SCHED;
            PG8_STAGE(PG8_SB(0, 1), b2 + hstep, voffB);
            PG8_WAIT_V(6); PG8_BAR; PG8_MMA(1, 1, At, B1); PG8_BAR;
            PG8_LDB(B0, 1, 0); PG8_SCHED; PG8_LDA(At, 1, 0); PG8_STAGE(PG8_SA(0, 1), a2 + hstep, voffA);
            PG8_WAIT_L(8); PG8_BAR; PG8_WAIT_L(0); PG8_MMA(0, 0, At, B0); PG8_BAR; PG8_SCHED;
            PG8_LDB(B1, 1, 1); PG8_STAGE(PG8_SB(1, 0), b3, voffB);
            PG8_BAR; PG8_WAIT_L(0); PG8_MMA(0, 1, At, B1); PG8_BAR;
            PG8_LDA(At, 1, 1); PG8_STAGE(PG8_SA(1, 0), a3, voffA);
            PG8_BAR; PG8_WAIT_L(0); PG8_MMA(1, 0, At, B0); PG8_BAR; PG8_SCHED;
            PG8_STAGE(PG8_SB(1, 1), b3 + hstep, voffB);
            PG8_WAIT_V(6); PG8_BAR; PG8_MMA(1, 1, At, B1); PG8_BAR;
            }
        }
        if constexpr (ALIGN_EPI) { if (wr == 0) PG8_BAR; }
        if constexpr (!Epi::AFTER_DRAIN) { E(acc, cur, wr, wc, fr, fq); S.done(cur); }
        if (!has_next) break;
#pragma unroll
        for (int a = 0; a < 2; ++a)
#pragma unroll
            for (int b = 0; b < 2; ++b)
#pragma unroll
                for (int m = 0; m < 4; ++m)
#pragma unroll
                    for (int n = 0; n < 2; ++n) acc[a][b][m][n] = (f32x4){0.f, 0.f, 0.f, 0.f};
        cur = nxt; cA = nA; cB = nB; ++ui;
        if constexpr (ALIGN_EPI) { if (wr == 1) PG8_BAR; }
    }
    PG8_WAIT_V(0);
    if constexpr (!ALIGN_EPI) { if (wr == 0) PG8_BAR; }
    PG8_BAR;
    if constexpr (Epi::AFTER_DRAIN) { E.fused(acc, cur, wr, wc, fr, fq, lds, wid, lane); S.done(cur); }
#undef PG8_SA
#undef PG8_SB
#undef PG8_STAGE
#undef PG8_LDA
#undef PG8_LDB
#undef PG8_MMA
#undef PG8_WAIT_V
#undef PG8_WAIT_L
#undef PG8_BAR
#undef PG8_SCHED
}
}

#ifndef PG8_SP2
#define PG8_SP2 true
#endif
#ifndef PG8_ALIGN
#define PG8_ALIGN true
#endif
#define GAS __attribute__((address_space(1)))
#define LAS __attribute__((address_space(3)))
typedef unsigned short bf16;
typedef unsigned v4u __attribute__((ext_vector_type(4)));
typedef float f32x4 __attribute__((ext_vector_type(4)));
typedef short bf16x8 __attribute__((ext_vector_type(8)));
typedef GAS unsigned gu32;
typedef GAS unsigned long long gu64;
#define RLX_AGENT __ATOMIC_RELAXED, __HIP_MEMORY_SCOPE_AGENT
#define LDS_WAIT() asm volatile("s_waitcnt lgkmcnt(0)" ::: "memory")
#define VM_WAIT() asm volatile("s_waitcnt vmcnt(0)" ::: "memory")
__device__ __forceinline__ unsigned long long rt() { return __builtin_amdgcn_s_memrealtime(); }
__device__ __forceinline__ unsigned f2bf(float f) { unsigned u = __builtin_bit_cast(unsigned, f); return (u + 0x7fffu + ((u >> 16) & 1u)) >> 16; }
__device__ __forceinline__ unsigned pk2(float lo, float hi) { return f2bf(lo) | (f2bf(hi) << 16); }

#define XB_TMO      128
#define XB_XCNT(j)  (256  + 64 * (j))
#define XB_XSUB(j)  (1280 + 64 * (j))
#define XB_XGEN(j)  (2304 + 64 * (j))
#define XB_TOP      3328
#define XB_TOPGEN   3392
#define XCD_BAR_WORDS 3456
#define XB_SPIN_CAP (1u << 18)

__device__ __forceinline__ unsigned xb_ld(unsigned* p)              { return __hip_atomic_load(p, __ATOMIC_RELAXED, __HIP_MEMORY_SCOPE_AGENT); }
__device__ __forceinline__ unsigned xb_add(unsigned* p, unsigned v) { return __hip_atomic_fetch_add(p, v, __ATOMIC_RELAXED, __HIP_MEMORY_SCOPE_AGENT); }
__device__ __forceinline__ unsigned xb_xcc_id() { return (unsigned)__builtin_amdgcn_s_getreg((3 << 11) | 20) & 0xFu; }
#define XB_SPIN(cond, bar) do { unsigned _sp = 0; while (cond) { __builtin_amdgcn_s_sleep(1); \
    if ((++_sp & 255u) == 0u) { if (xb_ld(&(bar)[XB_TMO])) break; if (_sp > XB_SPIN_CAP) { atomicAdd(&(bar)[XB_TMO], 1u); break; } } } } while (0)

struct XcdBarrier {
    unsigned* bar; unsigned x;
    volatile LAS unsigned* st;
};

__device__ __forceinline__ XcdBarrier xcd_barrier_post(unsigned* bar, volatile LAS unsigned* st) {
    XcdBarrier b; b.bar = bar; b.x = xb_xcc_id(); b.st = st;
    if (threadIdx.x == 0) (void)xb_add(&bar[XB_XCNT(b.x)], 1u);
    return b;
}
__device__ __forceinline__ void xcd_barrier_complete(unsigned* bar, unsigned x, unsigned& nloc, unsigned& nx) {
    const unsigned G = gridDim.x * gridDim.y * gridDim.z;
    unsigned sum, cnt, mine, sp = 0u;
    for (;;) {
        sum = 0u; cnt = 0u; mine = 0u;
#pragma unroll
        for (unsigned j = 0; j < 16; ++j) { const unsigned c = xb_ld(&bar[XB_XCNT(j)]); sum += c; cnt += (c > 0u) ? 1u : 0u; mine = (j == x) ? c : mine; }
        if (sum == G) break;
        __builtin_amdgcn_s_sleep(1);
        if ((++sp & 255u) == 0u) { if (xb_ld(&bar[XB_TMO])) break; if (sp > XB_SPIN_CAP) { atomicAdd(&bar[XB_TMO], 1u); break; } }
    }
    nloc = mine > 0u ? mine : 1u; nx = cnt > 0u ? cnt : 1u;
}

__device__ __forceinline__ void xcd_barrier(const XcdBarrier& b, const int wave) {
    asm volatile("s_waitcnt vmcnt(0)" ::: "memory");
    __syncthreads();
    if (wave == 0 && pg8::lane_id_v() == 0) {
        unsigned* bar = b.bar;
        __builtin_amdgcn_s_waitcnt(0);
        unsigned nloc = b.st[0], nx = b.st[1];
        if (nloc == 0u) { xcd_barrier_complete(bar, b.x, nloc, nx); b.st[0] = nloc; b.st[1] = nx; }
        const unsigned old = xb_add(&bar[XB_XSUB(b.x)], 1u);
        const unsigned gen = old / nloc;
        if (old + 1u == (gen + 1u) * nloc) {
            __builtin_amdgcn_fence(__ATOMIC_RELEASE, "agent");
            asm volatile("s_waitcnt vmcnt(0)" ::: "memory");
            const unsigned og = xb_add(&bar[XB_TOP], 1u);
            const unsigned tg = og / nx;
            if (og + 1u == (tg + 1u) * nx) xb_add(&bar[XB_TOPGEN], 1u);
            else XB_SPIN(xb_ld(&bar[XB_TOPGEN]) == tg, bar);
            __builtin_amdgcn_fence(__ATOMIC_ACQUIRE, "agent");
            xb_add(&bar[XB_XGEN(b.x)], 1u);
            asm volatile("s_waitcnt vmcnt(0)" ::: "memory");
        } else {
            XB_SPIN(xb_ld(&bar[XB_XGEN(b.x)]) == gen, bar);
            __builtin_amdgcn_fence(__ATOMIC_ACQUIRE, "agent");
            asm volatile("s_waitcnt vmcnt(0)" ::: "memory");
        }
    }
    __syncthreads();
}


constexpr int NWAVES = 8;
#ifndef MK_PER_PHASE
#define MK_PER_PHASE 0
#endif

constexpr int BATCH = 8, SEQ = 2048, DM = 2048, CTXL = 256;
constexpr int MLAT = BATCH * SEQ, MCTX = BATCH * CTXL, MALL = MLAT + MCTX;
constexpr int INW = 9216, KVROWS = SEQ + CTXL;
constexpr float NORM_EPS = 1e-6f, LAM_INIT = 0.2f;
constexpr float QSCALE = 0.125f * 1.4426950408889634f;

constexpr int RING_BYTES = 131072;
constexpr int LDSCTL_OFF = RING_BYTES, MISC_OFF = LDSCTL_OFF + 320;
constexpr int LDS_BYTES = 147456;

struct Args { const float* in[27]; float* out; unsigned char* ws; int ph_lo, ph_hi, li, pad; };
enum In { I_X = 0, I_C, I_CTX, I_CCTX, I_WADA, I_BADA, I_NORMG, I_WIN, I_LQ1, I_LK1, I_LQ2, I_LK2, I_SUBLN, I_LRE, I_LIM, I_LSTEP, I_BRE, I_BIM, I_CRE, I_CIM, I_SSMD, I_WGLU, I_BGLU, I_WPA, I_WPS, I_WOUT, I_FING };

__device__ __forceinline__ float wave_sum(float v) {
#pragma unroll
    for (int o = 1; o < 64; o <<= 1) v += __shfl_xor(v, o);
    return v;
}
using pg8::bf_lo; using pg8::bf_hi; using pg8::unpack8; using pg8::pack8; using pg8::sigmoid_f;
typedef pg8::u32x4 u32x4;

__device__ __forceinline__ void p0_transpose_item(const float* W, int N, bf16* WT, int dpitch, int dcol, LAS float* scr, int item, int lane) {
    const int nblk = N / 32, kb = item / nblk, nb = item % nblk, k0 = 64 * kb, n0 = 32 * nb;
#pragma unroll 8
    for (int i = 0; i < 32; ++i) { const int kk = 2 * i + (lane >> 5); scr[kk * 33 + (lane & 31)] = W[(size_t)(k0 + kk) * N + n0 + (lane & 31)]; }
    LDS_WAIT(); asm volatile("" ::: "memory");
    const int c = lane & 7;
#pragma unroll
    for (int j = 0; j < 4; ++j) { const int n = (lane >> 3) + 8 * j; const LAS float* s = scr + (8 * c) * 33 + n;
        v4u o; o.x = pk2(s[0 * 33], s[1 * 33]); o.y = pk2(s[2 * 33], s[3 * 33]); o.z = pk2(s[4 * 33], s[5 * 33]); o.w = pk2(s[6 * 33], s[7 * 33]);
        *(GAS v4u*)(WT + (size_t)(n0 + n) * dpitch + dcol + k0 + 8 * c) = o; }
    LDS_WAIT(); asm volatile("" ::: "memory");
}

__device__ __forceinline__ void p0_prologue(const Args& a, LAS unsigned char* lds, int vcu, int G, int wave, int lane) {
    unsigned char* ws = a.ws;
    const int gw = vcu * NWAVES + wave, NGW = G * NWAVES;
    {
        float* mod = (float*)(ws + WS_CTL + CTL_MOD);
        const float* wada = a.in[I_WADA]; const float* cc = a.in[I_C]; const float* cctx = a.in[I_CCTX];
        for (int it = gw; it < 1536; it += NGW) {
            const int kc = it / 24, nc = it % 24, k0 = kc * 32, n0 = nc * 256 + 4 * lane;
            f32x4 acc[9];
#pragma unroll
            for (int r = 0; r < 9; ++r) acc[r] = (f32x4){0.f, 0.f, 0.f, 0.f};
            for (int kk = 0; kk < 32; ++kk) {
                const f32x4 w = *(const f32x4*)(wada + (size_t)(k0 + kk) * 6144 + n0);
#pragma unroll
                for (int r = 0; r < 9; ++r) { const float cv = (r < 8) ? cc[r * 2048 + k0 + kk] : cctx[k0 + kk]; const float s = cv * sigmoid_f(cv); acc[r] += w * s; }
            }
#pragma unroll
            for (int r = 0; r < 9; ++r)
#pragma unroll
                for (int e = 0; e < 4; ++e) atomicAdd(mod + r * 6144 + n0 + e, acc[r][e]);
        }
    }
    {
        LAS float* scr = (LAS float*)(lds + wave * 16384);
        constexpr int I_IN = (2048 / 64) * (9216 / 32), I_PA = (1024 / 64) * (2048 / 32), I_PS = (512 / 64) * (2048 / 32), I_OUT = (2048 / 64) * (2048 / 32), I_GLU = (512 / 64) * (512 / 32);
        constexpr int NITEMS = I_IN + I_PA + I_PS + I_OUT + I_GLU;
        for (int it = gw; it < NITEMS; it += NGW) {
            int r = it;
            if (r < I_IN) { p0_transpose_item(a.in[I_WIN], 9216, (bf16*)(ws + WS_WIN), 2048, 0, scr, r, lane); continue; } r -= I_IN;
            if (r < I_PA) { p0_transpose_item(a.in[I_WPA], 2048, (bf16*)(ws + WS_WCAT), 1536, 0, scr, r, lane); continue; } r -= I_PA;
            if (r < I_PS) { p0_transpose_item(a.in[I_WPS], 2048, (bf16*)(ws + WS_WCAT), 1536, 1024, scr, r, lane); continue; } r -= I_PS;
            if (r < I_OUT) { p0_transpose_item(a.in[I_WOUT], 2048, (bf16*)(ws + WS_WOUT), 2048, 0, scr, r, lane); continue; } r -= I_OUT;
            p0_transpose_item(a.in[I_WGLU], 512, (bf16*)(ws + WS_WGLU), 512, 0, scr, r, lane);
        }
    }
    const int gt = gw * 64 + lane;
    if (gt < 1024) {
        const int pos = gt >> 4, i = gt & 15;
        const float inv = exp2f(-(float)i * 0.8304820237218406f);
        const float ang = (float)pos * inv;
        float* rc = (float*)(ws + WS_ROPE); rc[gt] = cosf(ang); rc[1024 + gt] = sinf(ang);
    }
    if (gt >= 4096 && gt < 8192) {
        const int idx = gt - 4096, dg = idx >> 6;
        const float lre = a.in[I_LRE][idx], lim = a.in[I_LIM][idx], dt = expf(a.in[I_LSTEP][dg]);
        const float mag = expf(lre * dt), ar = mag * cosf(lim * dt), ai = mag * sinf(lim * dt);
        const float den = lre * lre + lim * lim;
        const float fr = ((ar - 1.0f) * lre + ai * lim) / den, fi = (ai * lre - (ar - 1.0f) * lim) / den;
        float* P = (float*)(ws + WS_SSMP);
        P[idx] = ar; P[4096 + idx] = ai;
        const float* br = a.in[I_BRE] + (size_t)idx * 16; const float* bi = a.in[I_BIM] + (size_t)idx * 16;
#pragma unroll
        for (int c = 0; c < 16; ++c) { P[8192 + idx * 16 + c] = fr * br[c] - fi * bi[c]; P[8192 + 65536 + idx * 16 + c] = fr * bi[c] + fi * br[c]; }
    }
}

__device__ __forceinline__ void p1_xn(const Args& a, int vcu, int G, int wave, int lane) {
    unsigned char* ws = a.ws;
    const int gw = vcu * NWAVES + wave, NGW = G * NWAVES;
    const float* mod = (const float*)(ws + WS_CTL + CTL_MOD); const float* bada = a.in[I_BADA]; const float* ng = a.in[I_NORMG];
    bf16* XN = (bf16*)(ws + WS_XN);
    for (int m = gw; m < MALL; m += NGW) {
        const float* src = m < MLAT ? a.in[I_X] + (size_t)m * DM : a.in[I_CTX] + (size_t)(m - MLAT) * DM;
        const int mr = m < MLAT ? (m >> 11) : 8;
        const f32x4* xr = (const f32x4*)src + lane;
        f32x4 v[8]; float s = 0.f;
#pragma unroll
        for (int j = 0; j < 8; ++j) { v[j] = xr[64 * j]; s += (v[j][0] * v[j][0] + v[j][1] * v[j][1]) + (v[j][2] * v[j][2] + v[j][3] * v[j][3]); }
        const float rstd = 1.0f / sqrtf(wave_sum(s) * (1.0f / DM) + NORM_EPS);
        unsigned long long* o8 = (unsigned long long*)(XN + (size_t)m * DM) + lane;
#pragma unroll
        for (int j = 0; j < 8; ++j) {
            const int col = 4 * lane + 256 * j;
            const f32x4 sh = *(const f32x4*)(mod + mr * 6144 + col) + *(const f32x4*)(bada + col);
            const f32x4 sc = *(const f32x4*)(mod + mr * 6144 + 2048 + col) + *(const f32x4*)(bada + 2048 + col);
            const f32x4 g = *(const f32x4*)(ng + col);
            const f32x4 h = (v[j] * rstd) * g * (sc + 1.0f) + sh;
            o8[64 * j] = (unsigned long long)pg8::cvt_pk_bf16(h[0], h[1]) | ((unsigned long long)pg8::cvt_pk_bf16(h[2], h[3]) << 32);
        }
    }
}

struct InProjOrder {
    pg8::StaticOrder so; int G, c;
    __device__ __forceinline__ void init(int G_, int c_) { so.init(MLAT, INW, G_, c_); G = G_; c = c_; }
    __device__ __forceinline__ bool next(int i, pg8::Unit& u) const {
        const long L = (long)i * G + c;
        if (L < 2304) return so.next(i, u);
        const int j = (int)(L - 2304); if (j >= 80) return false;
        const int jj = j % 10; u.pm = 64 + j / 10; u.pn = jj < 8 ? 4 + jj : 8 + jj; return true;
    }
    __device__ __forceinline__ void a_ready(const pg8::Unit&) const {}
    __device__ __forceinline__ void done(const pg8::Unit&) const {}
};

__device__ __forceinline__ void p3_attn_naive(const Args& a, int vcu, int G, int wave, int lane) {
    unsigned char* ws = a.ws;
    const int gw = vcu * NWAVES + wave, NGW = G * NWAVES;
    const bf16* Q = (const bf16*)(ws + WS_Q); const bf16* KALL = (const bf16*)(ws + WS_KALL); const bf16* VALL = (const bf16*)(ws + WS_VALL);
    for (int it = gw; it < 8192; it += NGW) {
        const int qblk = it & 63, s = (it >> 6) & 1, h = (it >> 7) & 7, b = it >> 10;
        const int r = lane & 31, vh = lane >> 5;
        const size_t tok = (size_t)b * SEQ + qblk * 32 + r;
        float q[64];
        { const u32x4* qp = (const u32x4*)(Q + tok * 1024 + h * 128 + s * 64);
#pragma unroll
          for (int j = 0; j < 8; ++j) { const u32x4 w = qp[j]; q[8 * j] = bf_lo(w.x); q[8 * j + 1] = bf_hi(w.x); q[8 * j + 2] = bf_lo(w.y); q[8 * j + 3] = bf_hi(w.y); q[8 * j + 4] = bf_lo(w.z); q[8 * j + 5] = bf_hi(w.z); q[8 * j + 6] = bf_lo(w.w); q[8 * j + 7] = bf_hi(w.w); } }
        const bf16* Kp = KALL + (size_t)b * KVROWS * 1024 + h * 128 + s * 64;
        const bf16* Vp = VALL + (size_t)b * KVROWS * 1024 + h * 128 + vh * 64;
        float mx = -3.0e38f;
        for (int key = 0; key < KVROWS; ++key) {
            const u32x4* kr = (const u32x4*)(Kp + (size_t)key * 1024); float sc = 0.f;
#pragma unroll
            for (int j = 0; j < 8; ++j) { const u32x4 w = kr[j];
                sc += q[8 * j] * bf_lo(w.x) + q[8 * j + 1] * bf_hi(w.x) + q[8 * j + 2] * bf_lo(w.y) + q[8 * j + 3] * bf_hi(w.y) + q[8 * j + 4] * bf_lo(w.z) + q[8 * j + 5] * bf_hi(w.z) + q[8 * j + 6] * bf_lo(w.w) + q[8 * j + 7] * bf_hi(w.w); }
            mx = fmaxf(mx, sc);
        }
        float l = 0.f, o[64];
#pragma unroll
        for (int e = 0; e < 64; ++e) o[e] = 0.f;
        for (int key = 0; key < KVROWS; ++key) {
            const u32x4* kr = (const u32x4*)(Kp + (size_t)key * 1024); float sc = 0.f;
#pragma unroll
            for (int j = 0; j < 8; ++j) { const u32x4 w = kr[j];
                sc += q[8 * j] * bf_lo(w.x) + q[8 * j + 1] * bf_hi(w.x) + q[8 * j + 2] * bf_lo(w.y) + q[8 * j + 3] * bf_hi(w.y) + q[8 * j + 4] * bf_lo(w.z) + q[8 * j + 5] * bf_hi(w.z) + q[8 * j + 6] * bf_lo(w.w) + q[8 * j + 7] * bf_hi(w.w); }
            const float p = exp2f(sc - mx); l += p;
            const u32x4* vr = (const u32x4*)(Vp + (size_t)key * 1024);
#pragma unroll
            for (int j = 0; j < 8; ++j) { const u32x4 w = vr[j];
                o[8 * j] += p * bf_lo(w.x); o[8 * j + 1] += p * bf_hi(w.x); o[8 * j + 2] += p * bf_lo(w.y); o[8 * j + 3] += p * bf_hi(w.y); o[8 * j + 4] += p * bf_lo(w.z); o[8 * j + 5] += p * bf_hi(w.z); o[8 * j + 6] += p * bf_lo(w.w); o[8 * j + 7] += p * bf_hi(w.w); }
        }
        const float rl = 1.0f / l;
        u32x4* op = (u32x4*)((bf16*)(ws + (s ? WS_O2 : WS_O1)) + tok * 1024 + h * 128 + vh * 64);
#pragma unroll
        for (int j = 0; j < 8; ++j) { u32x4 w; w.x = pg8::cvt_pk_bf16(o[8 * j] * rl, o[8 * j + 1] * rl); w.y = pg8::cvt_pk_bf16(o[8 * j + 2] * rl, o[8 * j + 3] * rl); w.z = pg8::cvt_pk_bf16(o[8 * j + 4] * rl, o[8 * j + 5] * rl); w.w = pg8::cvt_pk_bf16(o[8 * j + 6] * rl, o[8 * j + 7] * rl); op[j] = w; }
    }
}

__device__ __forceinline__ void p4_combine(const Args& a, int vcu, int G, int wave, int lane) {
    unsigned char* ws = a.ws;
    const int gw = vcu * NWAVES + wave, NGW = G * NWAVES;
    const float l1 = wave_sum(a.in[I_LQ1][lane] * a.in[I_LK1][lane]), l2 = wave_sum(a.in[I_LQ2][lane] * a.in[I_LK2][lane]);
    const float lam = expf(l1) - expf(l2) + LAM_INIT;
    const bf16* O1 = (const bf16*)(ws + WS_O1); const bf16* O2 = (const bf16*)(ws + WS_O2); const bf16* GA = (const bf16*)(ws + WS_GA); bf16* AS = (bf16*)(ws + WS_AS);
    const int col = 16 * lane;
    f32x4 sg[4];
#pragma unroll
    for (int j = 0; j < 4; ++j) sg[j] = *(const f32x4*)(a.in[I_SUBLN] + (col & 127) + 4 * j) * (1.0f - LAM_INIT);
    for (int tok = gw; tok < MLAT; tok += NGW) {
        f32x4 o[4], p[4], g[4];
        unpack8(*(const u32x4*)(O1 + (size_t)tok * 1024 + col), o[0], o[1]); unpack8(*(const u32x4*)(O1 + (size_t)tok * 1024 + col + 8), o[2], o[3]);
        unpack8(*(const u32x4*)(O2 + (size_t)tok * 1024 + col), p[0], p[1]); unpack8(*(const u32x4*)(O2 + (size_t)tok * 1024 + col + 8), p[2], p[3]);
        unpack8(*(const u32x4*)(GA + (size_t)tok * 1024 + col), g[0], g[1]); unpack8(*(const u32x4*)(GA + (size_t)tok * 1024 + col + 8), g[2], g[3]);
        float ss = 0.f;
#pragma unroll
        for (int j = 0; j < 4; ++j) { o[j] = o[j] - p[j] * lam; ss += (o[j][0] * o[j][0] + o[j][1] * o[j][1]) + (o[j][2] * o[j][2] + o[j][3] * o[j][3]); }
        ss += __shfl_xor(ss, 1); ss += __shfl_xor(ss, 2); ss += __shfl_xor(ss, 4);
        const float rs = 1.0f / sqrtf(ss * (1.0f / 128.0f) + NORM_EPS);
#pragma unroll
        for (int j = 0; j < 4; ++j) o[j] = o[j] * rs * sg[j] * g[j];
        *(u32x4*)(AS + (size_t)tok * 1536 + col) = pack8(o[0], o[1]); *(u32x4*)(AS + (size_t)tok * 1536 + col + 8) = pack8(o[2], o[3]);
    }
}

__device__ __forceinline__ void p5_ssm_naive(const Args& a, int vcu, int G, int wave, int lane) {
    unsigned char* ws = a.ws;
    const int gw = vcu * NWAVES + wave, NGW = G * NWAVES;
    const float* P = (const float*)(ws + WS_SSMP); const bf16* UCH = (const bf16*)(ws + WS_UCH);
    for (int it = gw; it < 512; it += NGW) {
        const int dir = it & 1, g = (it >> 1) & 31, b = it >> 6;
        const int idx = (dir * 32 + g) * 64 + lane;
        const float ar = P[idx], ai = P[4096 + idx];
        float bbr[16], bbi[16], cr[16], ci[16];
#pragma unroll
        for (int c = 0; c < 16; ++c) { bbr[c] = P[8192 + idx * 16 + c]; bbi[c] = P[8192 + 65536 + idx * 16 + c];
            cr[c] = a.in[I_CRE][((dir * 32 + g) * 16 + c) * 64 + lane]; ci[c] = a.in[I_CIM][((dir * 32 + g) * 16 + c) * 64 + lane]; }
        float* YD = (float*)(ws + (dir ? WS_YB : WS_YF));
        float hr = 0.f, hi = 0.f;
        for (int step = 0; step < KVROWS; ++step) {
            const bool isctx = step < CTXL; const int tt = isctx ? step : step - CTXL;
            const int t = dir ? ((isctx ? CTXL - 1 : SEQ - 1) - tt) : tt;
            const int R = isctx ? 1024 + b * 16 + (t >> 4) : b * 128 + (t >> 4), tl = t & 15;
            const u32x4* up = (const u32x4*)(UCH + ((size_t)(g * 1280 + R) * 256 + tl * 16));
            f32x4 u0, u1, u2, u3; unpack8(up[0], u0, u1); unpack8(up[1], u2, u3);
            float bur = 0.f, bui = 0.f;
#pragma unroll
            for (int e = 0; e < 4; ++e) { bur += bbr[e] * u0[e] + bbr[4 + e] * u1[e] + bbr[8 + e] * u2[e] + bbr[12 + e] * u3[e]; bui += bbi[e] * u0[e] + bbi[4 + e] * u1[e] + bbi[8 + e] * u2[e] + bbi[12 + e] * u3[e]; }
            const float nhr = ar * hr - ai * hi + bur, nhi = ar * hi + ai * hr + bui; hr = nhr; hi = nhi;
            if (!isctx) {
                float yv = 0.f;
#pragma unroll
                for (int c = 0; c < 16; ++c) { const float v = wave_sum(cr[c] * hr - ci[c] * hi); if (lane == c) yv = v; }
                if (lane < 16) YD[((size_t)b * SEQ + t) * 512 + g * 16 + lane] = yv;
            }
        }
    }
}

__device__ __forceinline__ float gelu_tanh(float x) {
    const float z = 0.7978845608028654f * (x + 0.044715f * x * x * x);
    const float th = 1.0f - 2.0f * __builtin_amdgcn_rcpf(1.0f + __builtin_amdgcn_exp2f(2.8853900817779268f * z));
    return 0.5f * x * (1.0f + th);
}
__device__ __forceinline__ void p6_ycombine(const Args& a, int vcu, int G, int wave, int lane) {
    unsigned char* ws = a.ws;
    const int gt = (vcu * NWAVES + wave) * 64 + lane, NGT = G * NWAVES * 64;
    const float* YF = (const float*)(ws + WS_YF); const float* YB = (const float*)(ws + WS_YB); const bf16* UCH = (const bf16*)(ws + WS_UCH); bf16* Y = (bf16*)(ws + WS_Y);
    for (int i = gt; i < MLAT * 64; i += NGT) {
        const int tok = i >> 6, c8 = (i & 63) * 8, g = c8 >> 4, c0 = c8 & 15, b = tok >> 11, t = tok & 2047, R = b * 128 + (t >> 4), tl = t & 15;
        f32x4 u0, u1; unpack8(*(const u32x4*)(UCH + ((size_t)(g * 1280 + R) * 256 + tl * 16 + c0)), u0, u1);
        const f32x4 d0 = *(const f32x4*)(a.in[I_SSMD] + g * 16 + c0), d1 = *(const f32x4*)(a.in[I_SSMD] + g * 16 + c0 + 4);
        f32x4 y0 = *(const f32x4*)(YF + (size_t)tok * 512 + c8) + *(const f32x4*)(YB + (size_t)tok * 512 + c8) + d0 * u0;
        f32x4 y1 = *(const f32x4*)(YF + (size_t)tok * 512 + c8 + 4) + *(const f32x4*)(YB + (size_t)tok * 512 + c8 + 4) + d1 * u1;
#pragma unroll
        for (int e = 0; e < 4; ++e) { y0[e] = gelu_tanh(y0[e]); y1[e] = gelu_tanh(y1[e]); }
        *(u32x4*)(Y + (size_t)tok * 512 + c8) = pack8(y0, y1);
    }
}

__device__ __forceinline__ void p10_final(const Args& a, int vcu, int G, int wave, int lane) {
    const int gw = vcu * NWAVES + wave, NGW = G * NWAVES;
    const float* rowsq = (const float*)(a.ws + WS_CTL + CTL_ROWSQ); const float* fg = a.in[I_FING];
    for (int m = gw; m < MLAT; m += NGW) {
        const float rstd = 1.0f / sqrtf(rowsq[m] * (1.0f / DM) + NORM_EPS);
        f32x4* o = (f32x4*)(a.out + (size_t)m * DM) + lane;
#pragma unroll
        for (int j = 0; j < 8; ++j) { const f32x4 g = *(const f32x4*)(fg + 4 * lane + 256 * j); o[64 * j] = o[64 * j] * rstd * g; }
    }
}

constexpr int N_PHASES = 11;
__global__ void __launch_bounds__(NWAVES * 64, 2) skel_fwd(Args args) {
    extern __shared__ __attribute__((aligned(16))) unsigned char lds_raw[];
    LAS unsigned char* lds = (LAS unsigned char*)lds_raw;
    volatile LAS unsigned* MISC = (volatile LAS unsigned*)(lds + MISC_OFF);
    const int tid = threadIdx.x, wave = __builtin_amdgcn_readfirstlane(tid >> 6);
    const int G = gridDim.x; const int bx = blockIdx.x; const int vcu = (G % 8 == 0) ? (bx % 8) * (G / 8) + bx / 8 : bx;
    unsigned char* ws = args.ws;
    gu32* ctl = (gu32*)(ws + WS_CTL);
    for (int u = tid; u < (LDS_BYTES - LDSCTL_OFF) / 4; u += NWAVES * 64) ((LAS unsigned*)(lds + LDSCTL_OFF))[u] = 0u;
    __syncthreads();
    XcdBarrier bar; bar.bar = (unsigned*)(ctl + CW_BAR); bar.x = 0; bar.st = nullptr;
    if (!MK_PER_PHASE) bar = xcd_barrier_post((unsigned*)(ctl + CW_BAR), MISC + 8);
    const int lo = args.ph_lo, hi = args.ph_hi;
#ifndef ONLY_PHASE
#define ONLY_PHASE -1
#endif
#define IN(k) ((ONLY_PHASE < 0 || ONLY_PHASE == (k)) && lo <= (k) && (k) < hi)
#define SEAM(k) do { if (IN(k) && IN((k) + 1)) xcd_barrier(bar, wave); } while (0)

    if (IN(0)) { const int ln = pg8::lane_id_v(); p0_prologue(args, lds, vcu, G, wave, ln); } SEAM(0);
    if (IN(1)) { const int ln = pg8::lane_id_v(); p1_xn(args, vcu, G, wave, ln); } SEAM(1);
    if (IN(2)) {
        pg8::Gemm g{(const pg8::bf16_t*)(ws + WS_XN), (const pg8::bf16_t*)(ws + WS_WIN), MALL, INW, DM};
        InProjOrder S; S.init(G, bx);
        pg8::EpiInProj E{ws, QSCALE, -1};
        pg8::gemm_phase<pg8::EpiInProj, InProjOrder, PG8_ALIGN, PG8_SP2>(lds, g, S, E, wave);
    } SEAM(2);
    if (IN(3)) { const int ln = pg8::lane_id_v(); p3_attn_naive(args, vcu, G, wave, ln); } SEAM(3);
    if (IN(4)) { const int ln = pg8::lane_id_v(); p4_combine(args, vcu, G, wave, ln); } SEAM(4);
    if (IN(5)) { const int ln = pg8::lane_id_v(); p5_ssm_naive(args, vcu, G, wave, ln); } SEAM(5);
    if (IN(6)) { const int ln = pg8::lane_id_v(); p6_ycombine(args, vcu, G, wave, ln); } SEAM(6);
    if (IN(7)) {
        pg8::Gemm g{(const pg8::bf16_t*)(ws + WS_Y), (const pg8::bf16_t*)(ws + WS_WGLU), MLAT, 512, 512};
        pg8::StaticOrder S; S.init(MLAT, 512, G, bx);
        pg8::EpiGlu E{(const pg8::bf16_t*)(ws + WS_Y), (const pg8::bf16_t*)(ws + WS_GS), args.in[I_BGLU], (pg8::bf16_t*)(ws + WS_AS), -1};
        pg8::gemm_phase<pg8::EpiGlu, pg8::StaticOrder, PG8_ALIGN, PG8_SP2>(lds, g, S, E, wave);
    } SEAM(7);
    if (IN(8)) {
        pg8::Gemm g{(const pg8::bf16_t*)(ws + WS_AS), (const pg8::bf16_t*)(ws + WS_WCAT), MLAT, DM, 1536};
        pg8::StaticOrder S; S.init(MLAT, DM, G, bx);
        pg8::EpiMerged E{(const pg8::bf16_t*)(ws + WS_GM), (pg8::bf16_t*)(ws + WS_MG), 16};
        pg8::gemm_phase<pg8::EpiMerged, pg8::StaticOrder, PG8_ALIGN, PG8_SP2>(lds, g, S, E, wave);
    } SEAM(8);
    if (IN(9)) {
        pg8::Gemm g{(const pg8::bf16_t*)(ws + WS_MG), (const pg8::bf16_t*)(ws + WS_WOUT), MLAT, DM, DM};
        pg8::StaticOrder S; S.init(MLAT, DM, G, bx);
        pg8::EpiOut E{args.in[I_X], (const float*)(ws + WS_CTL + CTL_MOD), args.in[I_BADA], args.out, (float*)(ws + WS_CTL + CTL_ROWSQ), -1};
        pg8::gemm_phase<pg8::EpiOut, pg8::StaticOrder, PG8_ALIGN, PG8_SP2>(lds, g, S, E, wave);
    } SEAM(9);
    if (IN(10)) { const int ln = pg8::lane_id_v(); p10_final(args, vcu, G, wave, ln); }
#undef IN
#undef SEAM
}

extern "C" void kernel_launch(void* const* d_in, const int* in_sizes, int n_in, void* d_out, int out_size, void* d_ws, size_t ws_size, hipStream_t stream) {
    static int grid = 0;
    if (grid == 0) {
        if (n_in != 27 || out_size != MLAT * DM || ws_size < WS_END) { fprintf(stderr, "kernel_launch: unexpected shapes (n_in %d, out %d, ws %zu); nothing launched\n", n_in, out_size, ws_size); grid = -1; return; }
        int dev = 0, cus = 0, per_cu = 0;
        if (hipGetDevice(&dev) != hipSuccess || hipDeviceGetAttribute(&cus, hipDeviceAttributeMultiprocessorCount, dev) != hipSuccess) { grid = -1; return; }
        if (hipFuncSetAttribute((const void*)skel_fwd, hipFuncAttributeMaxDynamicSharedMemorySize, LDS_BYTES) != hipSuccess) { fprintf(stderr, "kernel_launch: hipFuncSetAttribute failed\n"); grid = -1; return; }
        if (hipOccupancyMaxActiveBlocksPerMultiprocessor(&per_cu, (const void*)skel_fwd, NWAVES * 64, LDS_BYTES) != hipSuccess || per_cu < 1) { fprintf(stderr, "kernel_launch: occupancy query says %d blocks per CU\n", per_cu); }
        (void)hipGetLastError();
        grid = cus;
    }
    if (grid < 0) return;
    if (hipMemsetAsync((char*)d_ws + WS_CTL, 0, CTL_ZERO_BYTES, stream) != hipSuccess) { fprintf(stderr, "kernel_launch: hipMemsetAsync failed\n"); return; }
    Args a{};
    for (int i = 0; i < 27; ++i) a.in[i] = (const float*)d_in[i];
    a.out = (float*)d_out; a.ws = (unsigned char*)d_ws;
#if MK_PER_PHASE
    for (int p = 0; p < N_PHASES; ++p) { a.ph_lo = p; a.ph_hi = p + 1; a.li = 0; hipLaunchKernelGGL(skel_fwd, dim3(grid), dim3(NWAVES * 64), LDS_BYTES, stream, a); }
#else
    a.ph_lo = 0; a.ph_hi = N_PHASES; a.li = 0;
    hipLaunchKernelGGL(skel_fwd, dim3(grid), dim3(NWAVES * 64), LDS_BYTES, stream, a);
#endif
    const hipError_t le = hipPeekAtLastError();
    if (le != hipSuccess) fprintf(stderr, "kernel_launch: launch failed: %s\n", hipGetErrorName(le));
}
```

```cpp
#include <hip/hip_runtime.h>
#include <hip/hip_bf16.h>
#include <cstdio>
#include <cstdint>
#include <cmath>

constexpr size_t MiB = 1u << 20;
constexpr size_t WS_CTL = 0, CTL_ZERO_BYTES = 1 * MiB;
constexpr int CW_BAR = 4096;
constexpr size_t CTL_MOD = 262144, CTL_ROWSQ = 524288;
constexpr size_t WS_WIN = 2 * MiB;
constexpr size_t WS_WCAT = 38 * MiB;
constexpr size_t WS_WOUT = 44 * MiB;
constexpr size_t WS_WGLU = 52 * MiB;
constexpr size_t WS_ROPE = 52 * MiB + 512 * 1024;
constexpr size_t WS_SSMP = 53 * MiB;
constexpr size_t WS_SSMM = 54 * MiB;
constexpr size_t WS_UCH = 70 * MiB;
constexpr size_t WS_GS = 90 * MiB;
constexpr size_t WS_GA = 106 * MiB;
constexpr size_t WS_Q = 138 * MiB;
constexpr size_t WS_KALL = 170 * MiB;
constexpr size_t WS_VALL = 206 * MiB;
constexpr size_t WS_GM = 242 * MiB;
constexpr size_t WS_XN = 370 * MiB;
constexpr size_t WS_O1 = 370 * MiB, WS_O2 = 402 * MiB;
constexpr size_t WS_YF = 370 * MiB, WS_YB = 402 * MiB;
constexpr size_t WS_MG = 370 * MiB;
constexpr size_t WS_Y = 442 * MiB;
constexpr size_t WS_AS = 138 * MiB;
constexpr size_t WS_END = 458 * MiB;


namespace pg8 {
#define PG8_LAS __attribute__((address_space(3)))
typedef unsigned short bf16_t;
typedef short bf16x8 __attribute__((ext_vector_type(8)));
typedef float f32x4 __attribute__((ext_vector_type(4)));
typedef unsigned u32x4 __attribute__((ext_vector_type(4)));
constexpr int BM = 256, BK = 64, HALF = 128, HTB = HALF * BK * 2  , STAGE_BYTES = 8 * HTB, NXCD = 8, WGM = 8;

__host__ __device__ __forceinline__ int lds_byte(int r, int c) { const int st = (r >> 4) * 2 + (c >> 5), rr = r & 15, cc = c & 31, ob = rr * 64 + cc * 2; return st * 1024 + (ob ^ (((ob >> 9) & 1) << 5)); }
__host__ __device__ __forceinline__ void stage_rc(int b, int& R, int& C) { const int st = b / 1024, sb = b % 1024, swz = sb ^ (((sb >> 9) & 1) << 5); R = (st >> 1) * 16 + swz / 64; C = (st & 1) * 32 + (swz % 64) / 2; }
__host__ __device__ __forceinline__ int perm32(int rho) { const int n = rho >> 4, i = rho & 15; return 8 * (i >> 2) + 4 * n + (i & 3); }

struct Unit { int pm, pn; };
struct Gemm { const bf16_t* A; const bf16_t* Bt; int M, N, K; };

struct StaticOrder {
    int nM, nN, nwg, G, c;
    __host__ __device__ void init(int M, int N, int G_, int c_) { nM = M / BM; nN = N / BM; nwg = nM * nN; G = G_; c = c_; }
    __host__ __device__ bool next(int i, Unit& u) const {
        const long L = (long)i * G + c; if (L >= nwg) return false;
        int wgid = (int)L; { const int q = nwg / NXCD, r = nwg % NXCD, xcd = wgid % NXCD, off = wgid / NXCD; wgid = (xcd < r ? xcd * (q + 1) : r * (q + 1) + (xcd - r) * q) + off; }
        const int nig = WGM * nN, gid = wgid / nig, fm = gid * WGM, gsz = (nM - fm) < WGM ? (nM - fm) : WGM;
        u.pm = fm + ((wgid % nig) % gsz); u.pn = (wgid % nig) / gsz; return true;
    }
    __device__ __forceinline__ void a_ready(const Unit&) const {}
    __device__ __forceinline__ void done(const Unit&) const {}
};


__device__ __forceinline__ unsigned cvt_pk_bf16(float lo, float hi) { unsigned r; asm volatile("v_cvt_pk_bf16_f32 %0, %1, %2" : "=v"(r) : "v"(lo), "v"(hi)); return r; }
__device__ __forceinline__ int lane_id_v() { int l; asm volatile("v_mbcnt_lo_u32_b32 %0, -1, 0\n\tv_mbcnt_hi_u32_b32 %0, -1, %0" : "=v"(l)); return l; }
__device__ __forceinline__ float bf_lo(unsigned u) { return __uint_as_float(u << 16); }
__device__ __forceinline__ float bf_hi(unsigned u) { return __uint_as_float(u & 0xffff0000u); }
__device__ __forceinline__ void unpack8(const u32x4 w, f32x4& a, f32x4& b) { a = (f32x4){bf_lo(w.x), bf_hi(w.x), bf_lo(w.y), bf_hi(w.y)}; b = (f32x4){bf_lo(w.z), bf_hi(w.z), bf_lo(w.w), bf_hi(w.w)}; }
__device__ __forceinline__ u32x4 pack8(const f32x4 a, const f32x4 b) { u32x4 w; w.x = cvt_pk_bf16(a[0], a[1]); w.y = cvt_pk_bf16(a[2], a[3]); w.z = cvt_pk_bf16(b[0], b[1]); w.w = cvt_pk_bf16(b[2], b[3]); return w; }
__device__ __forceinline__ float sigmoid_f(float x) { return __builtin_amdgcn_rcpf(1.0f + __builtin_amdgcn_exp2f(-1.4426950408889634f * x)); }
__device__ __forceinline__ f32x4 sigmoid4(f32x4 v) { return (f32x4){sigmoid_f(v[0]), sigmoid_f(v[1]), sigmoid_f(v[2]), sigmoid_f(v[3])}; }
__device__ __forceinline__ f32x4 silu4(f32x4 v) { return v * sigmoid4(v); }
__device__ __forceinline__ f32x4 shflx32(f32x4 v) { return (f32x4){__shfl_xor(v[0], 32), __shfl_xor(v[1], 32), __shfl_xor(v[2], 32), __shfl_xor(v[3], 32)}; }

struct EpiInProj {
    static constexpr bool PERM = true, AFTER_DRAIN = false, HAS_MID = false;
    unsigned char* ws; float c2; int tmid;
    __device__ __forceinline__ void mid(f32x4 (&)[2][2][4][2], const Unit&, int, int, int, int) const {}
    __device__ __forceinline__ void operator()(const f32x4 (&acc)[2][2][4][2], const Unit& u, int wr, int wc, int fr, int fq) const {
        const int pn = u.pn, pm = u.pm;
        const bool isctx = pm >= 64;
        const int b = isctx ? pm - 64 : pm >> 3;
        const int t0 = isctx ? 0 : (pm & 7) * 256;
        const int colw = wc * 32 + 8 * fq;
        if (pn < 8) {
            const bool isq = pn < 4;
            bf16_t* base = (bf16_t*)(ws + (isq ? WS_Q : WS_KALL));
            const float* rope_c = (const float*)(ws + WS_ROPE); const float* rope_s = rope_c + 1024;
            const int ct = (isq ? pn : pn - 4) * 256 + colw;
            const float sgn = fq < 2 ? -1.f : 1.f, osc = isq ? c2 : 1.f;
#pragma unroll
            for (int ai = 0; ai < 2; ++ai)
#pragma unroll
                for (int m = 0; m < 4; ++m) {
                    const int rl = ai * HALF + wr * 64 + m * 16 + fr, t = t0 + rl;
                    const size_t grow = isq ? (size_t)(b * 2048 + t) : (size_t)(b * 2304 + (isctx ? 2048 : 0) + t);
                    f32x4 c0 = (f32x4){1.f, 1.f, 1.f, 1.f}, c1 = c0, s0 = (f32x4){0.f, 0.f, 0.f, 0.f}, s1 = s0;
                    if (!isctx) { const int pos = (wc & 1) ? (t & 63) : (t >> 6); const float* pc = rope_c + pos * 16 + 8 * (fq & 1); const float* ps = rope_s + pos * 16 + 8 * (fq & 1);
                        c0 = *(const f32x4*)pc; c1 = *(const f32x4*)(pc + 4); s0 = *(const f32x4*)ps * sgn; s1 = *(const f32x4*)(ps + 4) * sgn; }
#pragma unroll
                    for (int bj = 0; bj < 2; ++bj) {
                        const f32x4 v0 = acc[ai][bj][m][0], v1 = acc[ai][bj][m][1];
                        const f32x4 p0 = shflx32(v0), p1 = shflx32(v1);
                        const f32x4 o0 = (v0 * c0 + p0 * s0) * osc, o1 = (v1 * c1 + p1 * s1) * osc;
                        *(u32x4*)(base + grow * 1024 + ct + bj * HALF) = pack8(o0, o1);
                    }
                    asm volatile("" ::: "memory");
                }
        } else if (pn < 12) {
            const int ct = (pn - 8) * 256 + colw;
#pragma unroll
            for (int ai = 0; ai < 2; ++ai)
#pragma unroll
                for (int m = 0; m < 4; ++m) {
                    const int rl = ai * HALF + wr * 64 + m * 16 + fr, t = t0 + rl;
                    const size_t grow = (size_t)(b * 2304 + (isctx ? 2048 : 0) + t);
#pragma unroll
                    for (int bj = 0; bj < 2; ++bj) *(u32x4*)((bf16_t*)(ws + WS_VALL) + grow * 1024 + ct + bj * HALF) = pack8(acc[ai][bj][m][0], acc[ai][bj][m][1]);
                }
        } else if (pn == 16 || pn == 17) {
#pragma unroll
            for (int ai = 0; ai < 2; ++ai)
#pragma unroll
                for (int m = 0; m < 4; ++m) {
                    const int rl = ai * HALF + wr * 64 + m * 16 + fr, t = t0 + rl;
                    const int R = isctx ? 1024 + b * 16 + (t >> 4) : b * 128 + (t >> 4), tl = t & 15;
#pragma unroll
                    for (int bj = 0; bj < 2; ++bj) {
                        const int g = (pn - 16) * 16 + bj * 8 + wc * 2 + (fq >> 1), c0 = 8 * (fq & 1);
                        *(u32x4*)((bf16_t*)(ws + WS_UCH) + ((size_t)(g * 1280 + R) * 256 + tl * 16 + c0)) = pack8(acc[ai][bj][m][0], acc[ai][bj][m][1]);
                    }
                }
        } else {
            size_t boff; int pitch, ct; bool sil;
            if (pn < 16) { boff = WS_GA; pitch = 1024; ct = (pn - 12) * 256; sil = true; }
            else if (pn < 20) { boff = WS_GS; pitch = 512; ct = (pn - 18) * 256; sil = true; }
            else { boff = WS_GM; pitch = 4096; ct = (pn - 20) * 256; sil = false; }
            bf16_t* base = (bf16_t*)(ws + boff);
            ct += colw;
#pragma unroll
            for (int ai = 0; ai < 2; ++ai)
#pragma unroll
                for (int m = 0; m < 4; ++m) {
                    const size_t grow = (size_t)pm * 256 + ai * HALF + wr * 64 + m * 16 + fr;
#pragma unroll
                    for (int bj = 0; bj < 2; ++bj) {
                        const f32x4 v0 = acc[ai][bj][m][0], v1 = acc[ai][bj][m][1];
                        const f32x4 g0 = sigmoid4(v0), g1 = sigmoid4(v1);
                        const f32x4 o0 = sil ? v0 * g0 : g0, o1 = sil ? v1 * g1 : g1;
                        *(u32x4*)(base + grow * pitch + ct + bj * HALF) = pack8(o0, o1);
                    }
                    asm volatile("" ::: "memory");
                }
        }
    }
};

struct EpiGlu {
    static constexpr bool PERM = true, AFTER_DRAIN = false, HAS_MID = false;
    const bf16_t *Y, *GS; const float* bglu; bf16_t* AS; int tmid;
    __device__ __forceinline__ void mid(f32x4 (&)[2][2][4][2], const Unit&, int, int, int, int) const {}
    __device__ __forceinline__ void operator()(const f32x4 (&acc)[2][2][4][2], const Unit& u, int wr, int wc, int fr, int fq) const {
        const int col0 = u.pn * BM + wc * 32 + 8 * fq;
        f32x4 bv[2][2];
#pragma unroll
        for (int bj = 0; bj < 2; ++bj)
#pragma unroll
            for (int n = 0; n < 2; ++n) bv[bj][n] = *(const f32x4*)(bglu + col0 + bj * HALF + 4 * n);
#pragma unroll
        for (int ai = 0; ai < 2; ++ai)
#pragma unroll
            for (int m = 0; m < 4; ++m) {
                const size_t row = (size_t)u.pm * BM + ai * HALF + wr * 64 + m * 16 + fr;
#pragma unroll
                for (int bj = 0; bj < 2; ++bj) {
                    const int col = col0 + bj * HALF;
                    f32x4 y0, y1, g0, g1; unpack8(*(const u32x4*)(Y + row * 512 + col), y0, y1); unpack8(*(const u32x4*)(GS + row * 512 + col), g0, g1);
                    const f32x4 o0 = y0 * sigmoid4(acc[ai][bj][m][0] + bv[bj][0]) * g0, o1 = y1 * sigmoid4(acc[ai][bj][m][1] + bv[bj][1]) * g1;
                    *(u32x4*)(AS + row * 1536 + 1024 + col) = pack8(o0, o1);
                }
                asm volatile("" ::: "memory");
            }
    }
};

struct EpiMerged {
    static constexpr bool PERM = true, AFTER_DRAIN = false, HAS_MID = true;
    const bf16_t* GM; bf16_t* MG; int tmid;
    __device__ __forceinline__ void mid(f32x4 (&acc)[2][2][4][2], const Unit& u, int wr, int wc, int fr, int fq) const {
        unsigned opq = 0; asm volatile("" : "+v"(opq));
        const unsigned col0 = u.pn * BM + wc * 32 + 8 * fq + opq;
#pragma unroll
        for (int ai = 0; ai < 2; ++ai)
#pragma unroll
            for (int m = 0; m < 4; ++m) {
                const unsigned row = u.pm * BM + ai * HALF + wr * 64 + m * 16 + fr;
#pragma unroll
                for (int bj = 0; bj < 2; ++bj) {
                    const unsigned col = col0 + bj * HALF;
                    f32x4 a0, a1, s0, s1; unpack8(*(const u32x4*)(GM + (row * 4096u + col)), a0, a1); unpack8(*(const u32x4*)(GM + (row * 4096u + 2048u + col)), s0, s1);
#pragma unroll
                    for (int e = 0; e < 4; ++e) { acc[ai][bj][m][0][e] *= a0[e] * __builtin_amdgcn_rcpf(fmaxf(s0[e], 1e-30f)); acc[ai][bj][m][1][e] *= a1[e] * __builtin_amdgcn_rcpf(fmaxf(s1[e], 1e-30f)); }
                }
                asm volatile("" ::: "memory");
            }
    }
    __device__ __forceinline__ void operator()(const f32x4 (&acc)[2][2][4][2], const Unit& u, int wr, int wc, int fr, int fq) const {
        const int col0 = u.pn * BM + wc * 32 + 8 * fq;
#pragma unroll
        for (int ai = 0; ai < 2; ++ai)
#pragma unroll
            for (int m = 0; m < 4; ++m) {
                const size_t row = (size_t)u.pm * BM + ai * HALF + wr * 64 + m * 16 + fr;
#pragma unroll
                for (int bj = 0; bj < 2; ++bj) {
                    const int col = col0 + bj * HALF;
                    f32x4 s0, s1; unpack8(*(const u32x4*)(GM + row * 4096 + 2048 + col), s0, s1);
                    *(u32x4*)(MG + row * 2048 + col) = pack8(acc[ai][bj][m][0] * s0, acc[ai][bj][m][1] * s1);
                }
                asm volatile("" ::: "memory");
            }
    }
};

struct EpiOut {
    static constexpr bool PERM = false, AFTER_DRAIN = false, HAS_MID = false;
    const float *x, *mod, *bada; float* out; float* rowsq; int tmid;
    __device__ __forceinline__ void mid(f32x4 (&)[2][2][4][2], const Unit&, int, int, int, int) const {}
    __device__ __forceinline__ void operator()(const f32x4 (&acc)[2][2][4][2], const Unit& u, int wr, int wc, int fr, int fq) const {
        const int col0 = u.pn * BM + wc * 32 + 4 * fq, b = u.pm >> 3;
        f32x4 gv[2][2];
#pragma unroll
        for (int bj = 0; bj < 2; ++bj)
#pragma unroll
            for (int n = 0; n < 2; ++n) gv[bj][n] = *(const f32x4*)(mod + b * 6144 + 4096 + col0 + bj * HALF + n * 16) + *(const f32x4*)(bada + 4096 + col0 + bj * HALF + n * 16);
#pragma unroll
        for (int ai = 0; ai < 2; ++ai)
#pragma unroll
            for (int m = 0; m < 4; ++m) {
                const size_t row = (size_t)u.pm * BM + ai * HALF + wr * 64 + m * 16 + fr; float ss = 0.f;
#pragma unroll
                for (int bj = 0; bj < 2; ++bj)
#pragma unroll
                    for (int n = 0; n < 2; ++n) {
                        const size_t off = row * 2048 + col0 + bj * HALF + n * 16;
                        const f32x4 o = *(const f32x4*)(x + off) + gv[bj][n] * acc[ai][bj][m][n];
                        *(f32x4*)(out + off) = o; ss += (o[0] * o[0] + o[1] * o[1]) + (o[2] * o[2] + o[3] * o[3]);
                    }
                ss += __shfl_xor(ss, 16); ss += __shfl_xor(ss, 32);
                if (fq == 0) atomicAdd(rowsq + row, ss);
                asm volatile("" ::: "memory");
            }
    }
};
template <class Epi, class Sched, bool ALIGN_EPI = false, bool SP2 = false>
__device__ __forceinline__ void gemm_phase(PG8_LAS unsigned char* lds, const Gemm g, const Sched& S, const Epi& E, const int wid) {
    const int lane = lane_id_v(), tid = wid * 64 + lane, wr = wid >> 2, wc = wid & 3, fr = lane & 15, fq = lane >> 4;
    const int K = g.K, nt = K / BK;
    unsigned voffA[2], voffB[2];
#pragma unroll
    for (int i = 0; i < 2; ++i) { int R, C; stage_rc(tid * 16 + i * 8192, R, C); const int Rb = Epi::PERM ? ((R & ~31) + perm32(R & 31)) : R;
        voffA[i] = (unsigned)(R * K + C) * 2u; voffB[i] = (unsigned)(Rb * K + C) * 2u; }
    const size_t kstep = (size_t)(BK * 2);
    const size_t hstep = (size_t)HALF * K * 2;
    const size_t tstep = 2 * hstep;
    const unsigned ldsw = (unsigned)wid * 1024u;
    const int aoff = lds_byte(wr * 64 + fr, fq * 8), boff = lds_byte(wc * 32 + fr, fq * 8);
#define PG8_SA(b, h) (((b) * 2 + (h)) * HTB)
#define PG8_SB(b, h) ((4 + (b) * 2 + (h)) * HTB)
#define PG8_STAGE(bufoff, gbase, voff) do { _Pragma("unroll") for (int _i = 0; _i < 2; ++_i) \
        __builtin_amdgcn_global_load_lds((const unsigned*)((const char*)(gbase) + (voff)[_i]), (PG8_LAS unsigned*)(lds + (bufoff) + ldsw + _i * 8192), 16, 0, 0); } while (0)
#define PG8_LDA(dst, b, h) do { _Pragma("unroll") for (int m = 0; m < 4; ++m) _Pragma("unroll") for (int k = 0; k < 2; ++k) dst[m][k] = *(const PG8_LAS bf16x8*)(lds + PG8_SA(b, h) + aoff + m * 2048 + k * 1024); } while (0)
#define PG8_LDB(dst, b, h) do { _Pragma("unroll") for (int n = 0; n < 2; ++n) _Pragma("unroll") for (int k = 0; k < 2; ++k) dst[n][k] = *(const PG8_LAS bf16x8*)(lds + PG8_SB(b, h) + boff + n * 2048 + k * 1024); } while (0)
#define PG8_MMA(ai, bj, At, Bt) do { __builtin_amdgcn_s_setprio(1); _Pragma("unroll") for (int m = 0; m < 4; ++m) _Pragma("unroll") for (int n = 0; n < 2; ++n) _Pragma("unroll") for (int k = 0; k < 2; ++k) \
        acc[ai][bj][m][n] = __builtin_amdgcn_mfma_f32_16x16x32_bf16(Bt[n][k], At[m][k], acc[ai][bj][m][n], 0, 0, 0); __builtin_amdgcn_s_setprio(0); } while (0)
#define PG8_WAIT_V(n) asm volatile("s_waitcnt vmcnt(" #n ")" ::: "memory")
#define PG8_WAIT_L(n) asm volatile("s_waitcnt lgkmcnt(" #n ")" ::: "memory")
#define PG8_BAR __builtin_amdgcn_s_barrier()
#define PG8_SCHED __builtin_amdgcn_sched_barrier(0)
    Unit cur, nxt; int ui = 0;
    if (!S.next(0, cur)) return;
    f32x4 acc[2][2][4][2];
#pragma unroll
    for (int a = 0; a < 2; ++a)
#pragma unroll
        for (int b = 0; b < 2; ++b)
#pragma unroll
            for (int m = 0; m < 4; ++m)
#pragma unroll
                for (int n = 0; n < 2; ++n) acc[a][b][m][n] = (f32x4){0.f, 0.f, 0.f, 0.f};
    bf16x8 At[4][2], B0[2][2], B1[2][2];
    const char* cA = (const char*)g.A + (size_t)cur.pm * tstep; const char* cB = (const char*)g.Bt + (size_t)cur.pn * tstep;
    S.a_ready(cur);
    if constexpr (SP2) {
        PG8_STAGE(PG8_SB(0, 0), cB, voffB); PG8_STAGE(PG8_SB(0, 1), cB + hstep, voffB); PG8_STAGE(PG8_SA(0, 0), cA, voffA); PG8_STAGE(PG8_SA(0, 1), cA + hstep, voffA);
        if (wr == 1) PG8_BAR;
        PG8_WAIT_V(2); PG8_BAR;
        PG8_STAGE(PG8_SB(1, 0), cB + kstep, voffB); PG8_STAGE(PG8_SA(1, 0), cA + kstep, voffA); PG8_STAGE(PG8_SB(1, 1), cB + hstep + kstep, voffB);
        PG8_WAIT_V(6); PG8_BAR;
    } else {
        PG8_STAGE(PG8_SB(0, 0), cB, voffB); PG8_STAGE(PG8_SA(0, 0), cA, voffA); PG8_STAGE(PG8_SB(0, 1), cB + hstep, voffB); PG8_STAGE(PG8_SA(0, 1), cA + hstep, voffA);
        if (wr == 1) PG8_BAR;
        PG8_WAIT_V(4); PG8_BAR;
        PG8_STAGE(PG8_SB(1, 0), cB + kstep, voffB); PG8_STAGE(PG8_SA(1, 0), cA + kstep, voffA); PG8_STAGE(PG8_SB(1, 1), cB + hstep + kstep, voffB);
        PG8_WAIT_V(6); PG8_BAR;
    }
    for (;;) {
        const bool has_next = S.next(ui + 1, nxt);
        const char* nA = has_next ? (const char*)g.A + (size_t)nxt.pm * tstep : cA; const char* nB = has_next ? (const char*)g.Bt + (size_t)nxt.pn * tstep : cB;
        for (int t = 0; t < nt; t += 2) {
            const bool last = (t == nt - 2);
            const char* a1 = cA + (size_t)(t + 1) * kstep;
            const char* a2 = last ? nA : cA + (size_t)(t + 2) * kstep; const char* b2 = last ? nB : cB + (size_t)(t + 2) * kstep;
            const char* a3 = a2 + kstep; const char* b3 = b2 + kstep;
            if (last && has_next) S.a_ready(nxt);
            if constexpr (Epi::HAS_MID) { if (t == E.tmid) E.mid(acc, cur, wr, wc, fr, fq); }
            if constexpr (SP2) {
            PG8_LDB(B0, 0, 0); PG8_LDB(B1, 0, 1); PG8_SCHED; PG8_LDA(At, 0, 0); PG8_STAGE(PG8_SA(1, 1), a1 + hstep, voffA);
            PG8_WAIT_V(8); PG8_WAIT_L(0); PG8_BAR; PG8_MMA(0, 0, At, B0); PG8_MMA(0, 1, At, B1); PG8_BAR; PG8_SCHED;
            PG8_LDA(At, 0, 1); PG8_STAGE(PG8_SB(0, 0), b2, voffB); PG8_STAGE(PG8_SB(0, 1), b2 + hstep, voffB); PG8_STAGE(PG8_SA(0, 0), a2, voffA);
            PG8_WAIT_V(8); PG8_WAIT_L(0); PG8_BAR; PG8_MMA(1, 0, At, B0); PG8_MMA(1, 1, At, B1); PG8_BAR; PG8_SCHED;
            PG8_LDB(B0, 1, 0); PG8_LDB(B1, 1, 1); PG8_SCHED; PG8_LDA(At, 1, 0); PG8_STAGE(PG8_SA(0, 1), a2 + hstep, voffA);
            PG8_WAIT_V(8); PG8_WAIT_L(0); PG8_BAR; PG8_MMA(0, 0, At, B0); PG8_MMA(0, 1, At, B1); PG8_BAR; PG8_SCHED;
            PG8_LDA(At, 1, 1); PG8_STAGE(PG8_SB(1, 0), b3, voffB); PG8_STAGE(PG8_SB(1, 1), b3 + hstep, voffB); PG8_STAGE(PG8_SA(1, 0), a3, voffA);
            PG8_WAIT_V(8); PG8_WAIT_L(0); PG8_BAR; PG8_MMA(1, 0, At, B0); PG8_MMA(1, 1, At, B1); PG8_BAR; PG8_SCHED;
            } else {
            PG8_LDB(B0, 0, 0); PG8_SCHED; PG8_LDA(At, 0, 0); PG8_STAGE(PG8_SA(1, 1), a1 + hstep, voffA);
            PG8_WAIT_L(8); PG8_BAR; PG8_WAIT_L(0); PG8_MMA(0, 0, At, B0); PG8_BAR; PG8_SCHED;
            PG8_LDB(B1, 0, 1); PG8_STAGE(PG8_SB(0, 0), b2, voffB);
            PG8_BAR; PG8_WAIT_L(0); PG8_MMA(0, 1, At, B1); PG8_BAR;
            PG8_LDA(At, 0, 1); PG8_STAGE(PG8_SA(0, 0), a2, voffA);
            PG8_BAR; PG8_WAIT_L(0); PG8_MMA(1, 0, At, B0); PG8_BAR; PG8_SCHED;
            PG8_STAGE(PG8_SB(0, 1), b2 + hstep, voffB);
            PG8_WAIT_V(6); PG8_BAR; PG8_MMA(1, 1, At, B1); PG8_BAR;
            PG8_LDB(B0, 1, 0); PG8_SCHED; PG8_LDA(At, 1, 0); PG8_STAGE(PG8_SA(0, 1), a2 + hstep, voffA);
            PG8_WAIT_L(8); PG8_BAR; PG8_WAIT_L(0); PG8_MMA(0, 0, At, B0); PG8_BAR; PG8_SCHED;
            PG8_LDB(B1, 1, 1); PG8_STAGE(PG8_SB(1, 0), b3, voffB);
            PG8_BAR; PG8_WAIT_L(0); PG8_MMA(0, 1, At, B1); PG8_BAR;
            PG8_LDA(At, 1, 1); PG8_STAGE(PG8_SA(1, 0), a3, voffA);
            PG8_BAR; PG8_WAIT_L(0); PG8_MMA(1, 0, At, B0); PG8_BAR; PG8_SCHED;
            PG8_STAGE(PG8_SB(1, 1), b3 + hstep, voffB);
            PG8_WAIT_V(6); PG8_BAR; PG8_MMA(1, 1, At, B1); PG8_BAR;
            }
        }
        if constexpr (ALIGN_EPI) { if (wr == 0) PG8_BAR; }
        if constexpr (!Epi::AFTER_DRAIN) { E(acc, cur, wr, wc, fr, fq); S.done(cur); }
        if (!has_next) break;
#pragma unroll
        for (int a = 0; a < 2; ++a)
#pragma unroll
            for (int b = 0; b < 2; ++b)
#pragma unroll
                for (int m = 0; m < 4; ++m)
#pragma unroll
                    for (int n = 0; n < 2; ++n) acc[a][b][m][n] = (f32x4){0.f, 0.f, 0.f, 0.f};
        cur = nxt; cA = nA; cB = nB; ++ui;
        if constexpr (ALIGN_EPI) { if (wr == 1) PG8_BAR; }
    }
    PG8_WAIT_V(0);
    if constexpr (!ALIGN_EPI) { if (wr == 0) PG8_BAR; }
    PG8_BAR;
    if constexpr (Epi::AFTER_DRAIN) { E.fused(acc, cur, wr, wc, fr, fq, lds, wid, lane); S.done(cur); }
#undef PG8_SA
#undef PG8_SB
#undef PG8_STAGE
#undef PG8_LDA
#undef PG8_LDB
#undef PG8_MMA
#undef PG8_WAIT_V
#undef PG8_WAIT_L
#undef PG8_BAR
#undef PG8_SCHED
}
}

#ifndef PG8_SP2
#define PG8_SP2 true
#endif
#ifndef PG8_ALIGN
#define PG8_ALIGN true
#endif
#define GAS __attribute__((address_space(1)))
#define LAS __attribute__((address_space(3)))
typedef unsigned short bf16;
typedef unsigned v4u __attribute__((ext_vector_type(4)));
typedef float f32x4 __attribute__((ext_vector_type(4)));
typedef short bf16x8 __attribute__((ext_vector_type(8)));
typedef GAS unsigned gu32;
typedef GAS unsigned long long gu64;
#define RLX_AGENT __ATOMIC_RELAXED, __HIP_MEMORY_SCOPE_AGENT
#define LDS_WAIT() asm volatile("s_waitcnt lgkmcnt(0)" ::: "memory")
#define VM_WAIT() asm volatile("s_waitcnt vmcnt(0)" ::: "memory")
__device__ __forceinline__ unsigned long long rt() { return __builtin_amdgcn_s_memrealtime(); }
__device__ __forceinline__ unsigned f2bf(float f) { unsigned u = __builtin_bit_cast(unsigned, f); return (u + 0x7fffu + ((u >> 16) & 1u)) >> 16; }
__device__ __forceinline__ unsigned pk2(float lo, float hi) { return f2bf(lo) | (f2bf(hi) << 16); }

#define XB_TMO      128
#define XB_XCNT(j)  (256  + 64 * (j))
#define XB_XSUB(j)  (1280 + 64 * (j))
#define XB_XGEN(j)  (2304 + 64 * (j))
#define XB_TOP      3328
#define XB_TOPGEN   3392
#define XCD_BAR_WORDS 3456
#define XB_SPIN_CAP (1u << 18)

__device__ __forceinline__ unsigned xb_ld(unsigned* p)              { return __hip_atomic_load(p, __ATOMIC_RELAXED, __HIP_MEMORY_SCOPE_AGENT); }
__device__ __forceinline__ unsigned xb_add(unsigned* p, unsigned v) { return __hip_atomic_fetch_add(p, v, __ATOMIC_RELAXED, __HIP_MEMORY_SCOPE_AGENT); }
__device__ __forceinline__ unsigned xb_xcc_id() { return (unsigned)__builtin_amdgcn_s_getreg((3 << 11) | 20) & 0xFu; }
#define XB_SPIN(cond, bar) do { unsigned _sp = 0; while (cond) { __builtin_amdgcn_s_sleep(1); \
    if ((++_sp & 255u) == 0u) { if (xb_ld(&(bar)[XB_TMO])) break; if (_sp > XB_SPIN_CAP) { atomicAdd(&(bar)[XB_TMO], 1u); break; } } } } while (0)

struct XcdBarrier {
    unsigned* bar; unsigned x;
    volatile LAS unsigned* st;
};

__device__ __forceinline__ XcdBarrier xcd_barrier_post(unsigned* bar, volatile LAS unsigned* st) {
    XcdBarrier b; b.bar = bar; b.x = xb_xcc_id(); b.st = st;
    if (threadIdx.x == 0) (void)xb_add(&bar[XB_XCNT(b.x)], 1u);
    return b;
}
__device__ __forceinline__ void xcd_barrier_complete(unsigned* bar, unsigned x, unsigned& nloc, unsigned& nx) {
    const unsigned G = gridDim.x * gridDim.y * gridDim.z;
    unsigned sum, cnt, mine, sp = 0u;
    for (;;) {
        sum = 0u; cnt = 0u; mine = 0u;
#pragma unroll
        for (unsigned j = 0; j < 16; ++j) { const unsigned c = xb_ld(&bar[XB_XCNT(j)]); sum += c; cnt += (c > 0u) ? 1u : 0u; mine = (j == x) ? c : mine; }
        if (sum == G) break;
        __builtin_amdgcn_s_sleep(1);
        if ((++sp & 255u) == 0u) { if (xb_ld(&bar[XB_TMO])) break; if (sp > XB_SPIN_CAP) { atomicAdd(&bar[XB_TMO], 1u); break; } }
    }
    nloc = mine > 0u ? mine : 1u; nx = cnt > 0u ? cnt : 1u;
}

__device__ __forceinline__ void xcd_barrier(const XcdBarrier& b, const int wave) {
    asm volatile("s_waitcnt vmcnt(0)" ::: "memory");
    __syncthreads();
    if (wave == 0 && pg8::lane_id_v() == 0) {
        unsigned* bar = b.bar;
        __builtin_amdgcn_s_waitcnt(0);
        unsigned nloc = b.st[0], nx = b.st[1];
        if (nloc == 0u) { xcd_barrier_complete(bar, b.x, nloc, nx); b.st[0] = nloc; b.st[1] = nx; }
        const unsigned old = xb_add(&bar[XB_XSUB(b.x)], 1u);
        const unsigned gen = old / nloc;
        if (old + 1u == (gen + 1u) * nloc) {
            __builtin_amdgcn_fence(__ATOMIC_RELEASE, "agent");
            asm volatile("s_waitcnt vmcnt(0)" ::: "memory");
            const unsigned og = xb_add(&bar[XB_TOP], 1u);
            const unsigned tg = og / nx;
            if (og + 1u == (tg + 1u) * nx) xb_add(&bar[XB_TOPGEN], 1u);
            else XB_SPIN(xb_ld(&bar[XB_TOPGEN]) == tg, bar);
            __builtin_amdgcn_fence(__ATOMIC_ACQUIRE, "agent");
            xb_add(&bar[XB_XGEN(b.x)], 1u);
            asm volatile("s_waitcnt vmcnt(0)" ::: "memory");
        } else {
            XB_SPIN(xb_ld(&bar[XB_XGEN(b.x)]) == gen, bar);
            __builtin_amdgcn_fence(__ATOMIC_ACQUIRE, "agent");
            asm volatile("s_waitcnt vmcnt(0)" ::: "memory");
        }
    }
    __syncthreads();
}

#include <hip/hip_bf16.h>
#include <cmath>
namespace attn_body {
using bf16=__hip_bfloat16;
using bf16x8=__attribute__((ext_vector_type(8)))short;
using s16x4=__attribute__((ext_vector_type(4)))short;
using f32x16=__attribute__((ext_vector_type(16)))float;
using u32x4=__attribute__((ext_vector_type(4)))unsigned;
constexpr int D=64,DM=1024,SEQQ=2048,SEQKV=2304;
constexpr int NW=8,QBLK=32,QB=QBLK*NW,KVBLK=64,NQB=SEQQ/QB;
constexpr int ATTN_PITCH=DM, ATTN_UNIT_ROWS=QB;
__device__ __forceinline__ int crow(int r,int hi){return (r&3)+8*(r>>2)+4*hi;}
#define SBAR() __builtin_amdgcn_sched_barrier(0)
__device__ __forceinline__ void cmask(f32x16&p0,f32x16&p1,int jb,int qrel,int hi){
  const float NEG=-INFINITY; int kb=64*jb+4*hi;
  #pragma unroll
  for(int r=0;r<16;++r){int kv=kb+(r&3)+8*(r>>2); if(kv>qrel)p0[r]=NEG; if(kv+32>qrel)p1[r]=NEG;}
}

constexpr int NSLOT=3, SLOTB=8192;
constexpr int LDS_K=0, LDS_V=NSLOT*SLOTB, LDS_WS=2*NSLOT*SLOTB, LDS_OST=LDS_WS+NW*64*4, LDS_BYTES=LDS_OST+NW*4096;
constexpr float C2=0.125f*1.4426950408889634f;
__device__ __forceinline__ void glds16(const void*gsrc,unsigned lds_dst){unsigned keep;
  asm volatile("s_mov_b32 %0, m0\n\ts_mov_b32 m0, %2\n\ts_nop 0\n\tglobal_load_lds_dwordx4 %1, off\n\ts_mov_b32 m0, %0":"=&s"(keep):"v"(gsrc),"s"(lds_dst):"memory");}
__device__ __forceinline__ float max3f(float a,float b,float c){float r;asm("v_max3_f32 %0, %1, %2, %3":"=v"(r):"v"(a),"v"(b),"v"(c));return r;}
__device__ __forceinline__ float max2f(float a,float b){float r;asm("v_max_f32_e32 %0, %1, %2":"=v"(r):"v"(a),"v"(b));return r;}
__device__ __forceinline__ float fadd_s(float a,float b){float r;asm("v_add_f32_e32 %0, %1, %2":"=v"(r):"v"(a),"v"(b));return r;}
__device__ __forceinline__ float fsub_s(float a,float b){float r;asm("v_sub_f32_e32 %0, %1, %2":"=v"(r):"v"(a),"v"(b));return r;}
typedef float f32x2_t __attribute__((ext_vector_type(2))); typedef __bf16 bf16x2_t __attribute__((ext_vector_type(2)));
__device__ __forceinline__ unsigned cvtpk_s(float lo,float hi){f32x2_t v={lo,hi};bf16x2_t b=__builtin_convertvector(v,bf16x2_t);return __builtin_bit_cast(unsigned,b);}
#define WAIT_BAR(N) asm volatile("s_waitcnt vmcnt(" #N ") lgkmcnt(0)\n\ts_barrier":::"memory")

__device__ __forceinline__ void qkt(f32x16&p0,f32x16&p1,const char*Kslot,const bf16x8*qr,const f32x16&negm,int r32,int hi){
  const char*kb=Kslot+hi*1024+r32*16;
  #pragma unroll
  for(int d0=0;d0<4;++d0){
    const bf16x8 b0=*reinterpret_cast<const bf16x8*>(kb+d0*2048);
    const bf16x8 b1=*reinterpret_cast<const bf16x8*>(kb+d0*2048+512);
    if(d0==0){p0=__builtin_amdgcn_mfma_f32_32x32x16_bf16(b0,qr[0],negm,0,0,0);p1=__builtin_amdgcn_mfma_f32_32x32x16_bf16(b1,qr[0],negm,0,0,0);}
    else{p0=__builtin_amdgcn_mfma_f32_32x32x16_bf16(b0,qr[d0],p0,0,0,0);p1=__builtin_amdgcn_mfma_f32_32x32x16_bf16(b1,qr[d0],p1,0,0,0);}}
}
typedef __attribute__((address_space(3))) const char* lds_cptr;
typedef short v4i16_t __attribute__((ext_vector_type(4)));
__device__ __forceinline__ void kload8(bf16x8*kf,lds_cptr kp){
  kf[0]=*(const __attribute__((address_space(3))) bf16x8*)(kp);      kf[1]=*(const __attribute__((address_space(3))) bf16x8*)(kp+512);
  kf[2]=*(const __attribute__((address_space(3))) bf16x8*)(kp+2048); kf[3]=*(const __attribute__((address_space(3))) bf16x8*)(kp+2560);
  kf[4]=*(const __attribute__((address_space(3))) bf16x8*)(kp+4096); kf[5]=*(const __attribute__((address_space(3))) bf16x8*)(kp+4608);
  kf[6]=*(const __attribute__((address_space(3))) bf16x8*)(kp+6144); kf[7]=*(const __attribute__((address_space(3))) bf16x8*)(kp+6656);
}
__device__ __forceinline__ void kload2(bf16x8*kf,lds_cptr kp,int j){ kf[2*j]=*(const __attribute__((address_space(3))) bf16x8*)(kp+j*2048); kf[2*j+1]=*(const __attribute__((address_space(3))) bf16x8*)(kp+j*2048+512); }
__device__ __forceinline__ s16x4 vtr(lds_cptr p){ return __builtin_bit_cast(s16x4,__builtin_amdgcn_ds_read_tr16_b64_v4i16((__attribute__((address_space(3))) v4i16_t*)p)); }
__device__ __forceinline__ float rowmax(const f32x16&p0,const f32x16&p1){
  float a=max3f(p0[0],p0[1],p1[0]),b=max3f(p0[2],p0[3],p1[1]);a=max3f(a,p1[2],p1[3]);
  #pragma unroll
  for(int r=4;r<16;r+=4){a=max3f(a,p0[r],p0[r+1]);b=max3f(b,p0[r+2],p0[r+3]);a=max3f(a,p1[r],p1[r+1]);b=max3f(b,p1[r+2],p1[r+3]);}
  const float m=max2f(a,b);
  auto rr=__builtin_amdgcn_permlane32_swap(__float_as_uint(m),__float_as_uint(m),false,false);
  return max2f(__uint_as_float(rr[0]),__uint_as_float(rr[1]));
}
__device__ __forceinline__ void pv(f32x16*o,int vb,bf16x8 pa0,bf16x8 pa1,bf16x8 pa2,bf16x8 pa3){
  #pragma unroll
  for(int d0=0;d0<2;++d0){s16x4 lo[4],hi[4];
    #pragma unroll
    for(int ks=0;ks<4;++ks){
      asm volatile("ds_read_b64_tr_b16 %0,%1 offset:%c2":"=&v"(lo[ks]):"v"(vb),"i"(d0*4096+ks*1024):"memory");
      asm volatile("ds_read_b64_tr_b16 %0,%1 offset:%c2":"=&v"(hi[ks]):"v"(vb),"i"(d0*4096+ks*1024+512):"memory");}
    asm volatile("s_waitcnt lgkmcnt(0)":::"memory");SBAR();
    #define PK(k) (bf16x8){lo[k][0],lo[k][1],lo[k][2],lo[k][3],hi[k][0],hi[k][1],hi[k][2],hi[k][3]}
    o[d0]=__builtin_amdgcn_mfma_f32_32x32x16_bf16(pa0,PK(0),o[d0],0,0,0);
    o[d0]=__builtin_amdgcn_mfma_f32_32x32x16_bf16(pa1,PK(1),o[d0],0,0,0);
    o[d0]=__builtin_amdgcn_mfma_f32_32x32x16_bf16(pa2,PK(2),o[d0],0,0,0);
    o[d0]=__builtin_amdgcn_mfma_f32_32x32x16_bf16(pa3,PK(3),o[d0],0,0,0);
    #undef PK
  }
}

#ifndef ATTN_STORE16
#define ATTN_STORE16(p,v) (*(u32x4*)(p)=(v))
#endif
template<int THRL> __device__ __forceinline__ void attn_unit(int b,int qb,int qcol,int kcol,int vcol,int ocol,const bf16*Q,const bf16*__restrict__ K,const bf16*__restrict__ V,bf16*O,char*shm,const int wid){
  const int lane=pg8::lane_id_v(),r32=lane&31,hi=lane>>5;
  const long rowq=(long)b*SEQQ, rowkv=(long)b*SEQKV; const int q0=qb*QB;
  const bf16*Qw=Q+(rowq+q0+wid*QBLK)*DM+qcol;
  const bf16*Kh=K+rowkv*DM+kcol,*Vh=V+rowkv*DM+vcol;
  const unsigned lds0=(unsigned)(uintptr_t)shm;
  float*wsf=(float*)(shm+LDS_WS)+wid*64;
  const bf16*ksrc=Kh+(long)lane*DM+wid*8;
  const bf16*vsrc=Vh+(long)(16*(wid&3)+(lane>>2))*DM+(wid>>2)*32+(lane&3)*8;
  const unsigned kdst=lds0+LDS_K+wid*1024, vdst=lds0+LDS_V+wid*1024;
  #define DMA_K(t,slot) glds16(ksrc+(long)(t)*KVBLK*DM,(unsigned)__builtin_amdgcn_readfirstlane(kdst+(slot)))
  #define DMA_V(t,slot) glds16(vsrc+(long)(t)*KVBLK*DM,(unsigned)__builtin_amdgcn_readfirstlane(vdst+(slot)))
  const int vb0=(int)(lds0+LDS_V)+((lane>>4)&1)*32+(lane&3)*8+(4*hi+((lane&15)>>2))*64;
  const char*Kbase=shm+LDS_K; bf16x8 kf[8];
  const lds_cptr shm3=(lds_cptr)shm; const lds_cptr kp0=shm3+LDS_K+hi*1024+r32*16; const lds_cptr vp0=shm3+LDS_V+((lane>>4)&1)*32+(lane&3)*8+(4*hi+((lane&15)>>2))*64;
  constexpr int NT=SEQKV/KVBLK;
  DMA_K(0,0);DMA_V(0,0);DMA_K(1,SLOTB);
  bf16x8 qr[4];
  #pragma unroll
  for(int d0=0;d0<4;++d0)qr[d0]=*reinterpret_cast<const bf16x8*>(&Qw[(long)r32*DM+d0*16+hi*8]);
  float mhat=0.f,l_reg=0.f;f32x16 o[2];o[0]=f32x16{};o[1]=f32x16{};f32x16 negm=f32x16{};asm volatile("":"+v"(negm));
    #define CMASK(P0,P1,t) do{}while(0)
  bool resc=false;
  #define START(P0,P1) do{ const float rm=rowmax(P0,P1); resc=false; \
    { const float dl=rm; mhat=fadd_s(mhat,dl); \
      _Pragma("unroll") for(int r=0;r<16;++r){P0[r]=fsub_s(P0[r],dl);P1[r]=fsub_s(P1[r],dl);} \
      _Pragma("unroll") for(int r=0;r<16;++r)negm[r]=-mhat; asm volatile("":"+v"(negm)); } \
    _Pragma("unroll") for(int r=0;r<16;++r)P0[r]=__builtin_amdgcn_exp2f(P0[r]); }while(0)
  #define RESC() do{ if(resc){ asm volatile("s_waitcnt lgkmcnt(0)":::"memory"); \
      _Pragma("unroll") for(int d_=0;d_<2;++d_) _Pragma("unroll") for(int r=0;r<16;++r)o[d_][r]*=wsf[crow(r,hi)]; } }while(0)
  f32x16 pA0,pA1,pB0,pB1;
  int sl_prev=0,sl_cur=0,sl_next=SLOTB;
  #define ROT() do{sl_prev=sl_cur;sl_cur=sl_next;sl_next=(sl_next==(NSLOT-1)*SLOTB)?0:sl_next+SLOTB;}while(0)
  DMA_K(2,2*SLOTB);
  WAIT_BAR(3);
  qkt(pA0,pA1,Kbase,qr,negm,r32,hi);asm volatile("s_nop 15\n\ts_nop 7":"+v"(pA0),"+v"(pA1));CMASK(pA0,pA1,0);
  START(pA0,pA1);
  _Pragma("unroll") for(int r=0;r<16;++r)pA1[r]=__builtin_amdgcn_exp2f(pA1[r]);
  WAIT_BAR(0);
  DMA_K(3,0);DMA_V(1,SLOTB);
  ROT();
  kload8(kf,kp0+sl_cur);
  WAIT_BAR(2);
  s16x4 vlo[8],vhi[8]; u32x4 pw0,pw1,pw2,pw3;
  #define PKW(P,B) cvtpk_s(P[B],P[B+1])
  #define PAF(k) __builtin_bit_cast(bf16x8,pw##k)
  #define VFR(i) (bf16x8){vlo[i][0],vlo[i][1],vlo[i][2],vlo[i][3],vhi[i][0],vhi[i][1],vhi[i][2],vhi[i][3]}
  #define PIN(x) asm volatile("":"+v"(x))
  #define MX3(a,b,c) __builtin_fmaxf(__builtin_fmaxf((a),(b)),(c))
  #define GAPA(MF,A0,A1,A2,A3,W0,W1,PW) do{ MF; sacc+=A0; sacc+=A1; sacc+=A2; sacc+=A3; PIN(sacc); W0; W1; PIN(PW); SBAR(); }while(0)
  #define EX(v) __builtin_amdgcn_exp2f(v)
  #define GAPB(MF,X,B) do{ MF; X[B]=EX(X[B]); X[B+1]=EX(X[B+1]); X[B+2]=EX(X[B+2]); X[B+3]=EX(X[B+3]); PIN(X); SBAR(); }while(0)
  #define VRD(i) do{ vlo[i]=vtr(vp_+(((i)>>2)*4096+((i)&3)*1024)); vhi[i]=vtr(vp_+(((i)>>2)*4096+((i)&3)*1024+512)); }while(0)
  #define KRD(G,j) do{ if(G){ kload2(kf,kp0+sl_next,j); SBAR(); } }while(0)
  #define STEP(C0,C1,P0,P1,t,GK,GV,GL) do{ SBAR(); \
    const lds_cptr vp_=vp0+sl_prev; \
    VRD(0); SBAR(); float sacc=(P0[0]+P0[1]); \
    GAPA(C0=__builtin_amdgcn_mfma_f32_32x32x16_bf16(kf[0],qr[0],negm,0,0,0), P0[2],P0[3],P0[4],P0[5],     pw0[0]=PKW(P0,0), pw0[1]=PKW(P0,2), pw0); \
    VRD(4); SBAR(); GAPA(C1=__builtin_amdgcn_mfma_f32_32x32x16_bf16(kf[1],qr[0],negm,0,0,0), P0[6],P0[7],P0[8],P0[9],     pw0[2]=PKW(P0,4), pw0[3]=PKW(P0,6), pw0); \
    VRD(1); SBAR(); GAPA(C0=__builtin_amdgcn_mfma_f32_32x32x16_bf16(kf[2],qr[1],C0,0,0,0),   P0[10],P0[11],P0[12],P0[13], pw1[0]=PKW(P0,8), pw1[1]=PKW(P0,10), pw1); \
    VRD(5); SBAR(); GAPA(C1=__builtin_amdgcn_mfma_f32_32x32x16_bf16(kf[3],qr[1],C1,0,0,0),   P0[14],P0[15],P1[0],P1[1],   pw1[2]=PKW(P0,12),pw1[3]=PKW(P0,14), pw1); \
    VRD(2); SBAR(); GAPA(C0=__builtin_amdgcn_mfma_f32_32x32x16_bf16(kf[4],qr[2],C0,0,0,0),   P1[2],P1[3],P1[4],P1[5],     pw2[0]=PKW(P1,0), pw2[1]=PKW(P1,2), pw2); \
    VRD(6); SBAR(); GAPA(C1=__builtin_amdgcn_mfma_f32_32x32x16_bf16(kf[5],qr[2],C1,0,0,0),   P1[6],P1[7],P1[8],P1[9],     pw2[2]=PKW(P1,4), pw2[3]=PKW(P1,6), pw2); \
    VRD(3); SBAR(); GAPA(C0=__builtin_amdgcn_mfma_f32_32x32x16_bf16(kf[6],qr[3],C0,0,0,0),   P1[10],P1[11],P1[12],P1[13], pw3[0]=PKW(P1,8), pw3[1]=PKW(P1,10), pw3); \
    VRD(7); SBAR(); GAPA(C1=__builtin_amdgcn_mfma_f32_32x32x16_bf16(kf[7],qr[3],C1,0,0,0),   P1[14],P1[15],0.f,0.f,       pw3[2]=PKW(P1,12),pw3[3]=PKW(P1,14), pw3); \
    l_reg+=sacc; \
    if(GK){DMA_K((t)+3,sl_cur);} if(GV){DMA_V((t)+1,sl_next);} \
    CMASK(C0,C1,t); \
    { float a=MX3(C0[0],C0[1],C1[0]),b=MX3(C0[2],C0[3],C1[1]); a=MX3(a,C1[2],C1[3]); \
      _Pragma("unroll") for(int r=4;r<16;r+=4){a=MX3(a,C0[r],C0[r+1]);b=MX3(b,C0[r+2],C0[r+3]);a=MX3(a,C1[r],C1[r+1]);b=MX3(b,C1[r+2],C1[r+3]);} \
      float rm=__builtin_fmaxf(a,b); { auto rr=__builtin_amdgcn_permlane32_swap(__float_as_uint(rm),__float_as_uint(rm),false,false); rm=__builtin_fmaxf(__uint_as_float(rr[0]),__uint_as_float(rr[1])); } \
      resc=false; \
      if(__builtin_expect(__any(rm>(float)THRL),0)){ const float dl=__builtin_fmaxf(rm,0.f); mhat+=dl; \
        _Pragma("unroll") for(int r=0;r<16;++r){C0[r]-=dl;C1[r]-=dl;} \
        _Pragma("unroll") for(int r=0;r<16;++r)negm[r]=-mhat; asm volatile("":"+v"(negm)); \
        const float f=__builtin_amdgcn_exp2f(-dl); l_reg*=f; if(hi==0)wsf[r32]=f; resc=true; } } \
    SBAR(); \
    GAPB(o[0]=__builtin_amdgcn_mfma_f32_32x32x16_bf16(PAF(0),VFR(0),o[0],0,0,0), C0,0); \
    GAPB(o[1]=__builtin_amdgcn_mfma_f32_32x32x16_bf16(PAF(0),VFR(4),o[1],0,0,0), C0,4); \
    KRD(GL,0); GAPB(o[0]=__builtin_amdgcn_mfma_f32_32x32x16_bf16(PAF(1),VFR(1),o[0],0,0,0), C0,8); \
    KRD(GL,1); GAPB(o[1]=__builtin_amdgcn_mfma_f32_32x32x16_bf16(PAF(1),VFR(5),o[1],0,0,0), C0,12); \
    KRD(GL,2); GAPB(o[0]=__builtin_amdgcn_mfma_f32_32x32x16_bf16(PAF(2),VFR(2),o[0],0,0,0), C1,0); \
    KRD(GL,3); GAPB(o[1]=__builtin_amdgcn_mfma_f32_32x32x16_bf16(PAF(2),VFR(6),o[1],0,0,0), C1,4); \
    GAPB(o[0]=__builtin_amdgcn_mfma_f32_32x32x16_bf16(PAF(3),VFR(3),o[0],0,0,0), C1,8); \
    GAPB(o[1]=__builtin_amdgcn_mfma_f32_32x32x16_bf16(PAF(3),VFR(7),o[1],0,0,0), C1,12); \
    }while(0)
  int t=1;
  #undef CMASK
  #define CMASK(P0,P1,t) do{}while(0)
  for(;t+5<NT;t+=2){
    STEP(pB0,pB1,pA0,pA1,t,true,true,true);     WAIT_BAR(2); RESC(); ROT();
    STEP(pA0,pA1,pB0,pB1,t+1,true,true,true);   WAIT_BAR(2); RESC(); ROT();
  }
  #undef CMASK
  #define CMASK(P0,P1,t) do{}while(0)
  #define ENDW(tt) do{ if((tt)+3<NT){WAIT_BAR(2);} else if((tt)+2<NT){WAIT_BAR(1);} else {WAIT_BAR(0);} }while(0)
  for(;t+1<NT;t+=2){
    STEP(pB0,pB1,pA0,pA1,t,(t+3<NT),(t+1<NT),(t+1<NT));       ENDW(t);   RESC(); ROT();
    STEP(pA0,pA1,pB0,pB1,t+1,(t+4<NT),(t+2<NT),(t+2<NT));     ENDW(t+1); RESC(); ROT();
  }
  STEP(pB0,pB1,pA0,pA1,NT-1,false,false,false); RESC();
  { float sacc=pB0[0]+pB0[1]; _Pragma("unroll") for(int r=2;r<16;++r)sacc+=pB0[r]; _Pragma("unroll") for(int r=0;r<16;++r)sacc+=pB1[r]; l_reg+=sacc;
    pw0=(u32x4){PKW(pB0,0),PKW(pB0,2),PKW(pB0,4),PKW(pB0,6)};pw1=(u32x4){PKW(pB0,8),PKW(pB0,10),PKW(pB0,12),PKW(pB0,14)};pw2=(u32x4){PKW(pB1,0),PKW(pB1,2),PKW(pB1,4),PKW(pB1,6)};pw3=(u32x4){PKW(pB1,8),PKW(pB1,10),PKW(pB1,12),PKW(pB1,14)};
    SBAR(); pv(o,vb0+sl_cur,PAF(0),PAF(1),PAF(2),PAF(3)); }
  #undef PKW
  #undef PAF
  #undef VFR
  #undef PIN
  #undef MX3
  #undef GAPA
  #undef GAPB
  #undef EX
  #undef VRD
  #undef KRD
  #undef STEP
  #undef ENDW
  {auto rr=__builtin_amdgcn_permlane32_swap(__float_as_uint(l_reg),__float_as_uint(l_reg),false,false);l_reg=__uint_as_float(rr[0])+__uint_as_float(rr[1]);}
  if(hi==0)wsf[32+r32]=l_reg;asm volatile("s_waitcnt lgkmcnt(0)":::"memory");
  float rli[16];
  #pragma unroll
  for(int r=0;r<16;++r)rli[r]=__builtin_amdgcn_rcpf(wsf[32+crow(r,hi)]);
  bf16*Ow=O+(rowq+q0+wid*QBLK)*DM+ocol;
  { bf16*stg=(bf16*)(shm+LDS_OST)+wid*2048;
    #pragma unroll
    for(int r=0;r<16;++r){const int orow=crow(r,hi);
      #pragma unroll
      for(int d0=0;d0<2;++d0)stg[orow*64+d0*32+r32]=__float2bfloat16(o[d0][r]*rli[r]);}
    asm volatile("s_waitcnt lgkmcnt(0)":::"memory");
    #pragma unroll
    for(int i=0;i<4;++i){const int row=i*8+(lane>>3),ch=lane&7; const u32x4 v=*(const u32x4*)(stg+row*64+ch*8); ATTN_STORE16(Ow+(long)row*DM+ch*8,v);} }
  asm volatile("s_waitcnt lgkmcnt(0)\n\ts_barrier":::"memory");
  #undef DMA_K
  #undef DMA_V
  #undef CMASK
  #undef START
  #undef RESC
  #undef ROT
}
constexpr int ATTN_LDS_BYTES=LDS_BYTES;
#undef SBAR
#undef WAIT_BAR
}

constexpr int NWAVES = 8;
#ifndef MK_PER_PHASE
#define MK_PER_PHASE 0
#endif

constexpr int BATCH = 8, SEQ = 2048, DM = 2048, CTXL = 256;
constexpr int MLAT = BATCH * SEQ, MCTX = BATCH * CTXL, MALL = MLAT + MCTX;
constexpr int INW = 9216, KVROWS = SEQ + CTXL;
constexpr float NORM_EPS = 1e-6f, LAM_INIT = 0.2f;
constexpr float QSCALE = 0.125f * 1.4426950408889634f;

constexpr int RING_BYTES = 131072;
constexpr int LDSCTL_OFF = RING_BYTES, MISC_OFF = LDSCTL_OFF + 320;
constexpr int LDS_BYTES = 147456;

struct Args { const float* in[27]; float* out; unsigned char* ws; int ph_lo, ph_hi, li, pad; };
enum In { I_X = 0, I_C, I_CTX, I_CCTX, I_WADA, I_BADA, I_NORMG, I_WIN, I_LQ1, I_LK1, I_LQ2, I_LK2, I_SUBLN, I_LRE, I_LIM, I_LSTEP, I_BRE, I_BIM, I_CRE, I_CIM, I_SSMD, I_WGLU, I_BGLU, I_WPA, I_WPS, I_WOUT, I_FING };

__device__ __forceinline__ float wave_sum(float v) {
#pragma unroll
    for (int o = 1; o < 64; o <<= 1) v += __shfl_xor(v, o);
    return v;
}
using pg8::bf_lo; using pg8::bf_hi; using pg8::unpack8; using pg8::pack8; using pg8::sigmoid_f;
typedef pg8::u32x4 u32x4;

__device__ __forceinline__ void p0_transpose_item(const float* W, int N, bf16* WT, int dpitch, int dcol, LAS float* scr, int item, int lane) {
    const int nblk = N / 32, kb = item / nblk, nb = item % nblk, k0 = 64 * kb, n0 = 32 * nb;
#pragma unroll 8
    for (int i = 0; i < 32; ++i) { const int kk = 2 * i + (lane >> 5); scr[kk * 33 + (lane & 31)] = W[(size_t)(k0 + kk) * N + n0 + (lane & 31)]; }
    LDS_WAIT(); asm volatile("" ::: "memory");
    const int c = lane & 7;
#pragma unroll
    for (int j = 0; j < 4; ++j) { const int n = (lane >> 3) + 8 * j; const LAS float* s = scr + (8 * c) * 33 + n;
        v4u o; o.x = pk2(s[0 * 33], s[1 * 33]); o.y = pk2(s[2 * 33], s[3 * 33]); o.z = pk2(s[4 * 33], s[5 * 33]); o.w = pk2(s[6 * 33], s[7 * 33]);
        *(GAS v4u*)(WT + (size_t)(n0 + n) * dpitch + dcol + k0 + 8 * c) = o; }
    LDS_WAIT(); asm volatile("" ::: "memory");
}

__device__ __forceinline__ void p0_prologue(const Args& a, LAS unsigned char* lds, int vcu, int G, int wave, int lane) {
    unsigned char* ws = a.ws;
    const int gw = vcu * NWAVES + wave, NGW = G * NWAVES;
    {
        float* mod = (float*)(ws + WS_CTL + CTL_MOD);
        const float* wada = a.in[I_WADA]; const float* cc = a.in[I_C]; const float* cctx = a.in[I_CCTX];
        for (int it = gw; it < 1536; it += NGW) {
            const int kc = it / 24, nc = it % 24, k0 = kc * 32, n0 = nc * 256 + 4 * lane;
            f32x4 acc[9];
#pragma unroll
            for (int r = 0; r < 9; ++r) acc[r] = (f32x4){0.f, 0.f, 0.f, 0.f};
            for (int kk = 0; kk < 32; ++kk) {
                const f32x4 w = *(const f32x4*)(wada + (size_t)(k0 + kk) * 6144 + n0);
#pragma unroll
                for (int r = 0; r < 9; ++r) { const float cv = (r < 8) ? cc[r * 2048 + k0 + kk] : cctx[k0 + kk]; const float s = cv * sigmoid_f(cv); acc[r] += w * s; }
            }
#pragma unroll
            for (int r = 0; r < 9; ++r)
#pragma unroll
                for (int e = 0; e < 4; ++e) atomicAdd(mod + r * 6144 + n0 + e, acc[r][e]);
        }
    }
    {
        LAS float* scr = (LAS float*)(lds + wave * 16384);
        constexpr int I_IN = (2048 / 64) * (9216 / 32), I_PA = (1024 / 64) * (2048 / 32), I_PS = (512 / 64) * (2048 / 32), I_OUT = (2048 / 64) * (2048 / 32), I_GLU = (512 / 64) * (512 / 32);
        constexpr int NITEMS = I_IN + I_PA + I_PS + I_OUT + I_GLU;
        for (int it = gw; it < NITEMS; it += NGW) {
            int r = it;
            if (r < I_IN) { p0_transpose_item(a.in[I_WIN], 9216, (bf16*)(ws + WS_WIN), 2048, 0, scr, r, lane); continue; } r -= I_IN;
            if (r < I_PA) { p0_transpose_item(a.in[I_WPA], 2048, (bf16*)(ws + WS_WCAT), 1536, 0, scr, r, lane); continue; } r -= I_PA;
            if (r < I_PS) { p0_transpose_item(a.in[I_WPS], 2048, (bf16*)(ws + WS_WCAT), 1536, 1024, scr, r, lane); continue; } r -= I_PS;
            if (r < I_OUT) { p0_transpose_item(a.in[I_WOUT], 2048, (bf16*)(ws + WS_WOUT), 2048, 0, scr, r, lane); continue; } r -= I_OUT;
            p0_transpose_item(a.in[I_WGLU], 512, (bf16*)(ws + WS_WGLU), 512, 0, scr, r, lane);
        }
    }
    const int gt = gw * 64 + lane;
    if (gt < 1024) {
        const int pos = gt >> 4, i = gt & 15;
        const float inv = exp2f(-(float)i * 0.8304820237218406f);
        const float ang = (float)pos * inv;
        float* rc = (float*)(ws + WS_ROPE); rc[gt] = cosf(ang); rc[1024 + gt] = sinf(ang);
    }
    if (gt >= 4096 && gt < 8192) {
        const int idx = gt - 4096, dg = idx >> 6;
        const float lre = a.in[I_LRE][idx], lim = a.in[I_LIM][idx], dt = expf(a.in[I_LSTEP][dg]);
        const float mag = expf(lre * dt), ar = mag * cosf(lim * dt), ai = mag * sinf(lim * dt);
        const float den = lre * lre + lim * lim;
        const float fr = ((ar - 1.0f) * lre + ai * lim) / den, fi = (ai * lre - (ar - 1.0f) * lim) / den;
        float* P = (float*)(ws + WS_SSMP);
        P[idx] = ar; P[4096 + idx] = ai;
        const float* br = a.in[I_BRE] + (size_t)idx * 16; const float* bi = a.in[I_BIM] + (size_t)idx * 16;
#pragma unroll
        for (int c = 0; c < 16; ++c) { P[8192 + idx * 16 + c] = fr * br[c] - fi * bi[c]; P[8192 + 65536 + idx * 16 + c] = fr * bi[c] + fi * br[c]; }
    }
}

__device__ __forceinline__ void p1_xn(const Args& a, int vcu, int G, int wave, int lane) {
    unsigned char* ws = a.ws;
    const int gw = vcu * NWAVES + wave, NGW = G * NWAVES;
    const float* mod = (const float*)(ws + WS_CTL + CTL_MOD); const float* bada = a.in[I_BADA]; const float* ng = a.in[I_NORMG];
    bf16* XN = (bf16*)(ws + WS_XN);
    for (int m = gw; m < MALL; m += NGW) {
        const float* src = m < MLAT ? a.in[I_X] + (size_t)m * DM : a.in[I_CTX] + (size_t)(m - MLAT) * DM;
        const int mr = m < MLAT ? (m >> 11) : 8;
        const f32x4* xr = (const f32x4*)src + lane;
        f32x4 v[8]; float s = 0.f;
#pragma unroll
        for (int j = 0; j < 8; ++j) { v[j] = xr[64 * j]; s += (v[j][0] * v[j][0] + v[j][1] * v[j][1]) + (v[j][2] * v[j][2] + v[j][3] * v[j][3]); }
        const float rstd = 1.0f / sqrtf(wave_sum(s) * (1.0f / DM) + NORM_EPS);
        unsigned long long* o8 = (unsigned long long*)(XN + (size_t)m * DM) + lane;
#pragma unroll
        for (int j = 0; j < 8; ++j) {
            const int col = 4 * lane + 256 * j;
            const f32x4 sh = *(const f32x4*)(mod + mr * 6144 + col) + *(const f32x4*)(bada + col);
            const f32x4 sc = *(const f32x4*)(mod + mr * 6144 + 2048 + col) + *(const f32x4*)(bada + 2048 + col);
            const f32x4 g = *(const f32x4*)(ng + col);
            const f32x4 h = (v[j] * rstd) * g * (sc + 1.0f) + sh;
            o8[64 * j] = (unsigned long long)pg8::cvt_pk_bf16(h[0], h[1]) | ((unsigned long long)pg8::cvt_pk_bf16(h[2], h[3]) << 32);
        }
    }
}

struct InProjOrder {
    pg8::StaticOrder so; int G, c;
    __device__ __forceinline__ void init(int G_, int c_) { so.init(MLAT, INW, G_, c_); G = G_; c = c_; }
    __device__ __forceinline__ bool next(int i, pg8::Unit& u) const {
        const long L = (long)i * G + c;
        if (L < 2304) return so.next(i, u);
        const int j = (int)(L - 2304); if (j >= 80) return false;
        const int jj = j % 10; u.pm = 64 + j / 10; u.pn = jj < 8 ? 4 + jj : 8 + jj; return true;
    }
    __device__ __forceinline__ void a_ready(const pg8::Unit&) const {}
    __device__ __forceinline__ void done(const pg8::Unit&) const {}
};

__device__ __forceinline__ void p3_attn(const Args& a, char* lds_generic, int vcu, int G, int wave) {
    unsigned char* ws = a.ws;
    const attn_body::bf16* Q = (const attn_body::bf16*)(ws + WS_Q); const attn_body::bf16* K = (const attn_body::bf16*)(ws + WS_KALL); const attn_body::bf16* V = (const attn_body::bf16*)(ws + WS_VALL);
    for (int u = vcu; u < 2048; u += G) {
        const int xcd = (u & 255) >> 5, c = u & 31, i = u >> 8;
        const int vhd = xcd * 32 + i * 4 + (c >> 3), qb = c & 7;
        const int b = vhd >> 5, h = (vhd >> 2) & 7, s = (vhd >> 1) & 1, vh = vhd & 1;
        attn_body::bf16* O = (attn_body::bf16*)(ws + (s ? WS_O2 : WS_O1));
        attn_body::attn_unit<8>(b, qb, h * 128 + s * 64, h * 128 + s * 64, h * 128 + vh * 64, h * 128 + vh * 64, Q, K, V, O, lds_generic, wave);
    }
}

__device__ __forceinline__ void p4_combine(const Args& a, int vcu, int G, int wave, int lane) {
    unsigned char* ws = a.ws;
    const int gw = vcu * NWAVES + wave, NGW = G * NWAVES;
    const float l1 = wave_sum(a.in[I_LQ1][lane] * a.in[I_LK1][lane]), l2 = wave_sum(a.in[I_LQ2][lane] * a.in[I_LK2][lane]);
    const float lam = expf(l1) - expf(l2) + LAM_INIT;
    const bf16* O1 = (const bf16*)(ws + WS_O1); const bf16* O2 = (const bf16*)(ws + WS_O2); const bf16* GA = (const bf16*)(ws + WS_GA); bf16* AS = (bf16*)(ws + WS_AS);
    const int col = 16 * lane;
    f32x4 sg[4];
#pragma unroll
    for (int j = 0; j < 4; ++j) sg[j] = *(const f32x4*)(a.in[I_SUBLN] + (col & 127) + 4 * j) * (1.0f - LAM_INIT);
    for (int tok = gw; tok < MLAT; tok += NGW) {
        f32x4 o[4], p[4], g[4];
        unpack8(*(const u32x4*)(O1 + (size_t)tok * 1024 + col), o[0], o[1]); unpack8(*(const u32x4*)(O1 + (size_t)tok * 1024 + col + 8), o[2], o[3]);
        unpack8(*(const u32x4*)(O2 + (size_t)tok * 1024 + col), p[0], p[1]); unpack8(*(const u32x4*)(O2 + (size_t)tok * 1024 + col + 8), p[2], p[3]);
        unpack8(*(const u32x4*)(GA + (size_t)tok * 1024 + col), g[0], g[1]); unpack8(*(const u32x4*)(GA + (size_t)tok * 1024 + col + 8), g[2], g[3]);
        float ss = 0.f;
#pragma unroll
        for (int j = 0; j < 4; ++j) { o[j] = o[j] - p[j] * lam; ss += (o[j][0] * o[j][0] + o[j][1] * o[j][1]) + (o[j][2] * o[j][2] + o[j][3] * o[j][3]); }
        ss += __shfl_xor(ss, 1); ss += __shfl_xor(ss, 2); ss += __shfl_xor(ss, 4);
        const float rs = 1.0f / sqrtf(ss * (1.0f / 128.0f) + NORM_EPS);
#pragma unroll
        for (int j = 0; j < 4; ++j) o[j] = o[j] * rs * sg[j] * g[j];
        *(u32x4*)(AS + (size_t)tok * 1536 + col) = pack8(o[0], o[1]); *(u32x4*)(AS + (size_t)tok * 1536 + col + 8) = pack8(o[2], o[3]);
    }
}

__device__ __forceinline__ void p5_ssm_naive(const Args& a, int vcu, int G, int wave, int lane) {
    unsigned char* ws = a.ws;
    const int gw = vcu * NWAVES + wave, NGW = G * NWAVES;
    const float* P = (const float*)(ws + WS_SSMP); const bf16* UCH = (const bf16*)(ws + WS_UCH);
    for (int it = gw; it < 512; it += NGW) {
        const int dir = it & 1, g = (it >> 1) & 31, b = it >> 6;
        const int idx = (dir * 32 + g) * 64 + lane;
        const float ar = P[idx], ai = P[4096 + idx];
        float bbr[16], bbi[16], cr[16], ci[16];
#pragma unroll
        for (int c = 0; c < 16; ++c) { bbr[c] = P[8192 + idx * 16 + c]; bbi[c] = P[8192 + 65536 + idx * 16 + c];
            cr[c] = a.in[I_CRE][((dir * 32 + g) * 16 + c) * 64 + lane]; ci[c] = a.in[I_CIM][((dir * 32 + g) * 16 + c) * 64 + lane]; }
        float* YD = (float*)(ws + (dir ? WS_YB : WS_YF));
        float hr = 0.f, hi = 0.f;
        for (int step = 0; step < KVROWS; ++step) {
            const bool isctx = step < CTXL; const int tt = isctx ? step : step - CTXL;
            const int t = dir ? ((isctx ? CTXL - 1 : SEQ - 1) - tt) : tt;
            const int R = isctx ? 1024 + b * 16 + (t >> 4) : b * 128 + (t >> 4), tl = t & 15;
            const u32x4* up = (const u32x4*)(UCH + ((size_t)(g * 1280 + R) * 256 + tl * 16));
            f32x4 u0, u1, u2, u3; unpack8(up[0], u0, u1); unpack8(up[1], u2, u3);
            float bur = 0.f, bui = 0.f;
#pragma unroll
            for (int e = 0; e < 4; ++e) { bur += bbr[e] * u0[e] + bbr[4 + e] * u1[e] + bbr[8 + e] * u2[e] + bbr[12 + e] * u3[e]; bui += bbi[e] * u0[e] + bbi[4 + e] * u1[e] + bbi[8 + e] * u2[e] + bbi[12 + e] * u3[e]; }
            const float nhr = ar * hr - ai * hi + bur, nhi = ar * hi + ai * hr + bui; hr = nhr; hi = nhi;
            if (!isctx) {
                float yv = 0.f;
#pragma unroll
                for (int c = 0; c < 16; ++c) { const float v = wave_sum(cr[c] * hr - ci[c] * hi); if (lane == c) yv = v; }
                if (lane < 16) YD[((size_t)b * SEQ + t) * 512 + g * 16 + lane] = yv;
            }
        }
    }
}

__device__ __forceinline__ float gelu_tanh(float x) {
    const float z = 0.7978845608028654f * (x + 0.044715f * x * x * x);
    const float th = 1.0f - 2.0f * __builtin_amdgcn_rcpf(1.0f + __builtin_amdgcn_exp2f(2.8853900817779268f * z));
    return 0.5f * x * (1.0f + th);
}
__device__ __forceinline__ void p6_ycombine(const Args& a, int vcu, int G, int wave, int lane) {
    unsigned char* ws = a.ws;
    const int gt = (vcu * NWAVES + wave) * 64 + lane, NGT = G * NWAVES * 64;
    const float* YF = (const float*)(ws + WS_YF); const float* YB = (const float*)(ws + WS_YB); const bf16* UCH = (const bf16*)(ws + WS_UCH); bf16* Y = (bf16*)(ws + WS_Y);
    for (int i = gt; i < MLAT * 64; i += NGT) {
        const int tok = i >> 6, c8 = (i & 63) * 8, g = c8 >> 4, c0 = c8 & 15, b = tok >> 11, t = tok & 2047, R = b * 128 + (t >> 4), tl = t & 15;
        f32x4 u0, u1; unpack8(*(const u32x4*)(UCH + ((size_t)(g * 1280 + R) * 256 + tl * 16 + c0)), u0, u1);
        const f32x4 d0 = *(const f32x4*)(a.in[I_SSMD] + g * 16 + c0), d1 = *(const f32x4*)(a.in[I_SSMD] + g * 16 + c0 + 4);
        f32x4 y0 = *(const f32x4*)(YF + (size_t)tok * 512 + c8) + *(const f32x4*)(YB + (size_t)tok * 512 + c8) + d0 * u0;
        f32x4 y1 = *(const f32x4*)(YF + (size_t)tok * 512 + c8 + 4) + *(const f32x4*)(YB + (size_t)tok * 512 + c8 + 4) + d1 * u1;
#pragma unroll
        for (int e = 0; e < 4; ++e) { y0[e] = gelu_tanh(y0[e]); y1[e] = gelu_tanh(y1[e]); }
        *(u32x4*)(Y + (size_t)tok * 512 + c8) = pack8(y0, y1);
    }
}

__device__ __forceinline__ void p10_final(const Args& a, int vcu, int G, int wave, int lane) {
    const int gw = vcu * NWAVES + wave, NGW = G * NWAVES;
    const float* rowsq = (const float*)(a.ws + WS_CTL + CTL_ROWSQ); const float* fg = a.in[I_FING];
    for (int m = gw; m < MLAT; m += NGW) {
        const float rstd = 1.0f / sqrtf(rowsq[m] * (1.0f / DM) + NORM_EPS);
        f32x4* o = (f32x4*)(a.out + (size_t)m * DM) + lane;
#pragma unroll
        for (int j = 0; j < 8; ++j) { const f32x4 g = *(const f32x4*)(fg + 4 * lane + 256 * j); o[64 * j] = o[64 * j] * rstd * g; }
    }
}

constexpr int N_PHASES = 11;
__global__ void __launch_bounds__(NWAVES * 64, 2) skel_fwd(Args args) {
    extern __shared__ __attribute__((aligned(16))) unsigned char lds_raw[];
    LAS unsigned char* lds = (LAS unsigned char*)lds_raw;
    volatile LAS unsigned* MISC = (volatile LAS unsigned*)(lds + MISC_OFF);
    const int tid = threadIdx.x, wave = __builtin_amdgcn_readfirstlane(tid >> 6);
    const int G = gridDim.x; const int bx = blockIdx.x; const int vcu = (G % 8 == 0) ? (bx % 8) * (G / 8) + bx / 8 : bx;
    unsigned char* ws = args.ws;
    gu32* ctl = (gu32*)(ws + WS_CTL);
    for (int u = tid; u < (LDS_BYTES - LDSCTL_OFF) / 4; u += NWAVES * 64) ((LAS unsigned*)(lds + LDSCTL_OFF))[u] = 0u;
    __syncthreads();
    XcdBarrier bar; bar.bar = (unsigned*)(ctl + CW_BAR); bar.x = 0; bar.st = nullptr;
    if (!MK_PER_PHASE) bar = xcd_barrier_post((unsigned*)(ctl + CW_BAR), MISC + 8);
    const int lo = args.ph_lo, hi = args.ph_hi;
#ifndef ONLY_PHASE
#define ONLY_PHASE -1
#endif
#define IN(k) ((ONLY_PHASE < 0 || ONLY_PHASE == (k)) && lo <= (k) && (k) < hi)
#define SEAM(k) do { if (IN(k) && IN((k) + 1)) xcd_barrier(bar, wave); } while (0)

    if (IN(0)) { const int ln = pg8::lane_id_v(); p0_prologue(args, lds, vcu, G, wave, ln); } SEAM(0);
    if (IN(1)) { const int ln = pg8::lane_id_v(); p1_xn(args, vcu, G, wave, ln); } SEAM(1);
    if (IN(2)) {
        pg8::Gemm g{(const pg8::bf16_t*)(ws + WS_XN), (const pg8::bf16_t*)(ws + WS_WIN), MALL, INW, DM};
        InProjOrder S; S.init(G, bx);
        pg8::EpiInProj E{ws, QSCALE, -1};
        pg8::gemm_phase<pg8::EpiInProj, InProjOrder, PG8_ALIGN, PG8_SP2>(lds, g, S, E, wave);
    } SEAM(2);
    if (IN(3)) { p3_attn(args, (char*)lds_raw, vcu, G, wave); } SEAM(3);
    if (IN(4)) { const int ln = pg8::lane_id_v(); p4_combine(args, vcu, G, wave, ln); } SEAM(4);
    if (IN(5)) { const int ln = pg8::lane_id_v(); p5_ssm_naive(args, vcu, G, wave, ln); } SEAM(5);
    if (IN(6)) { const int ln = pg8::lane_id_v(); p6_ycombine(args, vcu, G, wave, ln); } SEAM(6);
    if (IN(7)) {
        pg8::Gemm g{(const pg8::bf16_t*)(ws + WS_Y), (const pg8::bf16_t*)(ws + WS_WGLU), MLAT, 512, 512};
        pg8::StaticOrder S; S.init(MLAT, 512, G, bx);
        pg8::EpiGlu E{(const pg8::bf16_t*)(ws + WS_Y), (const pg8::bf16_t*)(ws + WS_GS), args.in[I_BGLU], (pg8::bf16_t*)(ws + WS_AS), -1};
        pg8::gemm_phase<pg8::EpiGlu, pg8::StaticOrder, PG8_ALIGN, PG8_SP2>(lds, g, S, E, wave);
    } SEAM(7);
    if (IN(8)) {
        pg8::Gemm g{(const pg8::bf16_t*)(ws + WS_AS), (const pg8::bf16_t*)(ws + WS_WCAT), MLAT, DM, 1536};
        pg8::StaticOrder S; S.init(MLAT, DM, G, bx);
        pg8::EpiMerged E{(const pg8::bf16_t*)(ws + WS_GM), (pg8::bf16_t*)(ws + WS_MG), 16};
        pg8::gemm_phase<pg8::EpiMerged, pg8::StaticOrder, PG8_ALIGN, PG8_SP2>(lds, g, S, E, wave);
    } SEAM(8);
    if (IN(9)) {
        pg8::Gemm g{(const pg8::bf16_t*)(ws + WS_MG), (const pg8::bf16_t*)(ws + WS_WOUT), MLAT, DM, DM};
        pg8::StaticOrder S; S.init(MLAT, DM, G, bx);
        pg8::EpiOut E{args.in[I_X], (const float*)(ws + WS_CTL + CTL_MOD), args.in[I_BADA], args.out, (float*)(ws + WS_CTL + CTL_ROWSQ), -1};
        pg8::gemm_phase<pg8::EpiOut, pg8::StaticOrder, PG8_ALIGN, PG8_SP2>(lds, g, S, E, wave);
    } SEAM(9);
    if (IN(10)) { const int ln = pg8::lane_id_v(); p10_final(args, vcu, G, wave, ln); }
#undef IN
#undef SEAM
}

extern "C" void kernel_launch(void* const* d_in, const int* in_sizes, int n_in, void* d_out, int out_size, void* d_ws, size_t ws_size, hipStream_t stream) {
    static int grid = 0;
    if (grid == 0) {
        if (n_in != 27 || out_size != MLAT * DM || ws_size < WS_END) { fprintf(stderr, "kernel_launch: unexpected shapes (n_in %d, out %d, ws %zu); nothing launched\n", n_in, out_size, ws_size); grid = -1; return; }
        int dev = 0, cus = 0, per_cu = 0;
        if (hipGetDevice(&dev) != hipSuccess || hipDeviceGetAttribute(&cus, hipDeviceAttributeMultiprocessorCount, dev) != hipSuccess) { grid = -1; return; }
        if (hipFuncSetAttribute((const void*)skel_fwd, hipFuncAttributeMaxDynamicSharedMemorySize, LDS_BYTES) != hipSuccess) { fprintf(stderr, "kernel_launch: hipFuncSetAttribute failed\n"); grid = -1; return; }
        if (hipOccupancyMaxActiveBlocksPerMultiprocessor(&per_cu, (const void*)skel_fwd, NWAVES * 64, LDS_BYTES) != hipSuccess || per_cu < 1) { fprintf(stderr, "kernel_launch: occupancy query says %d blocks per CU\n", per_cu); }
        (void)hipGetLastError();
        grid = cus;
    }
    if (grid < 0) return;
    if (hipMemsetAsync((char*)d_ws + WS_CTL, 0, CTL_ZERO_BYTES, stream) != hipSuccess) { fprintf(stderr, "kernel_launch: hipMemsetAsync failed\n"); return; }
    Args a{};
    for (int i = 0; i < 27; ++i) a.in[i] = (const float*)d_in[i];
    a.out = (float*)d_out; a.ws = (unsigned char*)d_ws;
#if MK_PER_PHASE
    for (int p = 0; p < N_PHASES; ++p) { a.ph_lo = p; a.ph_hi = p + 1; a.li = 0; hipLaunchKernelGGL(skel_fwd, dim3(grid), dim3(NWAVES * 64), LDS_BYTES, stream, a); }
#else
    a.ph_lo = 0; a.ph_hi = N_PHASES; a.li = 0;
    hipLaunchKernelGGL(skel_fwd, dim3(grid), dim3(NWAVES * 64), LDS_BYTES, stream, a);
#endif
    const hipError_t le = hipPeekAtLastError();
    if (le != hipSuccess) fprintf(stderr, "kernel_launch: launch failed: %s\n", hipGetErrorName(le));
}
```

```cpp
#include <hip/hip_runtime.h>
#include <hip/hip_bf16.h>
#include <cstdio>
#include <cstdint>
#include <cmath>

constexpr size_t MiB = 1u << 20;
constexpr size_t WS_CTL = 0, CTL_ZERO_BYTES = 1 * MiB;
constexpr int CW_BAR = 4096;
constexpr size_t CTL_MOD = 262144, CTL_ROWSQ = 524288;
constexpr size_t WS_WIN = 2 * MiB;
constexpr size_t WS_WCAT = 38 * MiB;
constexpr size_t WS_WOUT = 44 * MiB;
constexpr size_t WS_WGLU = 52 * MiB;
constexpr size_t WS_ROPE = 52 * MiB + 512 * 1024;
constexpr size_t WS_SSMP = 53 * MiB;
constexpr int SSMP_APOW = 8192 + 131072;
constexpr size_t WS_KTAB = 55 * MiB;
constexpr size_t WS_BTY = 57 * MiB;
constexpr size_t WS_BTS = 65 * MiB;
constexpr size_t WS_A2 = 70 * MiB;
constexpr size_t WS_GS = 110 * MiB;
constexpr size_t WS_GA = 126 * MiB;
constexpr size_t WS_Q = 158 * MiB;
constexpr size_t WS_KALL = 190 * MiB;
constexpr size_t WS_VALL = 226 * MiB;
constexpr size_t WS_GM = 262 * MiB;
constexpr size_t WS_XN = 390 * MiB;
constexpr size_t WS_O1 = 390 * MiB, WS_O2 = 422 * MiB;
constexpr size_t WS_SBUF = 390 * MiB;
constexpr size_t WS_MG = 390 * MiB;
constexpr size_t WS_Y = 462 * MiB;
constexpr size_t WS_AS = 158 * MiB;
constexpr size_t WS_END = 478 * MiB;

namespace pg8 {
#define PG8_LAS __attribute__((address_space(3)))
typedef unsigned short bf16_t;
typedef short bf16x8 __attribute__((ext_vector_type(8)));
typedef float f32x4 __attribute__((ext_vector_type(4)));
typedef unsigned u32x4 __attribute__((ext_vector_type(4)));
constexpr int BM = 256, BK = 64, HALF = 128, HTB = HALF * BK * 2  , STAGE_BYTES = 8 * HTB, NXCD = 8, WGM = 8;

__host__ __device__ __forceinline__ int lds_byte(int r, int c) { const int st = (r >> 4) * 2 + (c >> 5), rr = r & 15, cc = c & 31, ob = rr * 64 + cc * 2; return st * 1024 + (ob ^ (((ob >> 9) & 1) << 5)); }
__host__ __device__ __forceinline__ void stage_rc(int b, int& R, int& C) { const int st = b / 1024, sb = b % 1024, swz = sb ^ (((sb >> 9) & 1) << 5); R = (st >> 1) * 16 + swz / 64; C = (st & 1) * 32 + (swz % 64) / 2; }
__host__ __device__ __forceinline__ int perm32(int rho) { const int n = rho >> 4, i = rho & 15; return 8 * (i >> 2) + 4 * n + (i & 3); }

struct Unit { int pm, pn; };
struct Gemm { const bf16_t* A; const bf16_t* Bt; int M, N, K, lda, ldb; };

struct StaticOrder {
    int nM, nN, nwg, G, c;
    __host__ __device__ void init(int M, int N, int G_, int c_) { nM = M / BM; nN = N / BM; nwg = nM * nN; G = G_; c = c_; }
    __host__ __device__ bool next(int i, Unit& u) const {
        const long L = (long)i * G + c; if (L >= nwg) return false;
        int wgid = (int)L; { const int q = nwg / NXCD, r = nwg % NXCD, xcd = wgid % NXCD, off = wgid / NXCD; wgid = (xcd < r ? xcd * (q + 1) : r * (q + 1) + (xcd - r) * q) + off; }
        const int nig = WGM * nN, gid = wgid / nig, fm = gid * WGM, gsz = (nM - fm) < WGM ? (nM - fm) : WGM;
        u.pm = fm + ((wgid % nig) % gsz); u.pn = (wgid % nig) / gsz; return true;
    }
    __device__ __forceinline__ void a_ready(const Unit&) const {}
    __device__ __forceinline__ void done(const Unit&) const {}
};


__device__ __forceinline__ unsigned cvt_pk_bf16(float lo, float hi) { unsigned r; asm volatile("v_cvt_pk_bf16_f32 %0, %1, %2" : "=v"(r) : "v"(lo), "v"(hi)); return r; }
__device__ __forceinline__ int lane_id_v() { int l; asm volatile("v_mbcnt_lo_u32_b32 %0, -1, 0\n\tv_mbcnt_hi_u32_b32 %0, -1, %0" : "=v"(l)); return l; }
__device__ __forceinline__ float bf_lo(unsigned u) { return __uint_as_float(u << 16); }
__device__ __forceinline__ float bf_hi(unsigned u) { return __uint_as_float(u & 0xffff0000u); }
__device__ __forceinline__ void unpack8(const u32x4 w, f32x4& a, f32x4& b) { a = (f32x4){bf_lo(w.x), bf_hi(w.x), bf_lo(w.y), bf_hi(w.y)}; b = (f32x4){bf_lo(w.z), bf_hi(w.z), bf_lo(w.w), bf_hi(w.w)}; }
__device__ __forceinline__ u32x4 pack8(const f32x4 a, const f32x4 b) { u32x4 w; w.x = cvt_pk_bf16(a[0], a[1]); w.y = cvt_pk_bf16(a[2], a[3]); w.z = cvt_pk_bf16(b[0], b[1]); w.w = cvt_pk_bf16(b[2], b[3]); return w; }
__device__ __forceinline__ float sigmoid_f(float x) { return __builtin_amdgcn_rcpf(1.0f + __builtin_amdgcn_exp2f(-1.4426950408889634f * x)); }
__device__ __forceinline__ f32x4 sigmoid4(f32x4 v) { return (f32x4){sigmoid_f(v[0]), sigmoid_f(v[1]), sigmoid_f(v[2]), sigmoid_f(v[3])}; }
__device__ __forceinline__ f32x4 silu4(f32x4 v) { return v * sigmoid4(v); }
__device__ __forceinline__ f32x4 shflx32(f32x4 v) { return (f32x4){__shfl_xor(v[0], 32), __shfl_xor(v[1], 32), __shfl_xor(v[2], 32), __shfl_xor(v[3], 32)}; }

struct EpiInProj {
    static constexpr bool PERM = true, AFTER_DRAIN = false, HAS_MID = false;
    unsigned char* ws; float c2; int tmid;
    __device__ __forceinline__ void mid(f32x4 (&)[2][2][4][2], const Unit&, int, int, int, int) const {}
    __device__ __forceinline__ void operator()(const f32x4 (&acc)[2][2][4][2], const Unit& u, int wr, int wc, int fr, int fq) const {
        const int pn = u.pn, pm = u.pm;
        const bool isctx = pm >= 64;
        const int b = isctx ? pm - 64 : pm >> 3;
        const int t0 = isctx ? 0 : (pm & 7) * 256;
        const int colw = wc * 32 + 8 * fq;
        if (pn < 8) {
            const bool isq = pn < 4;
            bf16_t* base = (bf16_t*)(ws + (isq ? WS_Q : WS_KALL));
            const float* rope_c = (const float*)(ws + WS_ROPE); const float* rope_s = rope_c + 1024;
            const int ct = (isq ? pn : pn - 4) * 256 + colw;
            const float sgn = fq < 2 ? -1.f : 1.f, osc = isq ? c2 : 1.f;
#pragma unroll
            for (int ai = 0; ai < 2; ++ai)
#pragma unroll
                for (int m = 0; m < 4; ++m) {
                    const int rl = ai * HALF + wr * 64 + m * 16 + fr, t = t0 + rl;
                    const size_t grow = isq ? (size_t)(b * 2048 + t) : (size_t)(b * 2304 + (isctx ? 2048 : 0) + t);
                    f32x4 c0 = (f32x4){1.f, 1.f, 1.f, 1.f}, c1 = c0, s0 = (f32x4){0.f, 0.f, 0.f, 0.f}, s1 = s0;
                    if (!isctx) { const int pos = (wc & 1) ? (t & 63) : (t >> 6); const float* pc = rope_c + pos * 16 + 8 * (fq & 1); const float* ps = rope_s + pos * 16 + 8 * (fq & 1);
                        c0 = *(const f32x4*)pc; c1 = *(const f32x4*)(pc + 4); s0 = *(const f32x4*)ps * sgn; s1 = *(const f32x4*)(ps + 4) * sgn; }
#pragma unroll
                    for (int bj = 0; bj < 2; ++bj) {
                        const f32x4 v0 = acc[ai][bj][m][0], v1 = acc[ai][bj][m][1];
                        const f32x4 p0 = shflx32(v0), p1 = shflx32(v1);
                        const f32x4 o0 = (v0 * c0 + p0 * s0) * osc, o1 = (v1 * c1 + p1 * s1) * osc;
                        *(u32x4*)(base + grow * 1024 + ct + bj * HALF) = pack8(o0, o1);
                    }
                    asm volatile("" ::: "memory");
                }
        } else if (pn < 12) {
            const int ct = (pn - 8) * 256 + colw;
#pragma unroll
            for (int ai = 0; ai < 2; ++ai)
#pragma unroll
                for (int m = 0; m < 4; ++m) {
                    const int rl = ai * HALF + wr * 64 + m * 16 + fr, t = t0 + rl;
                    const size_t grow = (size_t)(b * 2304 + (isctx ? 2048 : 0) + t);
#pragma unroll
                    for (int bj = 0; bj < 2; ++bj) *(u32x4*)((bf16_t*)(ws + WS_VALL) + grow * 1024 + ct + bj * HALF) = pack8(acc[ai][bj][m][0], acc[ai][bj][m][1]);
                }
        } else if (pn == 16 || pn == 17) {
#pragma unroll
            for (int ai = 0; ai < 2; ++ai)
#pragma unroll
                for (int m = 0; m < 4; ++m) {
                    const int rl = ai * HALF + wr * 64 + m * 16 + fr, t = t0 + rl;
                    const int R = isctx ? 1024 + b * 16 + (t >> 4) : b * 128 + (t >> 4), tl = t & 15;
#pragma unroll
                    for (int bj = 0; bj < 2; ++bj) {
                        const int g = (pn - 16) * 16 + bj * 8 + wc * 2 + (fq >> 1), c0 = 8 * (fq & 1);
                        *(u32x4*)((bf16_t*)(ws + WS_A2) + ((size_t)(g * 1280 + R) * 512 + tl * 16 + c0)) = pack8(acc[ai][bj][m][0], acc[ai][bj][m][1]);
                    }
                }
        } else {
            size_t boff; int pitch, ct; bool sil;
            if (pn < 16) { boff = WS_GA; pitch = 1024; ct = (pn - 12) * 256; sil = true; }
            else if (pn < 20) { boff = WS_GS; pitch = 512; ct = (pn - 18) * 256; sil = true; }
            else { boff = WS_GM; pitch = 4096; ct = (pn - 20) * 256; sil = false; }
            bf16_t* base = (bf16_t*)(ws + boff);
            ct += colw;
#pragma unroll
            for (int ai = 0; ai < 2; ++ai)
#pragma unroll
                for (int m = 0; m < 4; ++m) {
                    const size_t grow = (size_t)pm * 256 + ai * HALF + wr * 64 + m * 16 + fr;
#pragma unroll
                    for (int bj = 0; bj < 2; ++bj) {
                        const f32x4 v0 = acc[ai][bj][m][0], v1 = acc[ai][bj][m][1];
                        const f32x4 g0 = sigmoid4(v0), g1 = sigmoid4(v1);
                        const f32x4 o0 = sil ? v0 * g0 : g0, o1 = sil ? v1 * g1 : g1;
                        *(u32x4*)(base + grow * pitch + ct + bj * HALF) = pack8(o0, o1);
                    }
                    asm volatile("" ::: "memory");
                }
        }
    }
};

struct EpiGlu {
    static constexpr bool PERM = true, AFTER_DRAIN = false, HAS_MID = false;
    const bf16_t *Y, *GS; const float* bglu; bf16_t* AS; int tmid;
    __device__ __forceinline__ void mid(f32x4 (&)[2][2][4][2], const Unit&, int, int, int, int) const {}
    __device__ __forceinline__ void operator()(const f32x4 (&acc)[2][2][4][2], const Unit& u, int wr, int wc, int fr, int fq) const {
        const int col0 = u.pn * BM + wc * 32 + 8 * fq;
        f32x4 bv[2][2];
#pragma unroll
        for (int bj = 0; bj < 2; ++bj)
#pragma unroll
            for (int n = 0; n < 2; ++n) bv[bj][n] = *(const f32x4*)(bglu + col0 + bj * HALF + 4 * n);
#pragma unroll
        for (int ai = 0; ai < 2; ++ai)
#pragma unroll
            for (int m = 0; m < 4; ++m) {
                const size_t row = (size_t)u.pm * BM + ai * HALF + wr * 64 + m * 16 + fr;
#pragma unroll
                for (int bj = 0; bj < 2; ++bj) {
                    const int col = col0 + bj * HALF;
                    f32x4 y0, y1, g0, g1; unpack8(*(const u32x4*)(Y + row * 512 + col), y0, y1); unpack8(*(const u32x4*)(GS + row * 512 + col), g0, g1);
                    const f32x4 o0 = y0 * sigmoid4(acc[ai][bj][m][0] + bv[bj][0]) * g0, o1 = y1 * sigmoid4(acc[ai][bj][m][1] + bv[bj][1]) * g1;
                    *(u32x4*)(AS + row * 1536 + 1024 + col) = pack8(o0, o1);
                }
                asm volatile("" ::: "memory");
            }
    }
};

struct EpiMerged {
    static constexpr bool PERM = true, AFTER_DRAIN = false, HAS_MID = true;
    const bf16_t* GM; bf16_t* MG; int tmid;
    __device__ __forceinline__ void mid(f32x4 (&acc)[2][2][4][2], const Unit& u, int wr, int wc, int fr, int fq) const {
        unsigned opq = 0; asm volatile("" : "+v"(opq));
        const unsigned col0 = u.pn * BM + wc * 32 + 8 * fq + opq;
#pragma unroll
        for (int ai = 0; ai < 2; ++ai)
#pragma unroll
            for (int m = 0; m < 4; ++m) {
                const unsigned row = u.pm * BM + ai * HALF + wr * 64 + m * 16 + fr;
#pragma unroll
                for (int bj = 0; bj < 2; ++bj) {
                    const unsigned col = col0 + bj * HALF;
                    f32x4 a0, a1, s0, s1; unpack8(*(const u32x4*)(GM + (row * 4096u + col)), a0, a1); unpack8(*(const u32x4*)(GM + (row * 4096u + 2048u + col)), s0, s1);
#pragma unroll
                    for (int e = 0; e < 4; ++e) { acc[ai][bj][m][0][e] *= a0[e] * __builtin_amdgcn_rcpf(fmaxf(s0[e], 1e-30f)); acc[ai][bj][m][1][e] *= a1[e] * __builtin_amdgcn_rcpf(fmaxf(s1[e], 1e-30f)); }
                }
                asm volatile("" ::: "memory");
            }
    }
    __device__ __forceinline__ void operator()(const f32x4 (&acc)[2][2][4][2], const Unit& u, int wr, int wc, int fr, int fq) const {
        const int col0 = u.pn * BM + wc * 32 + 8 * fq;
#pragma unroll
        for (int ai = 0; ai < 2; ++ai)
#pragma unroll
            for (int m = 0; m < 4; ++m) {
                const size_t row = (size_t)u.pm * BM + ai * HALF + wr * 64 + m * 16 + fr;
#pragma unroll
                for (int bj = 0; bj < 2; ++bj) {
                    const int col = col0 + bj * HALF;
                    f32x4 s0, s1; unpack8(*(const u32x4*)(GM + row * 4096 + 2048 + col), s0, s1);
                    *(u32x4*)(MG + row * 2048 + col) = pack8(acc[ai][bj][m][0] * s0, acc[ai][bj][m][1] * s1);
                }
                asm volatile("" ::: "memory");
            }
    }
};

struct EpiOut {
    static constexpr bool PERM = false, AFTER_DRAIN = false, HAS_MID = false;
    const float *x, *mod, *bada; float* out; float* rowsq; int tmid;
    __device__ __forceinline__ void mid(f32x4 (&)[2][2][4][2], const Unit&, int, int, int, int) const {}
    __device__ __forceinline__ void operator()(const f32x4 (&acc)[2][2][4][2], const Unit& u, int wr, int wc, int fr, int fq) const {
        const int col0 = u.pn * BM + wc * 32 + 4 * fq, b = u.pm >> 3;
        f32x4 gv[2][2];
#pragma unroll
        for (int bj = 0; bj < 2; ++bj)
#pragma unroll
            for (int n = 0; n < 2; ++n) gv[bj][n] = *(const f32x4*)(mod + b * 6144 + 4096 + col0 + bj * HALF + n * 16) + *(const f32x4*)(bada + 4096 + col0 + bj * HALF + n * 16);
#pragma unroll
        for (int ai = 0; ai < 2; ++ai)
#pragma unroll
            for (int m = 0; m < 4; ++m) {
                const size_t row = (size_t)u.pm * BM + ai * HALF + wr * 64 + m * 16 + fr; float ss = 0.f;
#pragma unroll
                for (int bj = 0; bj < 2; ++bj)
#pragma unroll
                    for (int n = 0; n < 2; ++n) {
                        const size_t off = row * 2048 + col0 + bj * HALF + n * 16;
                        const f32x4 o = *(const f32x4*)(x + off) + gv[bj][n] * acc[ai][bj][m][n];
                        *(f32x4*)(out + off) = o; ss += (o[0] * o[0] + o[1] * o[1]) + (o[2] * o[2] + o[3] * o[3]);
                    }
                ss += __shfl_xor(ss, 16); ss += __shfl_xor(ss, 32);
                if (fq == 0) atomicAdd(rowsq + row, ss);
                asm volatile("" ::: "memory");
            }
    }
};

__device__ __forceinline__ float gelu_tanh(float x) {
    const float z = 0.7978845608028654f * (x + 0.044715f * x * x * x);
    const float th = 1.0f - 2.0f * __builtin_amdgcn_rcpf(1.0f + __builtin_amdgcn_exp2f(2.8853900817779268f * z));
    return 0.5f * x * (1.0f + th);
}
struct EpiS {
    static constexpr bool PERM = false, AFTER_DRAIN = false, HAS_MID = false;
    float* S; int tmid;
    __device__ __forceinline__ void mid(f32x4 (&)[2][2][4][2], const Unit&, int, int, int, int) const {}
    __device__ __forceinline__ void operator()(const f32x4 (&acc)[2][2][4][2], const Unit& u, int wr, int wc, int fr, int fq) const {
        const int col0 = wc * 32 + 4 * fq;
#pragma unroll
        for (int ai = 0; ai < 2; ++ai)
#pragma unroll
            for (int m = 0; m < 4; ++m) { float* rowp = S + ((size_t)u.pm * BM + ai * HALF + wr * 64 + m * 16 + fr) * 256 + col0;
#pragma unroll
                for (int bj = 0; bj < 2; ++bj)
#pragma unroll
                    for (int n = 0; n < 2; ++n) *(f32x4*)(rowp + bj * HALF + n * 16) = acc[ai][bj][m][n]; }
    }
};
struct EpiY {
    static constexpr bool PERM = true, AFTER_DRAIN = false, HAS_MID = false;
    bf16_t* Y; int tmid;
    __device__ __forceinline__ void mid(f32x4 (&)[2][2][4][2], const Unit&, int, int, int, int) const {}
    __device__ __forceinline__ void operator()(const f32x4 (&acc)[2][2][4][2], const Unit& u, int wr, int wc, int fr, int fq) const {
        const int g = u.pn, rt = u.pm - 5 * g;
#pragma unroll
        for (int ai = 0; ai < 2; ++ai)
#pragma unroll
            for (int m = 0; m < 4; ++m) {
                const int R = rt * 256 + ai * HALF + wr * 64 + m * 16 + fr, b = R >> 7, k = R & 127;
#pragma unroll
                for (int bj = 0; bj < 2; ++bj) {
                    const int col8 = bj * HALF + wc * 32 + 8 * fq, t = col8 >> 4, c0 = col8 & 15;
                    f32x4 y0 = acc[ai][bj][m][0], y1 = acc[ai][bj][m][1];
#pragma unroll
                    for (int e = 0; e < 4; ++e) { y0[e] = gelu_tanh(y0[e]); y1[e] = gelu_tanh(y1[e]); }
                    *(u32x4*)(Y + ((size_t)(b * 2048 + k * 16 + t) * 512 + g * 16 + c0)) = pack8(y0, y1);
                }
                asm volatile("" ::: "memory");
            }
    }
};
template <class Epi, class Sched, bool ALIGN_EPI = false, bool SP2 = false>
__device__ __forceinline__ void gemm_phase(PG8_LAS unsigned char* lds, const Gemm g, const Sched& S, const Epi& E, const int wid) {
    const int lane = lane_id_v(), tid = wid * 64 + lane, wr = wid >> 2, wc = wid & 3, fr = lane & 15, fq = lane >> 4;
    const int K = g.K, nt = K / BK;
    unsigned voffA[2], voffB[2];
#pragma unroll
    for (int i = 0; i < 2; ++i) { int R, C; stage_rc(tid * 16 + i * 8192, R, C); const int Rb = Epi::PERM ? ((R & ~31) + perm32(R & 31)) : R;
        voffA[i] = (unsigned)(R * g.lda + C) * 2u; voffB[i] = (unsigned)(Rb * g.ldb + C) * 2u; }
    const size_t kstep = (size_t)(BK * 2);
    const size_t hstepA = (size_t)HALF * g.lda * 2, hstepB = (size_t)HALF * g.ldb * 2;
    const size_t tstepA = 2 * hstepA, tstepB = 2 * hstepB;
    const unsigned ldsw = (unsigned)wid * 1024u;
    const int aoff = lds_byte(wr * 64 + fr, fq * 8), boff = lds_byte(wc * 32 + fr, fq * 8);
#define PG8_SA(b, h) (((b) * 2 + (h)) * HTB)
#define PG8_SB(b, h) ((4 + (b) * 2 + (h)) * HTB)
#define PG8_STAGE(bufoff, gbase, voff) do { _Pragma("unroll") for (int _i = 0; _i < 2; ++_i) \
        __builtin_amdgcn_global_load_lds((const unsigned*)((const char*)(gbase) + (voff)[_i]), (PG8_LAS unsigned*)(lds + (bufoff) + ldsw + _i * 8192), 16, 0, 0); } while (0)
#define PG8_LDA(dst, b, h) do { _Pragma("unroll") for (int m = 0; m < 4; ++m) _Pragma("unroll") for (int k = 0; k < 2; ++k) dst[m][k] = *(const PG8_LAS bf16x8*)(lds + PG8_SA(b, h) + aoff + m * 2048 + k * 1024); } while (0)
#define PG8_LDB(dst, b, h) do { _Pragma("unroll") for (int n = 0; n < 2; ++n) _Pragma("unroll") for (int k = 0; k < 2; ++k) dst[n][k] = *(const PG8_LAS bf16x8*)(lds + PG8_SB(b, h) + boff + n * 2048 + k * 1024); } while (0)
#define PG8_MMA(ai, bj, At, Bt) do { __builtin_amdgcn_s_setprio(1); _Pragma("unroll") for (int m = 0; m < 4; ++m) _Pragma("unroll") for (int n = 0; n < 2; ++n) _Pragma("unroll") for (int k = 0; k < 2; ++k) \
        acc[ai][bj][m][n] = __builtin_amdgcn_mfma_f32_16x16x32_bf16(Bt[n][k], At[m][k], acc[ai][bj][m][n], 0, 0, 0); __builtin_amdgcn_s_setprio(0); } while (0)
#define PG8_WAIT_V(n) asm volatile("s_waitcnt vmcnt(" #n ")" ::: "memory")
#define PG8_WAIT_L(n) asm volatile("s_waitcnt lgkmcnt(" #n ")" ::: "memory")
#define PG8_BAR __builtin_amdgcn_s_barrier()
#define PG8_SCHED __builtin_amdgcn_sched_barrier(0)
    Unit cur, nxt; int ui = 0;
    if (!S.next(0, cur)) return;
    f32x4 acc[2][2][4][2];
#pragma unroll
    for (int a = 0; a < 2; ++a)
#pragma unroll
        for (int b = 0; b < 2; ++b)
#pragma unroll
            for (int m = 0; m < 4; ++m)
#pragma unroll
                for (int n = 0; n < 2; ++n) acc[a][b][m][n] = (f32x4){0.f, 0.f, 0.f, 0.f};
    bf16x8 At[4][2], B0[2][2], B1[2][2];
    const char* cA = (const char*)g.A + (size_t)cur.pm * tstepA; const char* cB = (const char*)g.Bt + (size_t)cur.pn * tstepB;
    S.a_ready(cur);
    if constexpr (SP2) {
        PG8_STAGE(PG8_SB(0, 0), cB, voffB); PG8_STAGE(PG8_SB(0, 1), cB + hstepB, voffB); PG8_STAGE(PG8_SA(0, 0), cA, voffA); PG8_STAGE(PG8_SA(0, 1), cA + hstepA, voffA);
        if (wr == 1) PG8_BAR;
        PG8_WAIT_V(2); PG8_BAR;
        PG8_STAGE(PG8_SB(1, 0), cB + kstep, voffB); PG8_STAGE(PG8_SA(1, 0), cA + kstep, voffA); PG8_STAGE(PG8_SB(1, 1), cB + hstepB + kstep, voffB);
        PG8_WAIT_V(6); PG8_BAR;
    } else {
        PG8_STAGE(PG8_SB(0, 0), cB, voffB); PG8_STAGE(PG8_SA(0, 0), cA, voffA); PG8_STAGE(PG8_SB(0, 1), cB + hstepB, voffB); PG8_STAGE(PG8_SA(0, 1), cA + hstepA, voffA);
        if (wr == 1) PG8_BAR;
        PG8_WAIT_V(4); PG8_BAR;
        PG8_STAGE(PG8_SB(1, 0), cB + kstep, voffB); PG8_STAGE(PG8_SA(1, 0), cA + kstep, voffA); PG8_STAGE(PG8_SB(1, 1), cB + hstepB + kstep, voffB);
        PG8_WAIT_V(6); PG8_BAR;
    }
    for (;;) {
        const bool has_next = S.next(ui + 1, nxt);
        const char* nA = has_next ? (const char*)g.A + (size_t)nxt.pm * tstepA : cA; const char* nB = has_next ? (const char*)g.Bt + (size_t)nxt.pn * tstepB : cB;
        for (int t = 0; t < nt; t += 2) {
            const bool last = (t == nt - 2);
            const char* a1 = cA + (size_t)(t + 1) * kstep;
            const char* a2 = last ? nA : cA + (size_t)(t + 2) * kstep; const char* b2 = last ? nB : cB + (size_t)(t + 2) * kstep;
            const char* a3 = a2 + kstep; const char* b3 = b2 + kstep;
            if (last && has_next) S.a_ready(nxt);
            if constexpr (Epi::HAS_MID) { if (t == E.tmid) E.mid(acc, cur, wr, wc, fr, fq); }
            if constexpr (SP2) {
            PG8_LDB(B0, 0, 0); PG8_LDB(B1, 0, 1); PG8_SCHED; PG8_LDA(At, 0, 0); PG8_STAGE(PG8_SA(1, 1), a1 + hstepA, voffA);
            PG8_WAIT_V(8); PG8_WAIT_L(0); PG8_BAR; PG8_MMA(0, 0, At, B0); PG8_MMA(0, 1, At, B1); PG8_BAR; PG8_SCHED;
            PG8_LDA(At, 0, 1); PG8_STAGE(PG8_SB(0, 0), b2, voffB); PG8_STAGE(PG8_SB(0, 1), b2 + hstepB, voffB); PG8_STAGE(PG8_SA(0, 0), a2, voffA);
            PG8_WAIT_V(8); PG8_WAIT_L(0); PG8_BAR; PG8_MMA(1, 0, At, B0); PG8_MMA(1, 1, At, B1); PG8_BAR; PG8_SCHED;
            PG8_LDB(B0, 1, 0); PG8_LDB(B1, 1, 1); PG8_SCHED; PG8_LDA(At, 1, 0); PG8_STAGE(PG8_SA(0, 1), a2 + hstepA, voffA);
            PG8_WAIT_V(8); PG8_WAIT_L(0); PG8_BAR; PG8_MMA(0, 0, At, B0); PG8_MMA(0, 1, At, B1); PG8_BAR; PG8_SCHED;
            PG8_LDA(At, 1, 1); PG8_STAGE(PG8_SB(1, 0), b3, voffB); PG8_STAGE(PG8_SB(1, 1), b3 + hstepB, voffB); PG8_STAGE(PG8_SA(1, 0), a3, voffA);
            PG8_WAIT_V(8); PG8_WAIT_L(0); PG8_BAR; PG8_MMA(1, 0, At, B0); PG8_MMA(1, 1, At, B1); PG8_BAR; PG8_SCHED;
            } else {
            PG8_LDB(B0, 0, 0); PG8_SCHED; PG8_LDA(At, 0, 0); PG8_STAGE(PG8_SA(1, 1), a1 + hstepA, voffA);
            PG8_WAIT_L(8); PG8_BAR; PG8_WAIT_L(0); PG8_MMA(0, 0, At, B0); PG8_BAR; PG8_SCHED;
            PG8_LDB(B1, 0, 1); PG8_STAGE(PG8_SB(0, 0), b2, voffB);
            PG8_BAR; PG8_WAIT_L(0); PG8_MMA(0, 1, At, B1); PG8_BAR;
            PG8_LDA(At, 0, 1); PG8_STAGE(PG8_SA(0, 0), a2, voffA);
            PG8_BAR; PG8_WAIT_L(0); PG8_MMA(1, 0, At, B0); PG8_BAR; PG8_SCHED;
            PG8_STAGE(PG8_SB(0, 1), b2 + hstepB, voffB);
            PG8_WAIT_V(6); PG8_BAR; PG8_MMA(1, 1, At, B1); PG8_BAR;
            PG8_LDB(B0, 1, 0); PG8_SCHED; PG8_LDA(At, 1, 0); PG8_STAGE(PG8_SA(0, 1), a2 + hstepA, voffA);
            PG8_WAIT_L(8); PG8_BAR; PG8_WAIT_L(0); PG8_MMA(0, 0, At, B0); PG8_BAR; PG8_SCHED;
            PG8_LDB(B1, 1, 1); PG8_STAGE(PG8_SB(1, 0), b3, voffB);
            PG8_BAR; PG8_WAIT_L(0); PG8_MMA(0, 1, At, B1); PG8_BAR;
            PG8_LDA(At, 1, 1); PG8_STAGE(PG8_SA(1, 0), a3, voffA);
            PG8_BAR; PG8_WAIT_L(0); PG8_MMA(1, 0, At, B0); PG8_BAR; PG8_SCHED;
            PG8_STAGE(PG8_SB(1, 1), b3 + hstepB, voffB);
            PG8_WAIT_V(6); PG8_BAR; PG8_MMA(1, 1, At, B1); PG8_BAR;
            }
        }
        if constexpr (ALIGN_EPI) { if (wr == 0) PG8_BAR; }
        if constexpr (!Epi::AFTER_DRAIN) { E(acc, cur, wr, wc, fr, fq); S.done(cur); }
        if (!has_next) break;
#pragma unroll
        for (int a = 0; a < 2; ++a)
#pragma unroll
            for (int b = 0; b < 2; ++b)
#pragma unroll
                for (int m = 0; m < 4; ++m)
#pragma unroll
                    for (int n = 0; n < 2; ++n) acc[a][b][m][n] = (f32x4){0.f, 0.f, 0.f, 0.f};
        cur = nxt; cA = nA; cB = nB; ++ui;
        if constexpr (ALIGN_EPI) { if (wr == 1) PG8_BAR; }
    }
    PG8_WAIT_V(0);
    if constexpr (!ALIGN_EPI) { if (wr == 0) PG8_BAR; }
    PG8_BAR;
    if constexpr (Epi::AFTER_DRAIN) { E.fused(acc, cur, wr, wc, fr, fq, lds, wid, lane); S.done(cur); }
#undef PG8_SA
#undef PG8_SB
#undef PG8_STAGE
#undef PG8_LDA
#undef PG8_LDB
#undef PG8_MMA
#undef PG8_WAIT_V
#undef PG8_WAIT_L
#undef PG8_BAR
#undef PG8_SCHED
}
}

#ifndef PG8_SP2
#define PG8_SP2 true
#endif
#ifndef PG8_ALIGN
#define PG8_ALIGN true
#endif
#define GAS __attribute__((address_space(1)))
#define LAS __attribute__((address_space(3)))
typedef unsigned short bf16;
typedef unsigned v4u __attribute__((ext_vector_type(4)));
typedef float f32x4 __attribute__((ext_vector_type(4)));
typedef short bf16x8 __attribute__((ext_vector_type(8)));
typedef GAS unsigned gu32;
typedef GAS unsigned long long gu64;
#define RLX_AGENT __ATOMIC_RELAXED, __HIP_MEMORY_SCOPE_AGENT
#define LDS_WAIT() asm volatile("s_waitcnt lgkmcnt(0)" ::: "memory")
#define VM_WAIT() asm volatile("s_waitcnt vmcnt(0)" ::: "memory")
__device__ __forceinline__ unsigned long long rt() { return __builtin_amdgcn_s_memrealtime(); }
__device__ __forceinline__ unsigned f2bf(float f) { unsigned u = __builtin_bit_cast(unsigned, f); return (u + 0x7fffu + ((u >> 16) & 1u)) >> 16; }
__device__ __forceinline__ unsigned pk2(float lo, float hi) { return f2bf(lo) | (f2bf(hi) << 16); }

#define XB_TMO      128
#define XB_XCNT(j)  (256  + 64 * (j))
#define XB_XSUB(j)  (1280 + 64 * (j))
#define XB_XGEN(j)  (2304 + 64 * (j))
#define XB_TOP      3328
#define XB_TOPGEN   3392
#define XCD_BAR_WORDS 3456
#define XB_SPIN_CAP (1u << 18)

__device__ __forceinline__ unsigned xb_ld(unsigned* p)              { return __hip_atomic_load(p, __ATOMIC_RELAXED, __HIP_MEMORY_SCOPE_AGENT); }
__device__ __forceinline__ unsigned xb_add(unsigned* p, unsigned v) { return __hip_atomic_fetch_add(p, v, __ATOMIC_RELAXED, __HIP_MEMORY_SCOPE_AGENT); }
__device__ __forceinline__ unsigned xb_xcc_id() { return (unsigned)__builtin_amdgcn_s_getreg((3 << 11) | 20) & 0xFu; }
#define XB_SPIN(cond, bar) do { unsigned _sp = 0; while (cond) { __builtin_amdgcn_s_sleep(1); \
    if ((++_sp & 255u) == 0u) { if (xb_ld(&(bar)[XB_TMO])) break; if (_sp > XB_SPIN_CAP) { atomicAdd(&(bar)[XB_TMO], 1u); break; } } } } while (0)

struct XcdBarrier {
    unsigned* bar; unsigned x;
    volatile LAS unsigned* st;
};

__device__ __forceinline__ XcdBarrier xcd_barrier_post(unsigned* bar, volatile LAS unsigned* st) {
    XcdBarrier b; b.bar = bar; b.x = xb_xcc_id(); b.st = st;
    if (threadIdx.x == 0) (void)xb_add(&bar[XB_XCNT(b.x)], 1u);
    return b;
}
__device__ __forceinline__ void xcd_barrier_complete(unsigned* bar, unsigned x, unsigned& nloc, unsigned& nx) {
    const unsigned G = gridDim.x * gridDim.y * gridDim.z;
    unsigned sum, cnt, mine, sp = 0u;
    for (;;) {
        sum = 0u; cnt = 0u; mine = 0u;
#pragma unroll
        for (unsigned j = 0; j < 16; ++j) { const unsigned c = xb_ld(&bar[XB_XCNT(j)]); sum += c; cnt += (c > 0u) ? 1u : 0u; mine = (j == x) ? c : mine; }
        if (sum == G) break;
        __builtin_amdgcn_s_sleep(1);
        if ((++sp & 255u) == 0u) { if (xb_ld(&bar[XB_TMO])) break; if (sp > XB_SPIN_CAP) { atomicAdd(&bar[XB_TMO], 1u); break; } }
    }
    nloc = mine > 0u ? mine : 1u; nx = cnt > 0u ? cnt : 1u;
}

__device__ __forceinline__ void xcd_barrier(const XcdBarrier& b, const int wave) {
    asm volatile("s_waitcnt vmcnt(0)" ::: "memory");
    __syncthreads();
    if (wave == 0 && pg8::lane_id_v() == 0) {
        unsigned* bar = b.bar;
        __builtin_amdgcn_s_waitcnt(0);
        unsigned nloc = b.st[0], nx = b.st[1];
        if (nloc == 0u) { xcd_barrier_complete(bar, b.x, nloc, nx); b.st[0] = nloc; b.st[1] = nx; }
        const unsigned old = xb_add(&bar[XB_XSUB(b.x)], 1u);
        const unsigned gen = old / nloc;
        if (old + 1u == (gen + 1u) * nloc) {
            __builtin_amdgcn_fence(__ATOMIC_RELEASE, "agent");
            asm volatile("s_waitcnt vmcnt(0)" ::: "memory");
            const unsigned og = xb_add(&bar[XB_TOP], 1u);
            const unsigned tg = og / nx;
            if (og + 1u == (tg + 1u) * nx) xb_add(&bar[XB_TOPGEN], 1u);
            else XB_SPIN(xb_ld(&bar[XB_TOPGEN]) == tg, bar);
            __builtin_amdgcn_fence(__ATOMIC_ACQUIRE, "agent");
            xb_add(&bar[XB_XGEN(b.x)], 1u);
            asm volatile("s_waitcnt vmcnt(0)" ::: "memory");
        } else {
            XB_SPIN(xb_ld(&bar[XB_XGEN(b.x)]) == gen, bar);
            __builtin_amdgcn_fence(__ATOMIC_ACQUIRE, "agent");
            asm volatile("s_waitcnt vmcnt(0)" ::: "memory");
        }
    }
    __syncthreads();
}

#include <hip/hip_bf16.h>
#include <cmath>
namespace attn_body {
using bf16=__hip_bfloat16;
using bf16x8=__attribute__((ext_vector_type(8)))short;
using s16x4=__attribute__((ext_vector_type(4)))short;
using f32x16=__attribute__((ext_vector_type(16)))float;
using u32x4=__attribute__((ext_vector_type(4)))unsigned;
constexpr int D=64,DM=1024,SEQQ=2048,SEQKV=2304;
constexpr int NW=8,QBLK=32,QB=QBLK*NW,KVBLK=64,NQB=SEQQ/QB;
constexpr int ATTN_PITCH=DM, ATTN_UNIT_ROWS=QB;
__device__ __forceinline__ int crow(int r,int hi){return (r&3)+8*(r>>2)+4*hi;}
#define SBAR() __builtin_amdgcn_sched_barrier(0)
__device__ __forceinline__ void cmask(f32x16&p0,f32x16&p1,int jb,int qrel,int hi){
  const float NEG=-INFINITY; int kb=64*jb+4*hi;
  #pragma unroll
  for(int r=0;r<16;++r){int kv=kb+(r&3)+8*(r>>2); if(kv>qrel)p0[r]=NEG; if(kv+32>qrel)p1[r]=NEG;}
}

constexpr int NSLOT=3, SLOTB=8192;
constexpr int LDS_K=0, LDS_V=NSLOT*SLOTB, LDS_WS=2*NSLOT*SLOTB, LDS_OST=LDS_WS+NW*64*4, LDS_BYTES=LDS_OST+NW*4096;
constexpr float C2=0.125f*1.4426950408889634f;
__device__ __forceinline__ void glds16(const void*gsrc,unsigned lds_dst){unsigned keep;
  asm volatile("s_mov_b32 %0, m0\n\ts_mov_b32 m0, %2\n\ts_nop 0\n\tglobal_load_lds_dwordx4 %1, off\n\ts_mov_b32 m0, %0":"=&s"(keep):"v"(gsrc),"s"(lds_dst):"memory");}
__device__ __forceinline__ float max3f(float a,float b,float c){float r;asm("v_max3_f32 %0, %1, %2, %3":"=v"(r):"v"(a),"v"(b),"v"(c));return r;}
__device__ __forceinline__ float max2f(float a,float b){float r;asm("v_max_f32_e32 %0, %1, %2":"=v"(r):"v"(a),"v"(b));return r;}
__device__ __forceinline__ float fadd_s(float a,float b){float r;asm("v_add_f32_e32 %0, %1, %2":"=v"(r):"v"(a),"v"(b));return r;}
__device__ __forceinline__ float fsub_s(float a,float b){float r;asm("v_sub_f32_e32 %0, %1, %2":"=v"(r):"v"(a),"v"(b));return r;}
typedef float f32x2_t __attribute__((ext_vector_type(2))); typedef __bf16 bf16x2_t __attribute__((ext_vector_type(2)));
__device__ __forceinline__ unsigned cvtpk_s(float lo,float hi){f32x2_t v={lo,hi};bf16x2_t b=__builtin_convertvector(v,bf16x2_t);return __builtin_bit_cast(unsigned,b);}
#define WAIT_BAR(N) asm volatile("s_waitcnt vmcnt(" #N ") lgkmcnt(0)\n\ts_barrier":::"memory")

__device__ __forceinline__ void qkt(f32x16&p0,f32x16&p1,const char*Kslot,const bf16x8*qr,const f32x16&negm,int r32,int hi){
  const char*kb=Kslot+hi*1024+r32*16;
  #pragma unroll
  for(int d0=0;d0<4;++d0){
    const bf16x8 b0=*reinterpret_cast<const bf16x8*>(kb+d0*2048);
    const bf16x8 b1=*reinterpret_cast<const bf16x8*>(kb+d0*2048+512);
    if(d0==0){p0=__builtin_amdgcn_mfma_f32_32x32x16_bf16(b0,qr[0],negm,0,0,0);p1=__builtin_amdgcn_mfma_f32_32x32x16_bf16(b1,qr[0],negm,0,0,0);}
    else{p0=__builtin_amdgcn_mfma_f32_32x32x16_bf16(b0,qr[d0],p0,0,0,0);p1=__builtin_amdgcn_mfma_f32_32x32x16_bf16(b1,qr[d0],p1,0,0,0);}}
}
typedef __attribute__((address_space(3))) const char* lds_cptr;
typedef short v4i16_t __attribute__((ext_vector_type(4)));
__device__ __forceinline__ void kload8(bf16x8*kf,lds_cptr kp){
  kf[0]=*(const __attribute__((address_space(3))) bf16x8*)(kp);      kf[1]=*(const __attribute__((address_space(3))) bf16x8*)(kp+512);
  kf[2]=*(const __attribute__((address_space(3))) bf16x8*)(kp+2048); kf[3]=*(const __attribute__((address_space(3))) bf16x8*)(kp+2560);
  kf[4]=*(const __attribute__((address_space(3))) bf16x8*)(kp+4096); kf[5]=*(const __attribute__((address_space(3))) bf16x8*)(kp+4608);
  kf[6]=*(const __attribute__((address_space(3))) bf16x8*)(kp+6144); kf[7]=*(const __attribute__((address_space(3))) bf16x8*)(kp+6656);
}
__device__ __forceinline__ void kload2(bf16x8*kf,lds_cptr kp,int j){ kf[2*j]=*(const __attribute__((address_space(3))) bf16x8*)(kp+j*2048); kf[2*j+1]=*(const __attribute__((address_space(3))) bf16x8*)(kp+j*2048+512); }
__device__ __forceinline__ s16x4 vtr(lds_cptr p){ return __builtin_bit_cast(s16x4,__builtin_amdgcn_ds_read_tr16_b64_v4i16((__attribute__((address_space(3))) v4i16_t*)p)); }
__device__ __forceinline__ float rowmax(const f32x16&p0,const f32x16&p1){
  float a=max3f(p0[0],p0[1],p1[0]),b=max3f(p0[2],p0[3],p1[1]);a=max3f(a,p1[2],p1[3]);
  #pragma unroll
  for(int r=4;r<16;r+=4){a=max3f(a,p0[r],p0[r+1]);b=max3f(b,p0[r+2],p0[r+3]);a=max3f(a,p1[r],p1[r+1]);b=max3f(b,p1[r+2],p1[r+3]);}
  const float m=max2f(a,b);
  auto rr=__builtin_amdgcn_permlane32_swap(__float_as_uint(m),__float_as_uint(m),false,false);
  return max2f(__uint_as_float(rr[0]),__uint_as_float(rr[1]));
}
__device__ __forceinline__ void pv(f32x16*o,int vb,bf16x8 pa0,bf16x8 pa1,bf16x8 pa2,bf16x8 pa3){
  #pragma unroll
  for(int d0=0;d0<2;++d0){s16x4 lo[4],hi[4];
    #pragma unroll
    for(int ks=0;ks<4;++ks){
      asm volatile("ds_read_b64_tr_b16 %0,%1 offset:%c2":"=&v"(lo[ks]):"v"(vb),"i"(d0*4096+ks*1024):"memory");
      asm volatile("ds_read_b64_tr_b16 %0,%1 offset:%c2":"=&v"(hi[ks]):"v"(vb),"i"(d0*4096+ks*1024+512):"memory");}
    asm volatile("s_waitcnt lgkmcnt(0)":::"memory");SBAR();
    #define PK(k) (bf16x8){lo[k][0],lo[k][1],lo[k][2],lo[k][3],hi[k][0],hi[k][1],hi[k][2],hi[k][3]}
    o[d0]=__builtin_amdgcn_mfma_f32_32x32x16_bf16(pa0,PK(0),o[d0],0,0,0);
    o[d0]=__builtin_amdgcn_mfma_f32_32x32x16_bf16(pa1,PK(1),o[d0],0,0,0);
    o[d0]=__builtin_amdgcn_mfma_f32_32x32x16_bf16(pa2,PK(2),o[d0],0,0,0);
    o[d0]=__builtin_amdgcn_mfma_f32_32x32x16_bf16(pa3,PK(3),o[d0],0,0,0);
    #undef PK
  }
}

#ifndef ATTN_STORE16
#define ATTN_STORE16(p,v) (*(u32x4*)(p)=(v))
#endif
template<int THRL> __device__ __forceinline__ void attn_unit(int b,int qb,int qcol,int kcol,int vcol,int ocol,const bf16*Q,const bf16*__restrict__ K,const bf16*__restrict__ V,bf16*O,char*shm,const int wid){
  const int lane=pg8::lane_id_v(),r32=lane&31,hi=lane>>5;
  const long rowq=(long)b*SEQQ, rowkv=(long)b*SEQKV; const int q0=qb*QB;
  const bf16*Qw=Q+(rowq+q0+wid*QBLK)*DM+qcol;
  const bf16*Kh=K+rowkv*DM+kcol,*Vh=V+rowkv*DM+vcol;
  const unsigned lds0=(unsigned)(uintptr_t)shm;
  float*wsf=(float*)(shm+LDS_WS)+wid*64;
  const bf16*ksrc=Kh+(long)lane*DM+wid*8;
  const bf16*vsrc=Vh+(long)(16*(wid&3)+(lane>>2))*DM+(wid>>2)*32+(lane&3)*8;
  const unsigned kdst=lds0+LDS_K+wid*1024, vdst=lds0+LDS_V+wid*1024;
  #define DMA_K(t,slot) glds16(ksrc+(long)(t)*KVBLK*DM,(unsigned)__builtin_amdgcn_readfirstlane(kdst+(slot)))
  #define DMA_V(t,slot) glds16(vsrc+(long)(t)*KVBLK*DM,(unsigned)__builtin_amdgcn_readfirstlane(vdst+(slot)))
  const int vb0=(int)(lds0+LDS_V)+((lane>>4)&1)*32+(lane&3)*8+(4*hi+((lane&15)>>2))*64;
  const char*Kbase=shm+LDS_K; bf16x8 kf[8];
  const lds_cptr shm3=(lds_cptr)shm; const lds_cptr kp0=shm3+LDS_K+hi*1024+r32*16; const lds_cptr vp0=shm3+LDS_V+((lane>>4)&1)*32+(lane&3)*8+(4*hi+((lane&15)>>2))*64;
  constexpr int NT=SEQKV/KVBLK;
  DMA_K(0,0);DMA_V(0,0);DMA_K(1,SLOTB);
  bf16x8 qr[4];
  #pragma unroll
  for(int d0=0;d0<4;++d0)qr[d0]=*reinterpret_cast<const bf16x8*>(&Qw[(long)r32*DM+d0*16+hi*8]);
  float mhat=0.f,l_reg=0.f;f32x16 o[2];o[0]=f32x16{};o[1]=f32x16{};f32x16 negm=f32x16{};asm volatile("":"+v"(negm));
    #define CMASK(P0,P1,t) do{}while(0)
  bool resc=false;
  #define START(P0,P1) do{ const float rm=rowmax(P0,P1); resc=false; \
    { const float dl=rm; mhat=fadd_s(mhat,dl); \
      _Pragma("unroll") for(int r=0;r<16;++r){P0[r]=fsub_s(P0[r],dl);P1[r]=fsub_s(P1[r],dl);} \
      _Pragma("unroll") for(int r=0;r<16;++r)negm[r]=-mhat; asm volatile("":"+v"(negm)); } \
    _Pragma("unroll") for(int r=0;r<16;++r)P0[r]=__builtin_amdgcn_exp2f(P0[r]); }while(0)
  #define RESC() do{ if(resc){ asm volatile("s_waitcnt lgkmcnt(0)":::"memory"); \
      _Pragma("unroll") for(int d_=0;d_<2;++d_) _Pragma("unroll") for(int r=0;r<16;++r)o[d_][r]*=wsf[crow(r,hi)]; } }while(0)
  f32x16 pA0,pA1,pB0,pB1;
  int sl_prev=0,sl_cur=0,sl_next=SLOTB;
  #define ROT() do{sl_prev=sl_cur;sl_cur=sl_next;sl_next=(sl_next==(NSLOT-1)*SLOTB)?0:sl_next+SLOTB;}while(0)
  DMA_K(2,2*SLOTB);
  WAIT_BAR(3);
  qkt(pA0,pA1,Kbase,qr,negm,r32,hi);asm volatile("s_nop 15\n\ts_nop 7":"+v"(pA0),"+v"(pA1));CMASK(pA0,pA1,0);
  START(pA0,pA1);
  _Pragma("unroll") for(int r=0;r<16;++r)pA1[r]=__builtin_amdgcn_exp2f(pA1[r]);
  WAIT_BAR(0);
  DMA_K(3,0);DMA_V(1,SLOTB);
  ROT();
  kload8(kf,kp0+sl_cur);
  WAIT_BAR(2);
  s16x4 vlo[8],vhi[8]; u32x4 pw0,pw1,pw2,pw3;
  #define PKW(P,B) cvtpk_s(P[B],P[B+1])
  #define PAF(k) __builtin_bit_cast(bf16x8,pw##k)
  #define VFR(i) (bf16x8){vlo[i][0],vlo[i][1],vlo[i][2],vlo[i][3],vhi[i][0],vhi[i][1],vhi[i][2],vhi[i][3]}
  #define PIN(x) asm volatile("":"+v"(x))
  #define MX3(a,b,c) __builtin_fmaxf(__builtin_fmaxf((a),(b)),(c))
  #define GAPA(MF,A0,A1,A2,A3,W0,W1,PW) do{ MF; sacc+=A0; sacc+=A1; sacc+=A2; sacc+=A3; PIN(sacc); W0; W1; PIN(PW); SBAR(); }while(0)
  #define EX(v) __builtin_amdgcn_exp2f(v)
  #define GAPB(MF,X,B) do{ MF; X[B]=EX(X[B]); X[B+1]=EX(X[B+1]); X[B+2]=EX(X[B+2]); X[B+3]=EX(X[B+3]); PIN(X); SBAR(); }while(0)
  #define VRD(i) do{ vlo[i]=vtr(vp_+(((i)>>2)*4096+((i)&3)*1024)); vhi[i]=vtr(vp_+(((i)>>2)*4096+((i)&3)*1024+512)); }while(0)
  #define KRD(G,j) do{ if(G){ kload2(kf,kp0+sl_next,j); SBAR(); } }while(0)
  #define STEP(C0,C1,P0,P1,t,GK,GV,GL) do{ SBAR(); \
    const lds_cptr vp_=vp0+sl_prev; \
    VRD(0); SBAR(); float sacc=(P0[0]+P0[1]); \
    GAPA(C0=__builtin_amdgcn_mfma_f32_32x32x16_bf16(kf[0],qr[0],negm,0,0,0), P0[2],P0[3],P0[4],P0[5],     pw0[0]=PKW(P0,0), pw0[1]=PKW(P0,2), pw0); \
    VRD(4); SBAR(); GAPA(C1=__builtin_amdgcn_mfma_f32_32x32x16_bf16(kf[1],qr[0],negm,0,0,0), P0[6],P0[7],P0[8],P0[9],     pw0[2]=PKW(P0,4), pw0[3]=PKW(P0,6), pw0); \
    VRD(1); SBAR(); GAPA(C0=__builtin_amdgcn_mfma_f32_32x32x16_bf16(kf[2],qr[1],C0,0,0,0),   P0[10],P0[11],P0[12],P0[13], pw1[0]=PKW(P0,8), pw1[1]=PKW(P0,10), pw1); \
    VRD(5); SBAR(); GAPA(C1=__builtin_amdgcn_mfma_f32_32x32x16_bf16(kf[3],qr[1],C1,0,0,0),   P0[14],P0[15],P1[0],P1[1],   pw1[2]=PKW(P0,12),pw1[3]=PKW(P0,14), pw1); \
    VRD(2); SBAR(); GAPA(C0=__builtin_amdgcn_mfma_f32_32x32x16_bf16(kf[4],qr[2],C0,0,0,0),   P1[2],P1[3],P1[4],P1[5],     pw2[0]=PKW(P1,0), pw2[1]=PKW(P1,2), pw2); \
    VRD(6); SBAR(); GAPA(C1=__builtin_amdgcn_mfma_f32_32x32x16_bf16(kf[5],qr[2],C1,0,0,0),   P1[6],P1[7],P1[8],P1[9],     pw2[2]=PKW(P1,4), pw2[3]=PKW(P1,6), pw2); \
    VRD(3); SBAR(); GAPA(C0=__builtin_amdgcn_mfma_f32_32x32x16_bf16(kf[6],qr[3],C0,0,0,0),   P1[10],P1[11],P1[12],P1[13], pw3[0]=PKW(P1,8), pw3[1]=PKW(P1,10), pw3); \
    VRD(7); SBAR(); GAPA(C1=__builtin_amdgcn_mfma_f32_32x32x16_bf16(kf[7],qr[3],C1,0,0,0),   P1[14],P1[15],0.f,0.f,       pw3[2]=PKW(P1,12),pw3[3]=PKW(P1,14), pw3); \
    l_reg+=sacc; \
    if(GK){DMA_K((t)+3,sl_cur);} if(GV){DMA_V((t)+1,sl_next);} \
    CMASK(C0,C1,t); \
    { float a=MX3(C0[0],C0[1],C1[0]),b=MX3(C0[2],C0[3],C1[1]); a=MX3(a,C1[2],C1[3]); \
      _Pragma("unroll") for(int r=4;r<16;r+=4){a=MX3(a,C0[r],C0[r+1]);b=MX3(b,C0[r+2],C0[r+3]);a=MX3(a,C1[r],C1[r+1]);b=MX3(b,C1[r+2],C1[r+3]);} \
      float rm=__builtin_fmaxf(a,b); { auto rr=__builtin_amdgcn_permlane32_swap(__float_as_uint(rm),__float_as_uint(rm),false,false); rm=__builtin_fmaxf(__uint_as_float(rr[0]),__uint_as_float(rr[1])); } \
      resc=false; \
      if(__builtin_expect(__any(rm>(float)THRL),0)){ const float dl=__builtin_fmaxf(rm,0.f); mhat+=dl; \
        _Pragma("unroll") for(int r=0;r<16;++r){C0[r]-=dl;C1[r]-=dl;} \
        _Pragma("unroll") for(int r=0;r<16;++r)negm[r]=-mhat; asm volatile("":"+v"(negm)); \
        const float f=__builtin_amdgcn_exp2f(-dl); l_reg*=f; if(hi==0)wsf[r32]=f; resc=true; } } \
    SBAR(); \
    GAPB(o[0]=__builtin_amdgcn_mfma_f32_32x32x16_bf16(PAF(0),VFR(0),o[0],0,0,0), C0,0); \
    GAPB(o[1]=__builtin_amdgcn_mfma_f32_32x32x16_bf16(PAF(0),VFR(4),o[1],0,0,0), C0,4); \
    KRD(GL,0); GAPB(o[0]=__builtin_amdgcn_mfma_f32_32x32x16_bf16(PAF(1),VFR(1),o[0],0,0,0), C0,8); \
    KRD(GL,1); GAPB(o[1]=__builtin_amdgcn_mfma_f32_32x32x16_bf16(PAF(1),VFR(5),o[1],0,0,0), C0,12); \
    KRD(GL,2); GAPB(o[0]=__builtin_amdgcn_mfma_f32_32x32x16_bf16(PAF(2),VFR(2),o[0],0,0,0), C1,0); \
    KRD(GL,3); GAPB(o[1]=__builtin_amdgcn_mfma_f32_32x32x16_bf16(PAF(2),VFR(6),o[1],0,0,0), C1,4); \
    GAPB(o[0]=__builtin_amdgcn_mfma_f32_32x32x16_bf16(PAF(3),VFR(3),o[0],0,0,0), C1,8); \
    GAPB(o[1]=__builtin_amdgcn_mfma_f32_32x32x16_bf16(PAF(3),VFR(7),o[1],0,0,0), C1,12); \
    }while(0)
  int t=1;
  #undef CMASK
  #define CMASK(P0,P1,t) do{}while(0)
  for(;t+5<NT;t+=2){
    STEP(pB0,pB1,pA0,pA1,t,true,true,true);     WAIT_BAR(2); RESC(); ROT();
    STEP(pA0,pA1,pB0,pB1,t+1,true,true,true);   WAIT_BAR(2); RESC(); ROT();
  }
  #undef CMASK
  #define CMASK(P0,P1,t) do{}while(0)
  #define ENDW(tt) do{ if((tt)+3<NT){WAIT_BAR(2);} else if((tt)+2<NT){WAIT_BAR(1);} else {WAIT_BAR(0);} }while(0)
  for(;t+1<NT;t+=2){
    STEP(pB0,pB1,pA0,pA1,t,(t+3<NT),(t+1<NT),(t+1<NT));       ENDW(t);   RESC(); ROT();
    STEP(pA0,pA1,pB0,pB1,t+1,(t+4<NT),(t+2<NT),(t+2<NT));     ENDW(t+1); RESC(); ROT();
  }
  STEP(pB0,pB1,pA0,pA1,NT-1,false,false,false); RESC();
  { float sacc=pB0[0]+pB0[1]; _Pragma("unroll") for(int r=2;r<16;++r)sacc+=pB0[r]; _Pragma("unroll") for(int r=0;r<16;++r)sacc+=pB1[r]; l_reg+=sacc;
    pw0=(u32x4){PKW(pB0,0),PKW(pB0,2),PKW(pB0,4),PKW(pB0,6)};pw1=(u32x4){PKW(pB0,8),PKW(pB0,10),PKW(pB0,12),PKW(pB0,14)};pw2=(u32x4){PKW(pB1,0),PKW(pB1,2),PKW(pB1,4),PKW(pB1,6)};pw3=(u32x4){PKW(pB1,8),PKW(pB1,10),PKW(pB1,12),PKW(pB1,14)};
    SBAR(); pv(o,vb0+sl_cur,PAF(0),PAF(1),PAF(2),PAF(3)); }
  #undef PKW
  #undef PAF
  #undef VFR
  #undef PIN
  #undef MX3
  #undef GAPA
  #undef GAPB
  #undef EX
  #undef VRD
  #undef KRD
  #undef STEP
  #undef ENDW
  {auto rr=__builtin_amdgcn_permlane32_swap(__float_as_uint(l_reg),__float_as_uint(l_reg),false,false);l_reg=__uint_as_float(rr[0])+__uint_as_float(rr[1]);}
  if(hi==0)wsf[32+r32]=l_reg;asm volatile("s_waitcnt lgkmcnt(0)":::"memory");
  float rli[16];
  #pragma unroll
  for(int r=0;r<16;++r)rli[r]=__builtin_amdgcn_rcpf(wsf[32+crow(r,hi)]);
  bf16*Ow=O+(rowq+q0+wid*QBLK)*DM+ocol;
  { bf16*stg=(bf16*)(shm+LDS_OST)+wid*2048;
    #pragma unroll
    for(int r=0;r<16;++r){const int orow=crow(r,hi);
      #pragma unroll
      for(int d0=0;d0<2;++d0)stg[orow*64+d0*32+r32]=__float2bfloat16(o[d0][r]*rli[r]);}
    asm volatile("s_waitcnt lgkmcnt(0)":::"memory");
    #pragma unroll
    for(int i=0;i<4;++i){const int row=i*8+(lane>>3),ch=lane&7; const u32x4 v=*(const u32x4*)(stg+row*64+ch*8); ATTN_STORE16(Ow+(long)row*DM+ch*8,v);} }
  asm volatile("s_waitcnt lgkmcnt(0)\n\ts_barrier":::"memory");
  #undef DMA_K
  #undef DMA_V
  #undef CMASK
  #undef START
  #undef RESC
  #undef ROT
}
constexpr int ATTN_LDS_BYTES=LDS_BYTES;
#undef SBAR
#undef WAIT_BAR
}

constexpr int NWAVES = 8;
#ifndef MK_PER_PHASE
#define MK_PER_PHASE 0
#endif

constexpr int BATCH = 8, SEQ = 2048, DM = 2048, CTXL = 256;
constexpr int MLAT = BATCH * SEQ, MCTX = BATCH * CTXL, MALL = MLAT + MCTX;
constexpr int INW = 9216, KVROWS = SEQ + CTXL;
constexpr float NORM_EPS = 1e-6f, LAM_INIT = 0.2f;
constexpr float QSCALE = 0.125f * 1.4426950408889634f;

constexpr int RING_BYTES = 131072;
constexpr int LDSCTL_OFF = RING_BYTES, MISC_OFF = LDSCTL_OFF + 320;
constexpr int LDS_BYTES = 147456;

struct Args { const float* in[27]; float* out; unsigned char* ws; int ph_lo, ph_hi, li, pad; };
enum In { I_X = 0, I_C, I_CTX, I_CCTX, I_WADA, I_BADA, I_NORMG, I_WIN, I_LQ1, I_LK1, I_LQ2, I_LK2, I_SUBLN, I_LRE, I_LIM, I_LSTEP, I_BRE, I_BIM, I_CRE, I_CIM, I_SSMD, I_WGLU, I_BGLU, I_WPA, I_WPS, I_WOUT, I_FING };

__device__ __forceinline__ float wave_sum(float v) {
#pragma unroll
    for (int o = 1; o < 64; o <<= 1) v += __shfl_xor(v, o);
    return v;
}
using pg8::bf_lo; using pg8::bf_hi; using pg8::unpack8; using pg8::pack8; using pg8::sigmoid_f;
typedef pg8::u32x4 u32x4;

__device__ __forceinline__ void p0_transpose_item(const float* W, int N, bf16* WT, int dpitch, int dcol, LAS float* scr, int item, int lane) {
    const int nblk = N / 32, kb = item / nblk, nb = item % nblk, k0 = 64 * kb, n0 = 32 * nb;
#pragma unroll 8
    for (int i = 0; i < 32; ++i) { const int kk = 2 * i + (lane >> 5); scr[kk * 33 + (lane & 31)] = W[(size_t)(k0 + kk) * N + n0 + (lane & 31)]; }
    LDS_WAIT(); asm volatile("" ::: "memory");
    const int c = lane & 7;
#pragma unroll
    for (int j = 0; j < 4; ++j) { const int n = (lane >> 3) + 8 * j; const LAS float* s = scr + (8 * c) * 33 + n;
        v4u o; o.x = pk2(s[0 * 33], s[1 * 33]); o.y = pk2(s[2 * 33], s[3 * 33]); o.z = pk2(s[4 * 33], s[5 * 33]); o.w = pk2(s[6 * 33], s[7 * 33]);
        *(GAS v4u*)(WT + (size_t)(n0 + n) * dpitch + dcol + k0 + 8 * c) = o; }
    LDS_WAIT(); asm volatile("" ::: "memory");
}

__device__ __forceinline__ void ssm_disc(const Args& a, int idx, float& ar, float& ai, float& fr, float& fi) {
    const float lre = a.in[I_LRE][idx], lim = a.in[I_LIM][idx], dt = expf(a.in[I_LSTEP][idx >> 6]);
    const float mag = expf(lre * dt); ar = mag * cosf(lim * dt); ai = mag * sinf(lim * dt);
    const float den = lre * lre + lim * lim;
    fr = ((ar - 1.0f) * lre + ai * lim) / den; fi = (ai * lre - (ar - 1.0f) * lim) / den;
}
__device__ __forceinline__ void p0_prologue(const Args& a, LAS unsigned char* lds, int vcu, int G, int wave, int lane) {
    unsigned char* ws = a.ws;
    const int gw = vcu * NWAVES + wave, NGW = G * NWAVES;
    {
        float* mod = (float*)(ws + WS_CTL + CTL_MOD);
        const float* wada = a.in[I_WADA]; const float* cc = a.in[I_C]; const float* cctx = a.in[I_CCTX];
        for (int it = gw; it < 1536; it += NGW) {
            const int kc = it / 24, nc = it % 24, k0 = kc * 32, n0 = nc * 256 + 4 * lane;
            f32x4 acc[9];
#pragma unroll
            for (int r = 0; r < 9; ++r) acc[r] = (f32x4){0.f, 0.f, 0.f, 0.f};
            for (int kk = 0; kk < 32; ++kk) {
                const f32x4 w = *(const f32x4*)(wada + (size_t)(k0 + kk) * 6144 + n0);
#pragma unroll
                for (int r = 0; r < 9; ++r) { const float cv = (r < 8) ? cc[r * 2048 + k0 + kk] : cctx[k0 + kk]; const float s = cv * sigmoid_f(cv); acc[r] += w * s; }
            }
#pragma unroll
            for (int r = 0; r < 9; ++r)
#pragma unroll
                for (int e = 0; e < 4; ++e) atomicAdd(mod + r * 6144 + n0 + e, acc[r][e]);
        }
    }
    {
        LAS float* scr = (LAS float*)(lds + wave * 16384);
        constexpr int I_IN = (2048 / 64) * (9216 / 32), I_PA = (1024 / 64) * (2048 / 32), I_PS = (512 / 64) * (2048 / 32), I_OUT = (2048 / 64) * (2048 / 32), I_GLU = (512 / 64) * (512 / 32);
        constexpr int NITEMS = I_IN + I_PA + I_PS + I_OUT + I_GLU;
        for (int it = gw; it < NITEMS; it += NGW) {
            int r = it;
            if (r < I_IN) { p0_transpose_item(a.in[I_WIN], 9216, (bf16*)(ws + WS_WIN), 2048, 0, scr, r, lane); continue; } r -= I_IN;
            if (r < I_PA) { p0_transpose_item(a.in[I_WPA], 2048, (bf16*)(ws + WS_WCAT), 1536, 0, scr, r, lane); continue; } r -= I_PA;
            if (r < I_PS) { p0_transpose_item(a.in[I_WPS], 2048, (bf16*)(ws + WS_WCAT), 1536, 1024, scr, r, lane); continue; } r -= I_PS;
            if (r < I_OUT) { p0_transpose_item(a.in[I_WOUT], 2048, (bf16*)(ws + WS_WOUT), 2048, 0, scr, r, lane); continue; } r -= I_OUT;
            p0_transpose_item(a.in[I_WGLU], 512, (bf16*)(ws + WS_WGLU), 512, 0, scr, r, lane);
        }
    }
    const int gt = gw * 64 + lane;
    if (gt < 1024) {
        const int pos = gt >> 4, i = gt & 15;
        const float inv = exp2f(-(float)i * 0.8304820237218406f);
        const float ang = (float)pos * inv;
        float* rc = (float*)(ws + WS_ROPE); rc[gt] = cosf(ang); rc[1024 + gt] = sinf(ang);
    }
    if (gt >= 4096 && gt < 8192) {
        const int idx = gt - 4096;
        float ar, ai, fr, fi; ssm_disc(a, idx, ar, ai, fr, fi);
        float* P = (float*)(ws + WS_SSMP);
        P[idx] = ar; P[4096 + idx] = ai;
        const float* br = a.in[I_BRE] + (size_t)idx * 16; const float* bi = a.in[I_BIM] + (size_t)idx * 16;
#pragma unroll
        for (int c = 0; c < 16; ++c) { P[8192 + idx * 16 + c] = fr * br[c] - fi * bi[c]; P[8192 + 65536 + idx * 16 + c] = fr * bi[c] + fi * br[c]; }
        float er = 1.f, ei = 0.f; const int dg = idx >> 6, p = idx & 63;
        for (int e = 0; e <= 16; ++e) { float* q = P + SSMP_APOW + ((size_t)(dg * 17 + e) * 64 + p) * 2; q[0] = er; q[1] = ei; const float nr = er * ar - ei * ai; ei = er * ai + ei * ar; er = nr; }
    }
    {
        float* KT = (float*)(ws + WS_KTAB);
        for (int it = gw; it < 8192; it += NGW) {
            const int g = it >> 8, c = (it >> 4) & 15, cp = it & 15;
#pragma unroll
            for (int dir = 0; dir < 2; ++dir) {
                const int dg = dir * 32 + g, idx = dg * 64 + lane;
                float ar, ai, fr, fi; ssm_disc(a, idx, ar, ai, fr, fi);
                const float br = a.in[I_BRE][(size_t)idx * 16 + cp], bi = a.in[I_BIM][(size_t)idx * 16 + cp];
                const float bbr = fr * br - fi * bi, bbi = fr * bi + fi * br;
                const float cr = a.in[I_CRE][(dg * 16 + c) * 64 + lane], ci = a.in[I_CIM][(dg * 16 + c) * 64 + lane];
                float zr = cr * bbr - ci * bbi, zi = cr * bbi + ci * bbr, kv = 0.f;
                for (int lag = 0; lag < 16; ++lag) { const float k = wave_sum(zr); if (lane == lag) kv = k; const float nr = zr * ar - zi * ai; zi = zr * ai + zi * ar; zr = nr; }
                if (lane < 16) KT[((size_t)((g * 2 + dir) * 16 + lane)) * 256 + c * 16 + cp] = kv;
            }
        }
    }
}

__device__ __forceinline__ void p1_ssm_mats(const Args& a, int vcu, int G, int wave, int lane) {
    unsigned char* ws = a.ws;
    const int gt = (vcu * NWAVES + wave) * 64 + lane, NGT = G * NWAVES * 64;
    const float* P = (const float*)(ws + WS_SSMP); const float* KT = (const float*)(ws + WS_KTAB);
    bf16* BTY = (bf16*)(ws + WS_BTY); bf16* BTS = (bf16*)(ws + WS_BTS);
    for (int i = gt; i < 786432; i += NGT) {
        float v[8];
        if (i < 524288) {
            const int k8 = (i & 63) * 8, n = (i >> 6) & 255, g = i >> 14, t = n >> 4, c = n & 15;
            if (k8 < 256) {
                const int s = k8 >> 4, cp0 = k8 & 15;
                if (t != s) { const float* kp = KT + ((size_t)((g * 2 + (t > s ? 0 : 1)) * 16 + (t > s ? t - s : s - t))) * 256 + c * 16 + cp0;
#pragma unroll
                    for (int j = 0; j < 8; ++j) v[j] = kp[j];
                } else { const float* kf = KT + ((size_t)((g * 2 + 0) * 16)) * 256 + c * 16 + cp0; const float* kb = KT + ((size_t)((g * 2 + 1) * 16)) * 256 + c * 16 + cp0; const float d = a.in[I_SSMD][g * 16 + c];
#pragma unroll
                    for (int j = 0; j < 8; ++j) v[j] = kf[j] + kb[j] + ((cp0 + j == c) ? d : 0.f);
                }
            } else {
                const int kk = k8 - 256, dir = kk >> 7, part = (kk >> 6) & 1, p0 = kk & 63, e = dir ? 16 - t : t + 1, dg = dir * 32 + g;
#pragma unroll
                for (int j = 0; j < 8; ++j) { const float* q = P + SSMP_APOW + ((size_t)(dg * 17 + e) * 64 + p0 + j) * 2; const float er = q[0], ei = q[1];
                    const float cr = a.in[I_CRE][(dg * 16 + c) * 64 + p0 + j], ci = a.in[I_CIM][(dg * 16 + c) * 64 + p0 + j];
                    v[j] = part ? -(cr * ei + ci * er) : (cr * er - ci * ei); }
            }
            u32x4 w; w.x = pg8::cvt_pk_bf16(v[0], v[1]); w.y = pg8::cvt_pk_bf16(v[2], v[3]); w.z = pg8::cvt_pk_bf16(v[4], v[5]); w.w = pg8::cvt_pk_bf16(v[6], v[7]);
            *(u32x4*)(BTY + ((size_t)(g * 256 + n) * 512 + k8)) = w;
        } else {
            const int jx = i - 524288, k8 = (jx & 31) * 8, n = (jx >> 5) & 255, g = jx >> 13, s = k8 >> 4, cp0 = k8 & 15;
            const int dir = n >> 7, part = (n >> 6) & 1, p = n & 63, e = dir ? s : 15 - s, dg = dir * 32 + g, idx = dg * 64 + p;
            const float* q = P + SSMP_APOW + ((size_t)(dg * 17 + e) * 64 + p) * 2; const float er = q[0], ei = q[1];
#pragma unroll
            for (int j = 0; j < 8; ++j) { const float br = P[8192 + idx * 16 + cp0 + j], bi = P[8192 + 65536 + idx * 16 + cp0 + j]; v[j] = part ? (er * bi + ei * br) : (er * br - ei * bi); }
            u32x4 w; w.x = pg8::cvt_pk_bf16(v[0], v[1]); w.y = pg8::cvt_pk_bf16(v[2], v[3]); w.z = pg8::cvt_pk_bf16(v[4], v[5]); w.w = pg8::cvt_pk_bf16(v[6], v[7]);
            *(u32x4*)(BTS + ((size_t)(g * 256 + n) * 256 + k8)) = w;
        }
    }
}

__device__ __forceinline__ void p1_xn(const Args& a, int vcu, int G, int wave, int lane) {
    unsigned char* ws = a.ws;
    const int gw = vcu * NWAVES + wave, NGW = G * NWAVES;
    const float* mod = (const float*)(ws + WS_CTL + CTL_MOD); const float* bada = a.in[I_BADA]; const float* ng = a.in[I_NORMG];
    bf16* XN = (bf16*)(ws + WS_XN);
    for (int m = gw; m < MALL; m += NGW) {
        const float* src = m < MLAT ? a.in[I_X] + (size_t)m * DM : a.in[I_CTX] + (size_t)(m - MLAT) * DM;
        const int mr = m < MLAT ? (m >> 11) : 8;
        const f32x4* xr = (const f32x4*)src + lane;
        f32x4 v[8]; float s = 0.f;
#pragma unroll
        for (int j = 0; j < 8; ++j) { v[j] = xr[64 * j]; s += (v[j][0] * v[j][0] + v[j][1] * v[j][1]) + (v[j][2] * v[j][2] + v[j][3] * v[j][3]); }
        const float rstd = 1.0f / sqrtf(wave_sum(s) * (1.0f / DM) + NORM_EPS);
        unsigned long long* o8 = (unsigned long long*)(XN + (size_t)m * DM) + lane;
#pragma unroll
        for (int j = 0; j < 8; ++j) {
            const int col = 4 * lane + 256 * j;
            const f32x4 sh = *(const f32x4*)(mod + mr * 6144 + col) + *(const f32x4*)(bada + col);
            const f32x4 sc = *(const f32x4*)(mod + mr * 6144 + 2048 + col) + *(const f32x4*)(bada + 2048 + col);
            const f32x4 g = *(const f32x4*)(ng + col);
            const f32x4 h = (v[j] * rstd) * g * (sc + 1.0f) + sh;
            o8[64 * j] = (unsigned long long)pg8::cvt_pk_bf16(h[0], h[1]) | ((unsigned long long)pg8::cvt_pk_bf16(h[2], h[3]) << 32);
        }
    }
}

struct InProjOrder {
    pg8::StaticOrder so; int G, c;
    __device__ __forceinline__ void init(int G_, int c_) { so.init(MLAT, INW, G_, c_); G = G_; c = c_; }
    __device__ __forceinline__ bool next(int i, pg8::Unit& u) const {
        const long L = (long)i * G + c;
        if (L < 2304) return so.next(i, u);
        const int j = (int)(L - 2304); if (j >= 80) return false;
        const int jj = j % 10; u.pm = 64 + j / 10; u.pn = jj < 8 ? 4 + jj : 8 + jj; return true;
    }
    __device__ __forceinline__ void a_ready(const pg8::Unit&) const {}
    __device__ __forceinline__ void done(const pg8::Unit&) const {}
};

__device__ __forceinline__ void p3_attn(const Args& a, char* lds_generic, int vcu, int G, int wave) {
    unsigned char* ws = a.ws;
    const attn_body::bf16* Q = (const attn_body::bf16*)(ws + WS_Q); const attn_body::bf16* K = (const attn_body::bf16*)(ws + WS_KALL); const attn_body::bf16* V = (const attn_body::bf16*)(ws + WS_VALL);
    for (int u = vcu; u < 2048; u += G) {
        const int xcd = (u & 255) >> 5, c = u & 31, i = u >> 8;
        const int vhd = xcd * 32 + i * 4 + (c >> 3), qb = c & 7;
        const int b = vhd >> 5, h = (vhd >> 2) & 7, s = (vhd >> 1) & 1, vh = vhd & 1;
        attn_body::bf16* O = (attn_body::bf16*)(ws + (s ? WS_O2 : WS_O1));
        attn_body::attn_unit<8>(b, qb, h * 128 + s * 64, h * 128 + s * 64, h * 128 + vh * 64, h * 128 + vh * 64, Q, K, V, O, lds_generic, wave);
    }
}

__device__ __forceinline__ void p4_combine(const Args& a, int vcu, int G, int wave, int lane) {
    unsigned char* ws = a.ws;
    const int gw = vcu * NWAVES + wave, NGW = G * NWAVES;
    const float l1 = wave_sum(a.in[I_LQ1][lane] * a.in[I_LK1][lane]), l2 = wave_sum(a.in[I_LQ2][lane] * a.in[I_LK2][lane]);
    const float lam = expf(l1) - expf(l2) + LAM_INIT;
    const bf16* O1 = (const bf16*)(ws + WS_O1); const bf16* O2 = (const bf16*)(ws + WS_O2); const bf16* GA = (const bf16*)(ws + WS_GA); bf16* AS = (bf16*)(ws + WS_AS);
    const int col = 16 * lane;
    f32x4 sg[4];
#pragma unroll
    for (int j = 0; j < 4; ++j) sg[j] = *(const f32x4*)(a.in[I_SUBLN] + (col & 127) + 4 * j) * (1.0f - LAM_INIT);
    for (int tok = gw; tok < MLAT; tok += NGW) {
        f32x4 o[4], p[4], g[4];
        unpack8(*(const u32x4*)(O1 + (size_t)tok * 1024 + col), o[0], o[1]); unpack8(*(const u32x4*)(O1 + (size_t)tok * 1024 + col + 8), o[2], o[3]);
        unpack8(*(const u32x4*)(O2 + (size_t)tok * 1024 + col), p[0], p[1]); unpack8(*(const u32x4*)(O2 + (size_t)tok * 1024 + col + 8), p[2], p[3]);
        unpack8(*(const u32x4*)(GA + (size_t)tok * 1024 + col), g[0], g[1]); unpack8(*(const u32x4*)(GA + (size_t)tok * 1024 + col + 8), g[2], g[3]);
        float ss = 0.f;
#pragma unroll
        for (int j = 0; j < 4; ++j) { o[j] = o[j] - p[j] * lam; ss += (o[j][0] * o[j][0] + o[j][1] * o[j][1]) + (o[j][2] * o[j][2] + o[j][3] * o[j][3]); }
        ss += __shfl_xor(ss, 1); ss += __shfl_xor(ss, 2); ss += __shfl_xor(ss, 4);
        const float rs = 1.0f / sqrtf(ss * (1.0f / 128.0f) + NORM_EPS);
#pragma unroll
        for (int j = 0; j < 4; ++j) o[j] = o[j] * rs * sg[j] * g[j];
        *(u32x4*)(AS + (size_t)tok * 1536 + col) = pack8(o[0], o[1]); *(u32x4*)(AS + (size_t)tok * 1536 + col + 8) = pack8(o[2], o[3]);
    }
}

struct SsmOrder {
    int G, c, nrt;
    __device__ __forceinline__ bool next(int i, pg8::Unit& u) const {
        const long L = (long)i * G + c; if (L >= 32 * nrt) return false;
        const int g = (int)L / nrt, rt = (int)L % nrt; u.pm = g * 5 + rt; u.pn = g; return true;
    }
    __device__ __forceinline__ void a_ready(const pg8::Unit&) const {}
    __device__ __forceinline__ void done(const pg8::Unit&) const {}
};
__device__ __forceinline__ void p6_carry(const Args& a, int vcu, int G, int wave, int lane) {
    unsigned char* ws = a.ws;
    const int gw = vcu * NWAVES + wave, NGW = G * NWAVES;
    const float* P = (const float*)(ws + WS_SSMP);
    for (int it = gw; it < 512; it += NGW) {
        const int dir = it & 1, g = (it >> 1) & 31, b = it >> 6;
        const float* q = P + SSMP_APOW + ((size_t)((dir * 32 + g) * 17 + 16) * 64 + lane) * 2; const float ar = q[0], ai = q[1];
        const float* S = (const float*)(ws + WS_SBUF) + (size_t)g * 1280 * 256 + dir * 128 + lane;
        bf16* H = (bf16*)(ws + WS_A2) + (size_t)g * 1280 * 512 + 256 + dir * 128 + lane;
        float hr = 0.f, hi = 0.f;
#pragma unroll 8
        for (int k = 0; k < 16; ++k) { const int R = 1024 + b * 16 + (dir ? 15 - k : k); const float sr = S[(size_t)R * 256], si = S[(size_t)R * 256 + 64];
            const float nr = ar * hr - ai * hi + sr; hi = ar * hi + ai * hr + si; hr = nr; }
#pragma unroll 8
        for (int k = 0; k < 128; ++k) { const int R = b * 128 + (dir ? 127 - k : k); const float sr = S[(size_t)R * 256], si = S[(size_t)R * 256 + 64];
            H[(size_t)R * 512] = (bf16)f2bf(hr); H[(size_t)R * 512 + 64] = (bf16)f2bf(hi);
            const float nr = ar * hr - ai * hi + sr; hi = ar * hi + ai * hr + si; hr = nr; }
    }
}

__device__ __forceinline__ void p10_final(const Args& a, int vcu, int G, int wave, int lane) {
    const int gw = vcu * NWAVES + wave, NGW = G * NWAVES;
    const float* rowsq = (const float*)(a.ws + WS_CTL + CTL_ROWSQ); const float* fg = a.in[I_FING];
    for (int m = gw; m < MLAT; m += NGW) {
        const float rstd = 1.0f / sqrtf(rowsq[m] * (1.0f / DM) + NORM_EPS);
        f32x4* o = (f32x4*)(a.out + (size_t)m * DM) + lane;
#pragma unroll
        for (int j = 0; j < 8; ++j) { const f32x4 g = *(const f32x4*)(fg + 4 * lane + 256 * j); o[64 * j] = o[64 * j] * rstd * g; }
    }
}

constexpr int N_PHASES = 12;
__global__ void __launch_bounds__(NWAVES * 64, 2) skel_fwd(Args args) {
    extern __shared__ __attribute__((aligned(16))) unsigned char lds_raw[];
    LAS unsigned char* lds = (LAS unsigned char*)lds_raw;
    volatile LAS unsigned* MISC = (volatile LAS unsigned*)(lds + MISC_OFF);
    const int tid = threadIdx.x, wave = __builtin_amdgcn_readfirstlane(tid >> 6);
    const int G = gridDim.x; const int bx = blockIdx.x; const int vcu = (G % 8 == 0) ? (bx % 8) * (G / 8) + bx / 8 : bx;
    unsigned char* ws = args.ws;
    gu32* ctl = (gu32*)(ws + WS_CTL);
    for (int u = tid; u < (LDS_BYTES - LDSCTL_OFF) / 4; u += NWAVES * 64) ((LAS unsigned*)(lds + LDSCTL_OFF))[u] = 0u;
    __syncthreads();
    XcdBarrier bar; bar.bar = (unsigned*)(ctl + CW_BAR); bar.x = 0; bar.st = nullptr;
    if (!MK_PER_PHASE) bar = xcd_barrier_post((unsigned*)(ctl + CW_BAR), MISC + 8);
    const int lo = args.ph_lo, hi = args.ph_hi;
#ifndef ONLY_PHASE
#define ONLY_PHASE -1
#endif
#define IN(k) ((ONLY_PHASE < 0 || ONLY_PHASE == (k)) && lo <= (k) && (k) < hi)
#define SEAM(k) do { if (IN(k) && IN((k) + 1)) xcd_barrier(bar, wave); } while (0)

    if (IN(0)) { const int ln = pg8::lane_id_v(); p0_prologue(args, lds, vcu, G, wave, ln); } SEAM(0);
    if (IN(1)) { const int ln = pg8::lane_id_v(); p1_xn(args, vcu, G, wave, ln); p1_ssm_mats(args, vcu, G, wave, ln); } SEAM(1);
    if (IN(2)) {
        pg8::Gemm g{(const pg8::bf16_t*)(ws + WS_XN), (const pg8::bf16_t*)(ws + WS_WIN), MALL, INW, DM, DM, DM};
        InProjOrder S; S.init(G, bx);
        pg8::EpiInProj E{ws, QSCALE, -1};
        pg8::gemm_phase<pg8::EpiInProj, InProjOrder, PG8_ALIGN, PG8_SP2>(lds, g, S, E, wave);
    } SEAM(2);
    if (IN(3)) { p3_attn(args, (char*)lds_raw, vcu, G, wave); } SEAM(3);
    if (IN(4)) { const int ln = pg8::lane_id_v(); p4_combine(args, vcu, G, wave, ln); } SEAM(4);
    if (IN(5)) {
        pg8::Gemm g{(const pg8::bf16_t*)(ws + WS_A2), (const pg8::bf16_t*)(ws + WS_BTS), 32 * 1280, 32 * 256, 256, 512, 256};
        SsmOrder S{G, bx, 5};
        pg8::EpiS E{(float*)(ws + WS_SBUF), -1};
        pg8::gemm_phase<pg8::EpiS, SsmOrder, PG8_ALIGN, PG8_SP2>(lds, g, S, E, wave);
    } SEAM(5);
    if (IN(6)) { const int ln = pg8::lane_id_v(); p6_carry(args, vcu, G, wave, ln); } SEAM(6);
    if (IN(7)) {
        pg8::Gemm g{(const pg8::bf16_t*)(ws + WS_A2), (const pg8::bf16_t*)(ws + WS_BTY), 32 * 1280, 32 * 256, 512, 512, 512};
        SsmOrder S{G, bx, 4};
        pg8::EpiY E{(pg8::bf16_t*)(ws + WS_Y), -1};
        pg8::gemm_phase<pg8::EpiY, SsmOrder, PG8_ALIGN, PG8_SP2>(lds, g, S, E, wave);
    } SEAM(7);
    if (IN(8)) {
        pg8::Gemm g{(const pg8::bf16_t*)(ws + WS_Y), (const pg8::bf16_t*)(ws + WS_WGLU), MLAT, 512, 512, 512, 512};
        pg8::StaticOrder S; S.init(MLAT, 512, G, bx);
        pg8::EpiGlu E{(const pg8::bf16_t*)(ws + WS_Y), (const pg8::bf16_t*)(ws + WS_GS), args.in[I_BGLU], (pg8::bf16_t*)(ws + WS_AS), -1};
        pg8::gemm_phase<pg8::EpiGlu, pg8::StaticOrder, PG8_ALIGN, PG8_SP2>(lds, g, S, E, wave);
    } SEAM(8);
    if (IN(9)) {
        pg8::Gemm g{(const pg8::bf16_t*)(ws + WS_AS), (const pg8::bf16_t*)(ws + WS_WCAT), MLAT, DM, 1536, 1536, 1536};
        pg8::StaticOrder S; S.init(MLAT, DM, G, bx);
        pg8::EpiMerged E{(const pg8::bf16_t*)(ws + WS_GM), (pg8::bf16_t*)(ws + WS_MG), 16};
        pg8::gemm_phase<pg8::EpiMerged, pg8::StaticOrder, PG8_ALIGN, PG8_SP2>(lds, g, S, E, wave);
    } SEAM(9);
    if (IN(10)) {
        pg8::Gemm g{(const pg8::bf16_t*)(ws + WS_MG), (const pg8::bf16_t*)(ws + WS_WOUT), MLAT, DM, DM, DM, DM};
        pg8::StaticOrder S; S.init(MLAT, DM, G, bx);
        pg8::EpiOut E{args.in[I_X], (const float*)(ws + WS_CTL + CTL_MOD), args.in[I_BADA], args.out, (float*)(ws + WS_CTL + CTL_ROWSQ), -1};
        pg8::gemm_phase<pg8::EpiOut, pg8::StaticOrder, PG8_ALIGN, PG8_SP2>(lds, g, S, E, wave);
    } SEAM(10);
    if (IN(11)) { const int ln = pg8::lane_id_v(); p10_final(args, vcu, G, wave, ln); }
#undef IN
#undef SEAM
}

extern "C" void kernel_launch(void* const* d_in, const int* in_sizes, int n_in, void* d_out, int out_size, void* d_ws, size_t ws_size, hipStream_t stream) {
    static int grid = 0;
    if (grid == 0) {
        if (n_in != 27 || out_size != MLAT * DM || ws_size < WS_END) { fprintf(stderr, "kernel_launch: unexpected shapes (n_in %d, out %d, ws %zu); nothing launched\n", n_in, out_size, ws_size); grid = -1; return; }
        int dev = 0, cus = 0, per_cu = 0;
        if (hipGetDevice(&dev) != hipSuccess || hipDeviceGetAttribute(&cus, hipDeviceAttributeMultiprocessorCount, dev) != hipSuccess) { grid = -1; return; }
        if (hipFuncSetAttribute((const void*)skel_fwd, hipFuncAttributeMaxDynamicSharedMemorySize, LDS_BYTES) != hipSuccess) { fprintf(stderr, "kernel_launch: hipFuncSetAttribute failed\n"); grid = -1; return; }
        if (hipOccupancyMaxActiveBlocksPerMultiprocessor(&per_cu, (const void*)skel_fwd, NWAVES * 64, LDS_BYTES) != hipSuccess || per_cu < 1) { fprintf(stderr, "kernel_launch: occupancy query says %d blocks per CU\n", per_cu); }
        (void)hipGetLastError();
        grid = cus;
    }
    if (grid < 0) return;
    if (hipMemsetAsync((char*)d_ws + WS_CTL, 0, CTL_ZERO_BYTES, stream) != hipSuccess) { fprintf(stderr, "kernel_launch: hipMemsetAsync failed\n"); return; }
    Args a{};
    for (int i = 0; i < 27; ++i) a.in[i] = (const float*)d_in[i];
    a.out = (float*)d_out; a.ws = (unsigned char*)d_ws;
#if MK_PER_PHASE
    for (int p = 0; p < N_PHASES; ++p) { a.ph_lo = p; a.ph_hi = p + 1; a.li = 0; hipLaunchKernelGGL(skel_fwd, dim3(grid), dim3(NWAVES * 64), LDS_BYTES, stream, a); }
#else
    a.ph_lo = 0; a.ph_hi = N_PHASES; a.li = 0;
    hipLaunchKernelGGL(skel_fwd, dim3(grid), dim3(NWAVES * 64), LDS_BYTES, stream, a);
#endif
    const hipError_t le = hipPeekAtLastError();
    if (le != hipSuccess) fprintf(stderr, "kernel_launch: launch failed: %s\n", hipGetErrorName(le));
}
```

```cpp
#include <hip/hip_runtime.h>
#include <hip/hip_bf16.h>
#include <cstdio>
#include <cstdint>
#include <cmath>

constexpr size_t MiB = 1u << 20;
constexpr size_t WS_CTL = 0, CTL_ZERO_BYTES = 1 * MiB;
constexpr int CW_BAR = 4096;
constexpr size_t CTL_MOD = 262144, CTL_ROWSQ = 524288, CTL_STAMP = 65536;
constexpr size_t WS_WIN = 2 * MiB;
constexpr size_t WS_WCAT = 38 * MiB;
constexpr size_t WS_WOUT = 44 * MiB;
constexpr size_t WS_WGLU = 52 * MiB;
constexpr size_t WS_ROPE = 52 * MiB + 512 * 1024;
constexpr size_t WS_SSMP = 53 * MiB;
constexpr int SSMP_APOW = 8192 + 131072;
constexpr size_t WS_KTAB = 55 * MiB;
constexpr size_t WS_BTY = 57 * MiB;
constexpr size_t WS_BTS = 65 * MiB;
constexpr size_t WS_A2 = 70 * MiB;
constexpr size_t WS_GS = 110 * MiB;
constexpr size_t WS_GA = 126 * MiB;
constexpr size_t WS_Q = 158 * MiB;
constexpr size_t WS_KALL = 190 * MiB;
constexpr size_t WS_VALL = 226 * MiB;
constexpr size_t WS_GM = 262 * MiB;
constexpr size_t WS_XN = 390 * MiB;
constexpr size_t WS_O1 = 390 * MiB, WS_O2 = 422 * MiB;
constexpr size_t WS_SBUF = 390 * MiB;
constexpr size_t WS_MG = 390 * MiB;
constexpr size_t WS_Y = 462 * MiB;
constexpr size_t WS_AS = 158 * MiB;
constexpr size_t WS_END = 478 * MiB;

namespace pg8 {
#define PG8_LAS __attribute__((address_space(3)))
typedef unsigned short bf16_t;
typedef short bf16x8 __attribute__((ext_vector_type(8)));
typedef float f32x4 __attribute__((ext_vector_type(4)));
typedef unsigned u32x4 __attribute__((ext_vector_type(4)));
constexpr int BM = 256, BK = 64, HALF = 128, HTB = HALF * BK * 2  , STAGE_BYTES = 8 * HTB, NXCD = 8, WGM = 8;

__host__ __device__ __forceinline__ int lds_byte(int r, int c) { const int st = (r >> 4) * 2 + (c >> 5), rr = r & 15, cc = c & 31, ob = rr * 64 + cc * 2; return st * 1024 + (ob ^ (((ob >> 9) & 1) << 5)); }
__host__ __device__ __forceinline__ void stage_rc(int b, int& R, int& C) { const int st = b / 1024, sb = b % 1024, swz = sb ^ (((sb >> 9) & 1) << 5); R = (st >> 1) * 16 + swz / 64; C = (st & 1) * 32 + (swz % 64) / 2; }
__host__ __device__ __forceinline__ int perm32(int rho) { const int n = rho >> 4, i = rho & 15; return 8 * (i >> 2) + 4 * n + (i & 3); }

struct Unit { int pm, pn; };
struct Gemm { const bf16_t* A; const bf16_t* Bt; int M, N, K, lda, ldb; };

struct StaticOrder {
    int nM, nN, nwg, G, c;
    __host__ __device__ void init(int M, int N, int G_, int c_) { nM = M / BM; nN = N / BM; nwg = nM * nN; G = G_; c = c_; }
    __host__ __device__ bool next(int i, Unit& u) const {
        const long L = (long)i * G + c; if (L >= nwg) return false;
        int wgid = (int)L; { const int q = nwg / NXCD, r = nwg % NXCD, xcd = wgid % NXCD, off = wgid / NXCD; wgid = (xcd < r ? xcd * (q + 1) : r * (q + 1) + (xcd - r) * q) + off; }
        const int nig = WGM * nN, gid = wgid / nig, fm = gid * WGM, gsz = (nM - fm) < WGM ? (nM - fm) : WGM;
        u.pm = fm + ((wgid % nig) % gsz); u.pn = (wgid % nig) / gsz; return true;
    }
    __device__ __forceinline__ void a_ready(const Unit&) const {}
    __device__ __forceinline__ void done(const Unit&) const {}
};


__device__ __forceinline__ unsigned cvt_pk_bf16(float lo, float hi) { unsigned r; asm volatile("v_cvt_pk_bf16_f32 %0, %1, %2" : "=v"(r) : "v"(lo), "v"(hi)); return r; }
__device__ __forceinline__ int lane_id_v() { int l; asm volatile("v_mbcnt_lo_u32_b32 %0, -1, 0\n\tv_mbcnt_hi_u32_b32 %0, -1, %0" : "=v"(l)); return l; }
__device__ __forceinline__ float bf_lo(unsigned u) { return __uint_as_float(u << 16); }
__device__ __forceinline__ float bf_hi(unsigned u) { return __uint_as_float(u & 0xffff0000u); }
__device__ __forceinline__ void unpack8(const u32x4 w, f32x4& a, f32x4& b) { a = (f32x4){bf_lo(w.x), bf_hi(w.x), bf_lo(w.y), bf_hi(w.y)}; b = (f32x4){bf_lo(w.z), bf_hi(w.z), bf_lo(w.w), bf_hi(w.w)}; }
__device__ __forceinline__ u32x4 pack8(const f32x4 a, const f32x4 b) { u32x4 w; w.x = cvt_pk_bf16(a[0], a[1]); w.y = cvt_pk_bf16(a[2], a[3]); w.z = cvt_pk_bf16(b[0], b[1]); w.w = cvt_pk_bf16(b[2], b[3]); return w; }
__device__ __forceinline__ float sigmoid_f(float x) { return __builtin_amdgcn_rcpf(1.0f + __builtin_amdgcn_exp2f(-1.4426950408889634f * x)); }
__device__ __forceinline__ f32x4 sigmoid4(f32x4 v) { return (f32x4){sigmoid_f(v[0]), sigmoid_f(v[1]), sigmoid_f(v[2]), sigmoid_f(v[3])}; }
__device__ __forceinline__ f32x4 silu4(f32x4 v) { return v * sigmoid4(v); }
__device__ __forceinline__ f32x4 shflx32(f32x4 v) { return (f32x4){__shfl_xor(v[0], 32), __shfl_xor(v[1], 32), __shfl_xor(v[2], 32), __shfl_xor(v[3], 32)}; }

struct EpiInProj {
    static constexpr bool PERM = true, AFTER_DRAIN = false, HAS_MID = false;
    unsigned char* ws; float c2; int tmid;
    __device__ __forceinline__ void mid(f32x4 (&)[2][2][4][2], const Unit&, int, int, int, int) const {}
    __device__ __forceinline__ void operator()(const f32x4 (&acc)[2][2][4][2], const Unit& u, int wr, int wc, int fr, int fq) const {
        const int pn = u.pn, pm = u.pm;
        const bool isctx = pm >= 64;
        const int b = isctx ? pm - 64 : pm >> 3;
        const int t0 = isctx ? 0 : (pm & 7) * 256;
        const int colw = wc * 32 + 8 * fq;
        if (pn < 8) {
            const bool isq = pn < 4;
            bf16_t* base = (bf16_t*)(ws + (isq ? WS_Q : WS_KALL));
            const float* rope_c = (const float*)(ws + WS_ROPE); const float* rope_s = rope_c + 1024;
            const int ct = (isq ? pn : pn - 4) * 256 + colw;
            const float sgn = fq < 2 ? -1.f : 1.f, osc = isq ? c2 : 1.f;
#pragma unroll
            for (int ai = 0; ai < 2; ++ai)
#pragma unroll
                for (int m = 0; m < 4; ++m) {
                    const int rl = ai * HALF + wr * 64 + m * 16 + fr, t = t0 + rl;
                    const size_t grow = isq ? (size_t)(b * 2048 + t) : (size_t)(b * 2304 + (isctx ? 2048 : 0) + t);
                    f32x4 c0 = (f32x4){1.f, 1.f, 1.f, 1.f}, c1 = c0, s0 = (f32x4){0.f, 0.f, 0.f, 0.f}, s1 = s0;
                    if (!isctx) { const int pos = (wc & 1) ? (t & 63) : (t >> 6); const float* pc = rope_c + pos * 16 + 8 * (fq & 1); const float* ps = rope_s + pos * 16 + 8 * (fq & 1);
                        c0 = *(const f32x4*)pc; c1 = *(const f32x4*)(pc + 4); s0 = *(const f32x4*)ps * sgn; s1 = *(const f32x4*)(ps + 4) * sgn; }
#pragma unroll
                    for (int bj = 0; bj < 2; ++bj) {
                        const f32x4 v0 = acc[ai][bj][m][0], v1 = acc[ai][bj][m][1];
                        const f32x4 p0 = shflx32(v0), p1 = shflx32(v1);
                        const f32x4 o0 = (v0 * c0 + p0 * s0) * osc, o1 = (v1 * c1 + p1 * s1) * osc;
                        *(u32x4*)(base + grow * 1024 + ct + bj * HALF) = pack8(o0, o1);
                    }
                    asm volatile("" ::: "memory");
                }
        } else if (pn < 12) {
            const int ct = (pn - 8) * 256 + colw;
#pragma unroll
            for (int ai = 0; ai < 2; ++ai)
#pragma unroll
                for (int m = 0; m < 4; ++m) {
                    const int rl = ai * HALF + wr * 64 + m * 16 + fr, t = t0 + rl;
                    const size_t grow = (size_t)(b * 2304 + (isctx ? 2048 : 0) + t);
#pragma unroll
                    for (int bj = 0; bj < 2; ++bj) *(u32x4*)((bf16_t*)(ws + WS_VALL) + grow * 1024 + ct + bj * HALF) = pack8(acc[ai][bj][m][0], acc[ai][bj][m][1]);
                }
        } else if (pn == 16 || pn == 17) {
#pragma unroll
            for (int ai = 0; ai < 2; ++ai)
#pragma unroll
                for (int m = 0; m < 4; ++m) {
                    const int rl = ai * HALF + wr * 64 + m * 16 + fr, t = t0 + rl;
                    const int R = isctx ? 1024 + b * 16 + (t >> 4) : b * 128 + (t >> 4), tl = t & 15;
#pragma unroll
                    for (int bj = 0; bj < 2; ++bj) {
                        const int g = (pn - 16) * 16 + bj * 8 + wc * 2 + (fq >> 1), c0 = 8 * (fq & 1);
                        *(u32x4*)((bf16_t*)(ws + WS_A2) + ((size_t)(g * 1280 + R) * 512 + tl * 16 + c0)) = pack8(acc[ai][bj][m][0], acc[ai][bj][m][1]);
                    }
                }
        } else {
            size_t boff; int pitch, ct; bool sil;
            if (pn < 16) { boff = WS_GA; pitch = 1024; ct = (pn - 12) * 256; sil = true; }
            else if (pn < 20) { boff = WS_GS; pitch = 512; ct = (pn - 18) * 256; sil = true; }
            else { boff = WS_GM; pitch = 4096; ct = (pn - 20) * 256; sil = false; }
            bf16_t* base = (bf16_t*)(ws + boff);
            ct += colw;
#pragma unroll
            for (int ai = 0; ai < 2; ++ai)
#pragma unroll
                for (int m = 0; m < 4; ++m) {
                    const size_t grow = (size_t)pm * 256 + ai * HALF + wr * 64 + m * 16 + fr;
#pragma unroll
                    for (int bj = 0; bj < 2; ++bj) {
                        const f32x4 v0 = acc[ai][bj][m][0], v1 = acc[ai][bj][m][1];
                        const f32x4 g0 = sigmoid4(v0), g1 = sigmoid4(v1);
                        const f32x4 o0 = sil ? v0 * g0 : g0, o1 = sil ? v1 * g1 : g1;
                        *(u32x4*)(base + grow * pitch + ct + bj * HALF) = pack8(o0, o1);
                    }
                    asm volatile("" ::: "memory");
                }
        }
    }
};

struct EpiGlu {
    static constexpr bool PERM = true, AFTER_DRAIN = false, HAS_MID = false;
    const bf16_t *Y, *GS; const float* bglu; bf16_t* AS; int tmid;
    __device__ __forceinline__ void mid(f32x4 (&)[2][2][4][2], const Unit&, int, int, int, int) const {}
    __device__ __forceinline__ void operator()(const f32x4 (&acc)[2][2][4][2], const Unit& u, int wr, int wc, int fr, int fq) const {
        const int col0 = u.pn * BM + wc * 32 + 8 * fq;
        f32x4 bv[2][2];
#pragma unroll
        for (int bj = 0; bj < 2; ++bj)
#pragma unroll
            for (int n = 0; n < 2; ++n) bv[bj][n] = *(const f32x4*)(bglu + col0 + bj * HALF + 4 * n);
#pragma unroll
        for (int ai = 0; ai < 2; ++ai)
#pragma unroll
            for (int m = 0; m < 4; ++m) {
                const size_t row = (size_t)u.pm * BM + ai * HALF + wr * 64 + m * 16 + fr;
#pragma unroll
                for (int bj = 0; bj < 2; ++bj) {
                    const int col = col0 + bj * HALF;
                    f32x4 y0, y1, g0, g1; unpack8(*(const u32x4*)(Y + row * 512 + col), y0, y1); unpack8(*(const u32x4*)(GS + row * 512 + col), g0, g1);
                    const f32x4 o0 = y0 * sigmoid4(acc[ai][bj][m][0] + bv[bj][0]) * g0, o1 = y1 * sigmoid4(acc[ai][bj][m][1] + bv[bj][1]) * g1;
                    *(u32x4*)(AS + row * 1536 + 1024 + col) = pack8(o0, o1);
                }
                asm volatile("" ::: "memory");
            }
    }
};

struct EpiMerged {
    static constexpr bool PERM = true, AFTER_DRAIN = false, HAS_MID = true;
    const bf16_t* GM; bf16_t* MG; int tmid;
    __device__ __forceinline__ void mid(f32x4 (&acc)[2][2][4][2], const Unit& u, int wr, int wc, int fr, int fq) const {
        unsigned opq = 0; asm volatile("" : "+v"(opq));
        const unsigned col0 = u.pn * BM + wc * 32 + 8 * fq + opq;
#pragma unroll
        for (int ai = 0; ai < 2; ++ai)
#pragma unroll
            for (int m = 0; m < 4; ++m) {
                const unsigned row = u.pm * BM + ai * HALF + wr * 64 + m * 16 + fr;
#pragma unroll
                for (int bj = 0; bj < 2; ++bj) {
                    const unsigned col = col0 + bj * HALF;
                    f32x4 a0, a1, s0, s1; unpack8(*(const u32x4*)(GM + (row * 4096u + col)), a0, a1); unpack8(*(const u32x4*)(GM + (row * 4096u + 2048u + col)), s0, s1);
#pragma unroll
                    for (int e = 0; e < 4; ++e) { acc[ai][bj][m][0][e] *= a0[e] * __builtin_amdgcn_rcpf(fmaxf(s0[e], 1e-30f)); acc[ai][bj][m][1][e] *= a1[e] * __builtin_amdgcn_rcpf(fmaxf(s1[e], 1e-30f)); }
                }
                asm volatile("" ::: "memory");
            }
    }
    __device__ __forceinline__ void operator()(const f32x4 (&acc)[2][2][4][2], const Unit& u, int wr, int wc, int fr, int fq) const {
        const int col0 = u.pn * BM + wc * 32 + 8 * fq;
#pragma unroll
        for (int ai = 0; ai < 2; ++ai)
#pragma unroll
            for (int m = 0; m < 4; ++m) {
                const size_t row = (size_t)u.pm * BM + ai * HALF + wr * 64 + m * 16 + fr;
#pragma unroll
                for (int bj = 0; bj < 2; ++bj) {
                    const int col = col0 + bj * HALF;
                    f32x4 s0, s1; unpack8(*(const u32x4*)(GM + row * 4096 + 2048 + col), s0, s1);
                    *(u32x4*)(MG + row * 2048 + col) = pack8(acc[ai][bj][m][0] * s0, acc[ai][bj][m][1] * s1);
                }
                asm volatile("" ::: "memory");
            }
    }
};

struct EpiOut {
    static constexpr bool PERM = false, AFTER_DRAIN = false, HAS_MID = false;
    const float *x, *mod, *bada; float* out; float* rowsq; int tmid;
    __device__ __forceinline__ void mid(f32x4 (&)[2][2][4][2], const Unit&, int, int, int, int) const {}
    __device__ __forceinline__ void operator()(const f32x4 (&acc)[2][2][4][2], const Unit& u, int wr, int wc, int fr, int fq) const {
        const int col0 = u.pn * BM + wc * 32 + 4 * fq, b = u.pm >> 3;
        f32x4 gv[2][2];
#pragma unroll
        for (int bj = 0; bj < 2; ++bj)
#pragma unroll
            for (int n = 0; n < 2; ++n) gv[bj][n] = *(const f32x4*)(mod + b * 6144 + 4096 + col0 + bj * HALF + n * 16) + *(const f32x4*)(bada + 4096 + col0 + bj * HALF + n * 16);
#pragma unroll
        for (int ai = 0; ai < 2; ++ai)
#pragma unroll
            for (int m = 0; m < 4; ++m) {
                const size_t row = (size_t)u.pm * BM + ai * HALF + wr * 64 + m * 16 + fr; float ss = 0.f;
#pragma unroll
                for (int bj = 0; bj < 2; ++bj)
#pragma unroll
                    for (int n = 0; n < 2; ++n) {
                        const size_t off = row * 2048 + col0 + bj * HALF + n * 16;
                        const f32x4 o = *(const f32x4*)(x + off) + gv[bj][n] * acc[ai][bj][m][n];
                        *(f32x4*)(out + off) = o; ss += (o[0] * o[0] + o[1] * o[1]) + (o[2] * o[2] + o[3] * o[3]);
                    }
                ss += __shfl_xor(ss, 16); ss += __shfl_xor(ss, 32);
                if (fq == 0) atomicAdd(rowsq + row, ss);
                asm volatile("" ::: "memory");
            }
    }
};

__device__ __forceinline__ float gelu_tanh(float x) {
    const float z = 0.7978845608028654f * (x + 0.044715f * x * x * x);
    const float th = 1.0f - 2.0f * __builtin_amdgcn_rcpf(1.0f + __builtin_amdgcn_exp2f(2.8853900817779268f * z));
    return 0.5f * x * (1.0f + th);
}
struct EpiS {
    static constexpr bool PERM = false, AFTER_DRAIN = false, HAS_MID = false;
    float* S; int tmid;
    __device__ __forceinline__ void mid(f32x4 (&)[2][2][4][2], const Unit&, int, int, int, int) const {}
    __device__ __forceinline__ void operator()(const f32x4 (&acc)[2][2][4][2], const Unit& u, int wr, int wc, int fr, int fq) const {
        const int col0 = wc * 32 + 4 * fq;
#pragma unroll
        for (int ai = 0; ai < 2; ++ai)
#pragma unroll
            for (int m = 0; m < 4; ++m) { float* rowp = S + ((size_t)u.pm * BM + ai * HALF + wr * 64 + m * 16 + fr) * 256 + col0;
#pragma unroll
                for (int bj = 0; bj < 2; ++bj)
#pragma unroll
                    for (int n = 0; n < 2; ++n) *(f32x4*)(rowp + bj * HALF + n * 16) = acc[ai][bj][m][n]; }
    }
};
struct EpiY {
    static constexpr bool PERM = true, AFTER_DRAIN = false, HAS_MID = false;
    bf16_t* Y; int tmid;
    __device__ __forceinline__ void mid(f32x4 (&)[2][2][4][2], const Unit&, int, int, int, int) const {}
    __device__ __forceinline__ void operator()(const f32x4 (&acc)[2][2][4][2], const Unit& u, int wr, int wc, int fr, int fq) const {
        const int g = u.pn, rt = u.pm - 5 * g;
#pragma unroll
        for (int ai = 0; ai < 2; ++ai)
#pragma unroll
            for (int m = 0; m < 4; ++m) {
                const int R = rt * 256 + ai * HALF + wr * 64 + m * 16 + fr, b = R >> 7, k = R & 127;
#pragma unroll
                for (int bj = 0; bj < 2; ++bj) {
                    const int col8 = bj * HALF + wc * 32 + 8 * fq, t = col8 >> 4, c0 = col8 & 15;
                    f32x4 y0 = acc[ai][bj][m][0], y1 = acc[ai][bj][m][1];
#pragma unroll
                    for (int e = 0; e < 4; ++e) { y0[e] = gelu_tanh(y0[e]); y1[e] = gelu_tanh(y1[e]); }
                    *(u32x4*)(Y + ((size_t)(b * 2048 + k * 16 + t) * 512 + g * 16 + c0)) = pack8(y0, y1);
                }
                asm volatile("" ::: "memory");
            }
    }
};
template <class Epi, class Sched, bool ALIGN_EPI = false, bool SP2 = false>
__device__ __forceinline__ void gemm_phase(PG8_LAS unsigned char* lds, const Gemm g, const Sched& S, const Epi& E, const int wid) {
    const int lane = lane_id_v(), tid = wid * 64 + lane, wr = wid >> 2, wc = wid & 3, fr = lane & 15, fq = lane >> 4;
    const int K = g.K, nt = K / BK;
    unsigned voffA[2], voffB[2];
#pragma unroll
    for (int i = 0; i < 2; ++i) { int R, C; stage_rc(tid * 16 + i * 8192, R, C); const int Rb = Epi::PERM ? ((R & ~31) + perm32(R & 31)) : R;
        voffA[i] = (unsigned)(R * g.lda + C) * 2u; voffB[i] = (unsigned)(Rb * g.ldb + C) * 2u; }
    const size_t kstep = (size_t)(BK * 2);
    const size_t hstepA = (size_t)HALF * g.lda * 2, hstepB = (size_t)HALF * g.ldb * 2;
    const size_t tstepA = 2 * hstepA, tstepB = 2 * hstepB;
    const unsigned ldsw = (unsigned)wid * 1024u;
    const int aoff = lds_byte(wr * 64 + fr, fq * 8), boff = lds_byte(wc * 32 + fr, fq * 8);
#define PG8_SA(b, h) (((b) * 2 + (h)) * HTB)
#define PG8_SB(b, h) ((4 + (b) * 2 + (h)) * HTB)
#define PG8_STAGE(bufoff, gbase, voff) do { _Pragma("unroll") for (int _i = 0; _i < 2; ++_i) \
        __builtin_amdgcn_global_load_lds((const unsigned*)((const char*)(gbase) + (voff)[_i]), (PG8_LAS unsigned*)(lds + (bufoff) + ldsw + _i * 8192), 16, 0, 0); } while (0)
#define PG8_LDA(dst, b, h) do { _Pragma("unroll") for (int m = 0; m < 4; ++m) _Pragma("unroll") for (int k = 0; k < 2; ++k) dst[m][k] = *(const PG8_LAS bf16x8*)(lds + PG8_SA(b, h) + aoff + m * 2048 + k * 1024); } while (0)
#define PG8_LDB(dst, b, h) do { _Pragma("unroll") for (int n = 0; n < 2; ++n) _Pragma("unroll") for (int k = 0; k < 2; ++k) dst[n][k] = *(const PG8_LAS bf16x8*)(lds + PG8_SB(b, h) + boff + n * 2048 + k * 1024); } while (0)
#define PG8_MMA(ai, bj, At, Bt) do { __builtin_amdgcn_s_setprio(1); _Pragma("unroll") for (int m = 0; m < 4; ++m) _Pragma("unroll") for (int n = 0; n < 2; ++n) _Pragma("unroll") for (int k = 0; k < 2; ++k) \
        acc[ai][bj][m][n] = __builtin_amdgcn_mfma_f32_16x16x32_bf16(Bt[n][k], At[m][k], acc[ai][bj][m][n], 0, 0, 0); __builtin_amdgcn_s_setprio(0); } while (0)
#define PG8_WAIT_V(n) asm volatile("s_waitcnt vmcnt(" #n ")" ::: "memory")
#define PG8_WAIT_L(n) asm volatile("s_waitcnt lgkmcnt(" #n ")" ::: "memory")
#define PG8_BAR __builtin_amdgcn_s_barrier()
#define PG8_SCHED __builtin_amdgcn_sched_barrier(0)
    Unit cur, nxt; int ui = 0;
    if (!S.next(0, cur)) return;
    f32x4 acc[2][2][4][2];
#pragma unroll
    for (int a = 0; a < 2; ++a)
#pragma unroll
        for (int b = 0; b < 2; ++b)
#pragma unroll
            for (int m = 0; m < 4; ++m)
#pragma unroll
                for (int n = 0; n < 2; ++n) acc[a][b][m][n] = (f32x4){0.f, 0.f, 0.f, 0.f};
    bf16x8 At[4][2], B0[2][2], B1[2][2];
    const char* cA = (const char*)g.A + (size_t)cur.pm * tstepA; const char* cB = (const char*)g.Bt + (size_t)cur.pn * tstepB;
    S.a_ready(cur);
    if constexpr (SP2) {
        PG8_STAGE(PG8_SB(0, 0), cB, voffB); PG8_STAGE(PG8_SB(0, 1), cB + hstepB, voffB); PG8_STAGE(PG8_SA(0, 0), cA, voffA); PG8_STAGE(PG8_SA(0, 1), cA + hstepA, voffA);
        if (wr == 1) PG8_BAR;
        PG8_WAIT_V(2); PG8_BAR;
        PG8_STAGE(PG8_SB(1, 0), cB + kstep, voffB); PG8_STAGE(PG8_SA(1, 0), cA + kstep, voffA); PG8_STAGE(PG8_SB(1, 1), cB + hstepB + kstep, voffB);
        PG8_WAIT_V(6); PG8_BAR;
    } else {
        PG8_STAGE(PG8_SB(0, 0), cB, voffB); PG8_STAGE(PG8_SA(0, 0), cA, voffA); PG8_STAGE(PG8_SB(0, 1), cB + hstepB, voffB); PG8_STAGE(PG8_SA(0, 1), cA + hstepA, voffA);
        if (wr == 1) PG8_BAR;
        PG8_WAIT_V(4); PG8_BAR;
        PG8_STAGE(PG8_SB(1, 0), cB + kstep, voffB); PG8_STAGE(PG8_SA(1, 0), cA + kstep, voffA); PG8_STAGE(PG8_SB(1, 1), cB + hstepB + kstep, voffB);
        PG8_WAIT_V(6); PG8_BAR;
    }
    for (;;) {
        const bool has_next = S.next(ui + 1, nxt);
        const char* nA = has_next ? (const char*)g.A + (size_t)nxt.pm * tstepA : cA; const char* nB = has_next ? (const char*)g.Bt + (size_t)nxt.pn * tstepB : cB;
        for (int t = 0; t < nt; t += 2) {
            const bool last = (t == nt - 2);
            const char* a1 = cA + (size_t)(t + 1) * kstep;
            const char* a2 = last ? nA : cA + (size_t)(t + 2) * kstep; const char* b2 = last ? nB : cB + (size_t)(t + 2) * kstep;
            const char* a3 = a2 + kstep; const char* b3 = b2 + kstep;
            if (last && has_next) S.a_ready(nxt);
            if constexpr (Epi::HAS_MID) { if (t == E.tmid) E.mid(acc, cur, wr, wc, fr, fq); }
            if constexpr (SP2) {
            PG8_LDB(B0, 0, 0); PG8_LDB(B1, 0, 1); PG8_SCHED; PG8_LDA(At, 0, 0); PG8_STAGE(PG8_SA(1, 1), a1 + hstepA, voffA);
            PG8_WAIT_V(8); PG8_WAIT_L(0); PG8_BAR; PG8_MMA(0, 0, At, B0); PG8_MMA(0, 1, At, B1); PG8_BAR; PG8_SCHED;
            PG8_LDA(At, 0, 1); PG8_STAGE(PG8_SB(0, 0), b2, voffB); PG8_STAGE(PG8_SB(0, 1), b2 + hstepB, voffB); PG8_STAGE(PG8_SA(0, 0), a2, voffA);
            PG8_WAIT_V(8); PG8_WAIT_L(0); PG8_BAR; PG8_MMA(1, 0, At, B0); PG8_MMA(1, 1, At, B1); PG8_BAR; PG8_SCHED;
            PG8_LDB(B0, 1, 0); PG8_LDB(B1, 1, 1); PG8_SCHED; PG8_LDA(At, 1, 0); PG8_STAGE(PG8_SA(0, 1), a2 + hstepA, voffA);
            PG8_WAIT_V(8); PG8_WAIT_L(0); PG8_BAR; PG8_MMA(0, 0, At, B0); PG8_MMA(0, 1, At, B1); PG8_BAR; PG8_SCHED;
            PG8_LDA(At, 1, 1); PG8_STAGE(PG8_SB(1, 0), b3, voffB); PG8_STAGE(PG8_SB(1, 1), b3 + hstepB, voffB); PG8_STAGE(PG8_SA(1, 0), a3, voffA);
            PG8_WAIT_V(8); PG8_WAIT_L(0); PG8_BAR; PG8_MMA(1, 0, At, B0); PG8_MMA(1, 1, At, B1); PG8_BAR; PG8_SCHED;
            } else {
            PG8_LDB(B0, 0, 0); PG8_SCHED; PG8_LDA(At, 0, 0); PG8_STAGE(PG8_SA(1, 1), a1 + hstepA, voffA);
            PG8_WAIT_L(8); PG8_BAR; PG8_WAIT_L(0); PG8_MMA(0, 0, At, B0); PG8_BAR; PG8_SCHED;
            PG8_LDB(B1, 0, 1); PG8_STAGE(PG8_SB(0, 0), b2, voffB);
            PG8_BAR; PG8_WAIT_L(0); PG8_MMA(0, 1, At, B1); PG8_BAR;
            PG8_LDA(At, 0, 1); PG8_STAGE(PG8_SA(0, 0), a2, voffA);
            PG8_BAR; PG8_WAIT_L(0); PG8_MMA(1, 0, At, B0); PG8_BAR; PG8_SCHED;
            PG8_STAGE(PG8_SB(0, 1), b2 + hstepB, voffB);
            PG8_WAIT_V(6); PG8_BAR; PG8_MMA(1, 1, At, B1); PG8_BAR;
            PG8_LDB(B0, 1, 0); PG8_SCHED; PG8_LDA(At, 1, 0); PG8_STAGE(PG8_SA(0, 1), a2 + hstepA, voffA);
            PG8_WAIT_L(8); PG8_BAR; PG8_WAIT_L(0); PG8_MMA(0, 0, At, B0); PG8_BAR; PG8_SCHED;
            PG8_LDB(B1, 1, 1); PG8_STAGE(PG8_SB(1, 0), b3, voffB);
            PG8_BAR; PG8_WAIT_L(0); PG8_MMA(0, 1, At, B1); PG8_BAR;
            PG8_LDA(At, 1, 1); PG8_STAGE(PG8_SA(1, 0), a3, voffA);
            PG8_BAR; PG8_WAIT_L(0); PG8_MMA(1, 0, At, B0); PG8_BAR; PG8_SCHED;
            PG8_STAGE(PG8_SB(1, 1), b3 + hstepB, voffB);
            PG8_WAIT_V(6); PG8_BAR; PG8_MMA(1, 1, At, B1); PG8_BAR;
            }
        }
        if constexpr (ALIGN_EPI) { if (wr == 0) PG8_BAR; }
        if constexpr (!Epi::AFTER_DRAIN) { E(acc, cur, wr, wc, fr, fq); S.done(cur); }
        if (!has_next) break;
#pragma unroll
        for (int a = 0; a < 2; ++a)
#pragma unroll
            for (int b = 0; b < 2; ++b)
#pragma unroll
                for (int m = 0; m < 4; ++m)
#pragma unroll
                    for (int n = 0; n < 2; ++n) acc[a][b][m][n] = (f32x4){0.f, 0.f, 0.f, 0.f};
        cur = nxt; cA = nA; cB = nB; ++ui;
        if constexpr (ALIGN_EPI) { if (wr == 1) PG8_BAR; }
    }
    PG8_WAIT_V(0);
    if constexpr (!ALIGN_EPI) { if (wr == 0) PG8_BAR; }
    PG8_BAR;
    if constexpr (Epi::AFTER_DRAIN) { E.fused(acc, cur, wr, wc, fr, fq, lds, wid, lane); S.done(cur); }
#undef PG8_SA
#undef PG8_SB
#undef PG8_STAGE
#undef PG8_LDA
#undef PG8_LDB
#undef PG8_MMA
#undef PG8_WAIT_V
#undef PG8_WAIT_L
#undef PG8_BAR
#undef PG8_SCHED
}
}

#ifndef PG8_SP2
#define PG8_SP2 true
#endif
#ifndef PG8_ALIGN
#define PG8_ALIGN true
#endif
#define GAS __attribute__((address_space(1)))
#define LAS __attribute__((address_space(3)))
typedef unsigned short bf16;
typedef unsigned v4u __attribute__((ext_vector_type(4)));
typedef float f32x4 __attribute__((ext_vector_type(4)));
typedef short bf16x8 __attribute__((ext_vector_type(8)));
typedef GAS unsigned gu32;
typedef GAS unsigned long long gu64;
#define RLX_AGENT __ATOMIC_RELAXED, __HIP_MEMORY_SCOPE_AGENT
#define LDS_WAIT() asm volatile("s_waitcnt lgkmcnt(0)" ::: "memory")
#define VM_WAIT() asm volatile("s_waitcnt vmcnt(0)" ::: "memory")
__device__ __forceinline__ unsigned long long rt() { return __builtin_amdgcn_s_memrealtime(); }
__device__ __forceinline__ unsigned f2bf(float f) { unsigned u = __builtin_bit_cast(unsigned, f); return (u + 0x7fffu + ((u >> 16) & 1u)) >> 16; }
__device__ __forceinline__ unsigned pk2(float lo, float hi) { return f2bf(lo) | (f2bf(hi) << 16); }

#define XB_TMO      128
#define XB_XCNT(j)  (256  + 64 * (j))
#define XB_XSUB(j)  (1280 + 64 * (j))
#define XB_XGEN(j)  (2304 + 64 * (j))
#define XB_TOP      3328
#define XB_TOPGEN   3392
#define XCD_BAR_WORDS 3456
#define XB_SPIN_CAP (1u << 18)

__device__ __forceinline__ unsigned xb_ld(unsigned* p)              { return __hip_atomic_load(p, __ATOMIC_RELAXED, __HIP_MEMORY_SCOPE_AGENT); }
__device__ __forceinline__ unsigned xb_add(unsigned* p, unsigned v) { return __hip_atomic_fetch_add(p, v, __ATOMIC_RELAXED, __HIP_MEMORY_SCOPE_AGENT); }
__device__ __forceinline__ unsigned xb_xcc_id() { return (unsigned)__builtin_amdgcn_s_getreg((3 << 11) | 20) & 0xFu; }
#define XB_SPIN(cond, bar) do { unsigned _sp = 0; while (cond) { __builtin_amdgcn_s_sleep(1); \
    if ((++_sp & 255u) == 0u) { if (xb_ld(&(bar)[XB_TMO])) break; if (_sp > XB_SPIN_CAP) { atomicAdd(&(bar)[XB_TMO], 1u); break; } } } } while (0)

struct XcdBarrier {
    unsigned* bar; unsigned x;
    volatile LAS unsigned* st;
};

__device__ __forceinline__ XcdBarrier xcd_barrier_post(unsigned* bar, volatile LAS unsigned* st) {
    XcdBarrier b; b.bar = bar; b.x = xb_xcc_id(); b.st = st;
    if (threadIdx.x == 0) (void)xb_add(&bar[XB_XCNT(b.x)], 1u);
    return b;
}
__device__ __forceinline__ void xcd_barrier_complete(unsigned* bar, unsigned x, unsigned& nloc, unsigned& nx) {
    const unsigned G = gridDim.x * gridDim.y * gridDim.z;
    unsigned sum, cnt, mine, sp = 0u;
    for (;;) {
        sum = 0u; cnt = 0u; mine = 0u;
#pragma unroll
        for (unsigned j = 0; j < 16; ++j) { const unsigned c = xb_ld(&bar[XB_XCNT(j)]); sum += c; cnt += (c > 0u) ? 1u : 0u; mine = (j == x) ? c : mine; }
        if (sum == G) break;
        __builtin_amdgcn_s_sleep(1);
        if ((++sp & 255u) == 0u) { if (xb_ld(&bar[XB_TMO])) break; if (sp > XB_SPIN_CAP) { atomicAdd(&bar[XB_TMO], 1u); break; } }
    }
    nloc = mine > 0u ? mine : 1u; nx = cnt > 0u ? cnt : 1u;
}

__device__ __forceinline__ void xcd_barrier(const XcdBarrier& b, const int wave) {
    asm volatile("s_waitcnt vmcnt(0)" ::: "memory");
    __syncthreads();
    if (wave == 0 && pg8::lane_id_v() == 0) {
        unsigned* bar = b.bar;
        __builtin_amdgcn_s_waitcnt(0);
        unsigned nloc = b.st[0], nx = b.st[1];
        if (nloc == 0u) { xcd_barrier_complete(bar, b.x, nloc, nx); b.st[0] = nloc; b.st[1] = nx; }
        const unsigned old = xb_add(&bar[XB_XSUB(b.x)], 1u);
        const unsigned gen = old / nloc;
        if (old + 1u == (gen + 1u) * nloc) {
            __builtin_amdgcn_fence(__ATOMIC_RELEASE, "agent");
            asm volatile("s_waitcnt vmcnt(0)" ::: "memory");
            const unsigned og = xb_add(&bar[XB_TOP], 1u);
            const unsigned tg = og / nx;
            if (og + 1u == (tg + 1u) * nx) xb_add(&bar[XB_TOPGEN], 1u);
            else XB_SPIN(xb_ld(&bar[XB_TOPGEN]) == tg, bar);
            __builtin_amdgcn_fence(__ATOMIC_ACQUIRE, "agent");
            xb_add(&bar[XB_XGEN(b.x)], 1u);
            asm volatile("s_waitcnt vmcnt(0)" ::: "memory");
        } else {
            XB_SPIN(xb_ld(&bar[XB_XGEN(b.x)]) == gen, bar);
            __builtin_amdgcn_fence(__ATOMIC_ACQUIRE, "agent");
            asm volatile("s_waitcnt vmcnt(0)" ::: "memory");
        }
    }
    __syncthreads();
}

#include <hip/hip_bf16.h>
#include <cmath>
namespace attn_body {
using bf16=__hip_bfloat16;
using bf16x8=__attribute__((ext_vector_type(8)))short;
using s16x4=__attribute__((ext_vector_type(4)))short;
using f32x16=__attribute__((ext_vector_type(16)))float;
using u32x4=__attribute__((ext_vector_type(4)))unsigned;
constexpr int D=64,DM=1024,SEQQ=2048,SEQKV=2304;
constexpr int NW=8,QBLK=32,QB=QBLK*NW,KVBLK=64,NQB=SEQQ/QB;
constexpr int ATTN_PITCH=DM, ATTN_UNIT_ROWS=QB;
__device__ __forceinline__ int crow(int r,int hi){return (r&3)+8*(r>>2)+4*hi;}
#define SBAR() __builtin_amdgcn_sched_barrier(0)
__device__ __forceinline__ void cmask(f32x16&p0,f32x16&p1,int jb,int qrel,int hi){
  const float NEG=-INFINITY; int kb=64*jb+4*hi;
  #pragma unroll
  for(int r=0;r<16;++r){int kv=kb+(r&3)+8*(r>>2); if(kv>qrel)p0[r]=NEG; if(kv+32>qrel)p1[r]=NEG;}
}

constexpr int NSLOT=3, SLOTB=8192;
constexpr int LDS_K=0, LDS_V=NSLOT*SLOTB, LDS_WS=2*NSLOT*SLOTB, LDS_OST=LDS_WS+NW*64*4, LDS_BYTES=LDS_OST+NW*4096;
constexpr float C2=0.125f*1.4426950408889634f;
__device__ __forceinline__ void glds16(const void*gsrc,unsigned lds_dst){unsigned keep;
  asm volatile("s_mov_b32 %0, m0\n\ts_mov_b32 m0, %2\n\ts_nop 0\n\tglobal_load_lds_dwordx4 %1, off\n\ts_mov_b32 m0, %0":"=&s"(keep):"v"(gsrc),"s"(lds_dst):"memory");}
__device__ __forceinline__ float max3f(float a,float b,float c){float r;asm("v_max3_f32 %0, %1, %2, %3":"=v"(r):"v"(a),"v"(b),"v"(c));return r;}
__device__ __forceinline__ float max2f(float a,float b){float r;asm("v_max_f32_e32 %0, %1, %2":"=v"(r):"v"(a),"v"(b));return r;}
__device__ __forceinline__ float fadd_s(float a,float b){float r;asm("v_add_f32_e32 %0, %1, %2":"=v"(r):"v"(a),"v"(b));return r;}
__device__ __forceinline__ float fsub_s(float a,float b){float r;asm("v_sub_f32_e32 %0, %1, %2":"=v"(r):"v"(a),"v"(b));return r;}
typedef float f32x2_t __attribute__((ext_vector_type(2))); typedef __bf16 bf16x2_t __attribute__((ext_vector_type(2)));
__device__ __forceinline__ unsigned cvtpk_s(float lo,float hi){f32x2_t v={lo,hi};bf16x2_t b=__builtin_convertvector(v,bf16x2_t);return __builtin_bit_cast(unsigned,b);}
#define WAIT_BAR(N) asm volatile("s_waitcnt vmcnt(" #N ") lgkmcnt(0)\n\ts_barrier":::"memory")

__device__ __forceinline__ void qkt(f32x16&p0,f32x16&p1,const char*Kslot,const bf16x8*qr,const f32x16&negm,int r32,int hi){
  const char*kb=Kslot+hi*1024+r32*16;
  #pragma unroll
  for(int d0=0;d0<4;++d0){
    const bf16x8 b0=*reinterpret_cast<const bf16x8*>(kb+d0*2048);
    const bf16x8 b1=*reinterpret_cast<const bf16x8*>(kb+d0*2048+512);
    if(d0==0){p0=__builtin_amdgcn_mfma_f32_32x32x16_bf16(b0,qr[0],negm,0,0,0);p1=__builtin_amdgcn_mfma_f32_32x32x16_bf16(b1,qr[0],negm,0,0,0);}
    else{p0=__builtin_amdgcn_mfma_f32_32x32x16_bf16(b0,qr[d0],p0,0,0,0);p1=__builtin_amdgcn_mfma_f32_32x32x16_bf16(b1,qr[d0],p1,0,0,0);}}
}
typedef __attribute__((address_space(3))) const char* lds_cptr;
typedef short v4i16_t __attribute__((ext_vector_type(4)));
__device__ __forceinline__ void kload8(bf16x8*kf,lds_cptr kp){
  kf[0]=*(const __attribute__((address_space(3))) bf16x8*)(kp);      kf[1]=*(const __attribute__((address_space(3))) bf16x8*)(kp+512);
  kf[2]=*(const __attribute__((address_space(3))) bf16x8*)(kp+2048); kf[3]=*(const __attribute__((address_space(3))) bf16x8*)(kp+2560);
  kf[4]=*(const __attribute__((address_space(3))) bf16x8*)(kp+4096); kf[5]=*(const __attribute__((address_space(3))) bf16x8*)(kp+4608);
  kf[6]=*(const __attribute__((address_space(3))) bf16x8*)(kp+6144); kf[7]=*(const __attribute__((address_space(3))) bf16x8*)(kp+6656);
}
__device__ __forceinline__ void kload2(bf16x8*kf,lds_cptr kp,int j){ kf[2*j]=*(const __attribute__((address_space(3))) bf16x8*)(kp+j*2048); kf[2*j+1]=*(const __attribute__((address_space(3))) bf16x8*)(kp+j*2048+512); }
__device__ __forceinline__ s16x4 vtr(lds_cptr p){ return __builtin_bit_cast(s16x4,__builtin_amdgcn_ds_read_tr16_b64_v4i16((__attribute__((address_space(3))) v4i16_t*)p)); }
__device__ __forceinline__ float rowmax(const f32x16&p0,const f32x16&p1){
  float a=max3f(p0[0],p0[1],p1[0]),b=max3f(p0[2],p0[3],p1[1]);a=max3f(a,p1[2],p1[3]);
  #pragma unroll
  for(int r=4;r<16;r+=4){a=max3f(a,p0[r],p0[r+1]);b=max3f(b,p0[r+2],p0[r+3]);a=max3f(a,p1[r],p1[r+1]);b=max3f(b,p1[r+2],p1[r+3]);}
  const float m=max2f(a,b);
  auto rr=__builtin_amdgcn_permlane32_swap(__float_as_uint(m),__float_as_uint(m),false,false);
  return max2f(__uint_as_float(rr[0]),__uint_as_float(rr[1]));
}
__device__ __forceinline__ void pv(f32x16*o,int vb,bf16x8 pa0,bf16x8 pa1,bf16x8 pa2,bf16x8 pa3){
  #pragma unroll
  for(int d0=0;d0<2;++d0){s16x4 lo[4],hi[4];
    #pragma unroll
    for(int ks=0;ks<4;++ks){
      asm volatile("ds_read_b64_tr_b16 %0,%1 offset:%c2":"=&v"(lo[ks]):"v"(vb),"i"(d0*4096+ks*1024):"memory");
      asm volatile("ds_read_b64_tr_b16 %0,%1 offset:%c2":"=&v"(hi[ks]):"v"(vb),"i"(d0*4096+ks*1024+512):"memory");}
    asm volatile("s_waitcnt lgkmcnt(0)":::"memory");SBAR();
    #define PK(k) (bf16x8){lo[k][0],lo[k][1],lo[k][2],lo[k][3],hi[k][0],hi[k][1],hi[k][2],hi[k][3]}
    o[d0]=__builtin_amdgcn_mfma_f32_32x32x16_bf16(pa0,PK(0),o[d0],0,0,0);
    o[d0]=__builtin_amdgcn_mfma_f32_32x32x16_bf16(pa1,PK(1),o[d0],0,0,0);
    o[d0]=__builtin_amdgcn_mfma_f32_32x32x16_bf16(pa2,PK(2),o[d0],0,0,0);
    o[d0]=__builtin_amdgcn_mfma_f32_32x32x16_bf16(pa3,PK(3),o[d0],0,0,0);
    #undef PK
  }
}

#ifndef ATTN_STORE16
#define ATTN_STORE16(p,v) (*(u32x4*)(p)=(v))
#endif
template<int THRL> __device__ __forceinline__ void attn_unit(int b,int qb,int qcol,int kcol,int vcol,int ocol,const bf16*Q,const bf16*__restrict__ K,const bf16*__restrict__ V,bf16*O,char*shm,const int wid){
  const int lane=pg8::lane_id_v(),r32=lane&31,hi=lane>>5;
  const long rowq=(long)b*SEQQ, rowkv=(long)b*SEQKV; const int q0=qb*QB;
  const bf16*Qw=Q+(rowq+q0+wid*QBLK)*DM+qcol;
  const bf16*Kh=K+rowkv*DM+kcol,*Vh=V+rowkv*DM+vcol;
  const unsigned lds0=(unsigned)(uintptr_t)shm;
  float*wsf=(float*)(shm+LDS_WS)+wid*64;
  const bf16*ksrc=Kh+(long)lane*DM+wid*8;
  const bf16*vsrc=Vh+(long)(16*(wid&3)+(lane>>2))*DM+(wid>>2)*32+(lane&3)*8;
  const unsigned kdst=lds0+LDS_K+wid*1024, vdst=lds0+LDS_V+wid*1024;
  #define DMA_K(t,slot) glds16(ksrc+(long)(t)*KVBLK*DM,(unsigned)__builtin_amdgcn_readfirstlane(kdst+(slot)))
  #define DMA_V(t,slot) glds16(vsrc+(long)(t)*KVBLK*DM,(unsigned)__builtin_amdgcn_readfirstlane(vdst+(slot)))
  const int vb0=(int)(lds0+LDS_V)+((lane>>4)&1)*32+(lane&3)*8+(4*hi+((lane&15)>>2))*64;
  const char*Kbase=shm+LDS_K; bf16x8 kf[8];
  const lds_cptr shm3=(lds_cptr)shm; const lds_cptr kp0=shm3+LDS_K+hi*1024+r32*16; const lds_cptr vp0=shm3+LDS_V+((lane>>4)&1)*32+(lane&3)*8+(4*hi+((lane&15)>>2))*64;
  constexpr int NT=SEQKV/KVBLK;
  DMA_K(0,0);DMA_V(0,0);DMA_K(1,SLOTB);
  bf16x8 qr[4];
  #pragma unroll
  for(int d0=0;d0<4;++d0)qr[d0]=*reinterpret_cast<const bf16x8*>(&Qw[(long)r32*DM+d0*16+hi*8]);
  float mhat=0.f,l_reg=0.f;f32x16 o[2];o[0]=f32x16{};o[1]=f32x16{};f32x16 negm=f32x16{};asm volatile("":"+v"(negm));
    #define CMASK(P0,P1,t) do{}while(0)
  bool resc=false;
  #define START(P0,P1) do{ const float rm=rowmax(P0,P1); resc=false; \
    { const float dl=rm; mhat=fadd_s(mhat,dl); \
      _Pragma("unroll") for(int r=0;r<16;++r){P0[r]=fsub_s(P0[r],dl);P1[r]=fsub_s(P1[r],dl);} \
      _Pragma("unroll") for(int r=0;r<16;++r)negm[r]=-mhat; asm volatile("":"+v"(negm)); } \
    _Pragma("unroll") for(int r=0;r<16;++r)P0[r]=__builtin_amdgcn_exp2f(P0[r]); }while(0)
  #define RESC() do{ if(resc){ asm volatile("s_waitcnt lgkmcnt(0)":::"memory"); \
      _Pragma("unroll") for(int d_=0;d_<2;++d_) _Pragma("unroll") for(int r=0;r<16;++r)o[d_][r]*=wsf[crow(r,hi)]; } }while(0)
  f32x16 pA0,pA1,pB0,pB1;
  int sl_prev=0,sl_cur=0,sl_next=SLOTB;
  #define ROT() do{sl_prev=sl_cur;sl_cur=sl_next;sl_next=(sl_next==(NSLOT-1)*SLOTB)?0:sl_next+SLOTB;}while(0)
  DMA_K(2,2*SLOTB);
  WAIT_BAR(3);
  qkt(pA0,pA1,Kbase,qr,negm,r32,hi);asm volatile("s_nop 15\n\ts_nop 7":"+v"(pA0),"+v"(pA1));CMASK(pA0,pA1,0);
  START(pA0,pA1);
  _Pragma("unroll") for(int r=0;r<16;++r)pA1[r]=__builtin_amdgcn_exp2f(pA1[r]);
  WAIT_BAR(0);
  DMA_K(3,0);DMA_V(1,SLOTB);
  ROT();
  kload8(kf,kp0+sl_cur);
  WAIT_BAR(2);
  s16x4 vlo[8],vhi[8]; u32x4 pw0,pw1,pw2,pw3;
  #define PKW(P,B) cvtpk_s(P[B],P[B+1])
  #define PAF(k) __builtin_bit_cast(bf16x8,pw##k)
  #define VFR(i) (bf16x8){vlo[i][0],vlo[i][1],vlo[i][2],vlo[i][3],vhi[i][0],vhi[i][1],vhi[i][2],vhi[i][3]}
  #define PIN(x) asm volatile("":"+v"(x))
  #define MX3(a,b,c) __builtin_fmaxf(__builtin_fmaxf((a),(b)),(c))
  #define GAPA(MF,A0,A1,A2,A3,W0,W1,PW) do{ MF; sacc+=A0; sacc+=A1; sacc+=A2; sacc+=A3; PIN(sacc); W0; W1; PIN(PW); SBAR(); }while(0)
  #define EX(v) __builtin_amdgcn_exp2f(v)
  #define GAPB(MF,X,B) do{ MF; X[B]=EX(X[B]); X[B+1]=EX(X[B+1]); X[B+2]=EX(X[B+2]); X[B+3]=EX(X[B+3]); PIN(X); SBAR(); }while(0)
  #define VRD(i) do{ vlo[i]=vtr(vp_+(((i)>>2)*4096+((i)&3)*1024)); vhi[i]=vtr(vp_+(((i)>>2)*4096+((i)&3)*1024+512)); }while(0)
  #define KRD(G,j) do{ if(G){ kload2(kf,kp0+sl_next,j); SBAR(); } }while(0)
  #define STEP(C0,C1,P0,P1,t,GK,GV,GL) do{ SBAR(); \
    const lds_cptr vp_=vp0+sl_prev; \
    VRD(0); SBAR(); float sacc=(P0[0]+P0[1]); \
    GAPA(C0=__builtin_amdgcn_mfma_f32_32x32x16_bf16(kf[0],qr[0],negm,0,0,0), P0[2],P0[3],P0[4],P0[5],     pw0[0]=PKW(P0,0), pw0[1]=PKW(P0,2), pw0); \
    VRD(4); SBAR(); GAPA(C1=__builtin_amdgcn_mfma_f32_32x32x16_bf16(kf[1],qr[0],negm,0,0,0), P0[6],P0[7],P0[8],P0[9],     pw0[2]=PKW(P0,4), pw0[3]=PKW(P0,6), pw0); \
    VRD(1); SBAR(); GAPA(C0=__builtin_amdgcn_mfma_f32_32x32x16_bf16(kf[2],qr[1],C0,0,0,0),   P0[10],P0[11],P0[12],P0[13], pw1[0]=PKW(P0,8), pw1[1]=PKW(P0,10), pw1); \
    VRD(5); SBAR(); GAPA(C1=__builtin_amdgcn_mfma_f32_32x32x16_bf16(kf[3],qr[1],C1,0,0,0),   P0[14],P0[15],P1[0],P1[1],   pw1[2]=PKW(P0,12),pw1[3]=PKW(P0,14), pw1); \
    VRD(2); SBAR(); GAPA(C0=__builtin_amdgcn_mfma_f32_32x32x16_bf16(kf[4],qr[2],C0,0,0,0),   P1[2],P1[3],P1[4],P1[5],     pw2[0]=PKW(P1,0), pw2[1]=PKW(P1,2), pw2); \
    VRD(6); SBAR(); GAPA(C1=__builtin_amdgcn_mfma_f32_32x32x16_bf16(kf[5],qr[2],C1,0,0,0),   P1[6],P1[7],P1[8],P1[9],     pw2[2]=PKW(P1,4), pw2[3]=PKW(P1,6), pw2); \
    VRD(3); SBAR(); GAPA(C0=__builtin_amdgcn_mfma_f32_32x32x16_bf16(kf[6],qr[3],C0,0,0,0),   P1[10],P1[11],P1[12],P1[13], pw3[0]=PKW(P1,8), pw3[1]=PKW(P1,10), pw3); \
    VRD(7); SBAR(); GAPA(C1=__builtin_amdgcn_mfma_f32_32x32x16_bf16(kf[7],qr[3],C1,0,0,0),   P1[14],P1[15],0.f,0.f,       pw3[2]=PKW(P1,12),pw3[3]=PKW(P1,14), pw3); \
    l_reg+=sacc; \
    if(GK){DMA_K((t)+3,sl_cur);} if(GV){DMA_V((t)+1,sl_next);} \
    CMASK(C0,C1,t); \
    { float a=MX3(C0[0],C0[1],C1[0]),b=MX3(C0[2],C0[3],C1[1]); a=MX3(a,C1[2],C1[3]); \
      _Pragma("unroll") for(int r=4;r<16;r+=4){a=MX3(a,C0[r],C0[r+1]);b=MX3(b,C0[r+2],C0[r+3]);a=MX3(a,C1[r],C1[r+1]);b=MX3(b,C1[r+2],C1[r+3]);} \
      float rm=__builtin_fmaxf(a,b); { auto rr=__builtin_amdgcn_permlane32_swap(__float_as_uint(rm),__float_as_uint(rm),false,false); rm=__builtin_fmaxf(__uint_as_float(rr[0]),__uint_as_float(rr[1])); } \
      resc=false; \
      if(__builtin_expect(__any(rm>(float)THRL),0)){ const float dl=__builtin_fmaxf(rm,0.f); mhat+=dl; \
        _Pragma("unroll") for(int r=0;r<16;++r){C0[r]-=dl;C1[r]-=dl;} \
        _Pragma("unroll") for(int r=0;r<16;++r)negm[r]=-mhat; asm volatile("":"+v"(negm)); \
        const float f=__builtin_amdgcn_exp2f(-dl); l_reg*=f; if(hi==0)wsf[r32]=f; resc=true; } } \
    SBAR(); \
    GAPB(o[0]=__builtin_amdgcn_mfma_f32_32x32x16_bf16(PAF(0),VFR(0),o[0],0,0,0), C0,0); \
    GAPB(o[1]=__builtin_amdgcn_mfma_f32_32x32x16_bf16(PAF(0),VFR(4),o[1],0,0,0), C0,4); \
    KRD(GL,0); GAPB(o[0]=__builtin_amdgcn_mfma_f32_32x32x16_bf16(PAF(1),VFR(1),o[0],0,0,0), C0,8); \
    KRD(GL,1); GAPB(o[1]=__builtin_amdgcn_mfma_f32_32x32x16_bf16(PAF(1),VFR(5),o[1],0,0,0), C0,12); \
    KRD(GL,2); GAPB(o[0]=__builtin_amdgcn_mfma_f32_32x32x16_bf16(PAF(2),VFR(2),o[0],0,0,0), C1,0); \
    KRD(GL,3); GAPB(o[1]=__builtin_amdgcn_mfma_f32_32x32x16_bf16(PAF(2),VFR(6),o[1],0,0,0), C1,4); \
    GAPB(o[0]=__builtin_amdgcn_mfma_f32_32x32x16_bf16(PAF(3),VFR(3),o[0],0,0,0), C1,8); \
    GAPB(o[1]=__builtin_amdgcn_mfma_f32_32x32x16_bf16(PAF(3),VFR(7),o[1],0,0,0), C1,12); \
    }while(0)
  int t=1;
  #undef CMASK
  #define CMASK(P0,P1,t) do{}while(0)
  for(;t+5<NT;t+=2){
    STEP(pB0,pB1,pA0,pA1,t,true,true,true);     WAIT_BAR(2); RESC(); ROT();
    STEP(pA0,pA1,pB0,pB1,t+1,true,true,true);   WAIT_BAR(2); RESC(); ROT();
  }
  #undef CMASK
  #define CMASK(P0,P1,t) do{}while(0)
  #define ENDW(tt) do{ if((tt)+3<NT){WAIT_BAR(2);} else if((tt)+2<NT){WAIT_BAR(1);} else {WAIT_BAR(0);} }while(0)
  for(;t+1<NT;t+=2){
    STEP(pB0,pB1,pA0,pA1,t,(t+3<NT),(t+1<NT),(t+1<NT));       ENDW(t);   RESC(); ROT();
    STEP(pA0,pA1,pB0,pB1,t+1,(t+4<NT),(t+2<NT),(t+2<NT));     ENDW(t+1); RESC(); ROT();
  }
  STEP(pB0,pB1,pA0,pA1,NT-1,false,false,false); RESC();
  { float sacc=pB0[0]+pB0[1]; _Pragma("unroll") for(int r=2;r<16;++r)sacc+=pB0[r]; _Pragma("unroll") for(int r=0;r<16;++r)sacc+=pB1[r]; l_reg+=sacc;
    pw0=(u32x4){PKW(pB0,0),PKW(pB0,2),PKW(pB0,4),PKW(pB0,6)};pw1=(u32x4){PKW(pB0,8),PKW(pB0,10),PKW(pB0,12),PKW(pB0,14)};pw2=(u32x4){PKW(pB1,0),PKW(pB1,2),PKW(pB1,4),PKW(pB1,6)};pw3=(u32x4){PKW(pB1,8),PKW(pB1,10),PKW(pB1,12),PKW(pB1,14)};
    SBAR(); pv(o,vb0+sl_cur,PAF(0),PAF(1),PAF(2),PAF(3)); }
  #undef PKW
  #undef PAF
  #undef VFR
  #undef PIN
  #undef MX3
  #undef GAPA
  #undef GAPB
  #undef EX
  #undef VRD
  #undef KRD
  #undef STEP
  #undef ENDW
  {auto rr=__builtin_amdgcn_permlane32_swap(__float_as_uint(l_reg),__float_as_uint(l_reg),false,false);l_reg=__uint_as_float(rr[0])+__uint_as_float(rr[1]);}
  if(hi==0)wsf[32+r32]=l_reg;asm volatile("s_waitcnt lgkmcnt(0)":::"memory");
  float rli[16];
  #pragma unroll
  for(int r=0;r<16;++r)rli[r]=__builtin_amdgcn_rcpf(wsf[32+crow(r,hi)]);
  bf16*Ow=O+(rowq+q0+wid*QBLK)*DM+ocol;
  { bf16*stg=(bf16*)(shm+LDS_OST)+wid*2048;
    #pragma unroll
    for(int r=0;r<16;++r){const int orow=crow(r,hi);
      #pragma unroll
      for(int d0=0;d0<2;++d0)stg[orow*64+d0*32+r32]=__float2bfloat16(o[d0][r]*rli[r]);}
    asm volatile("s_waitcnt lgkmcnt(0)":::"memory");
    #pragma unroll
    for(int i=0;i<4;++i){const int row=i*8+(lane>>3),ch=lane&7; const u32x4 v=*(const u32x4*)(stg+row*64+ch*8); ATTN_STORE16(Ow+(long)row*DM+ch*8,v);} }
  asm volatile("s_waitcnt lgkmcnt(0)\n\ts_barrier":::"memory");
  #undef DMA_K
  #undef DMA_V
  #undef CMASK
  #undef START
  #undef RESC
  #undef ROT
}
constexpr int ATTN_LDS_BYTES=LDS_BYTES;
#undef SBAR
#undef WAIT_BAR
}

constexpr int NWAVES = 8;
#ifndef MK_PER_PHASE
#define MK_PER_PHASE 0
#endif

constexpr int BATCH = 8, SEQ = 2048, DM = 2048, CTXL = 256;
constexpr int MLAT = BATCH * SEQ, MCTX = BATCH * CTXL, MALL = MLAT + MCTX;
constexpr int INW = 9216, KVROWS = SEQ + CTXL;
constexpr float NORM_EPS = 1e-6f, LAM_INIT = 0.2f;
constexpr float QSCALE = 0.125f * 1.4426950408889634f;

constexpr int RING_BYTES = 131072;
constexpr int LDSCTL_OFF = RING_BYTES, MISC_OFF = LDSCTL_OFF + 320;
constexpr int LDS_BYTES = 147456;

struct Args { const float* in[27]; float* out; unsigned char* ws; int ph_lo, ph_hi, li, pad; };
enum In { I_X = 0, I_C, I_CTX, I_CCTX, I_WADA, I_BADA, I_NORMG, I_WIN, I_LQ1, I_LK1, I_LQ2, I_LK2, I_SUBLN, I_LRE, I_LIM, I_LSTEP, I_BRE, I_BIM, I_CRE, I_CIM, I_SSMD, I_WGLU, I_BGLU, I_WPA, I_WPS, I_WOUT, I_FING };

__device__ __forceinline__ float wave_sum(float v) {
#pragma unroll
    for (int o = 1; o < 64; o <<= 1) v += __shfl_xor(v, o);
    return v;
}
using pg8::bf_lo; using pg8::bf_hi; using pg8::unpack8; using pg8::pack8; using pg8::sigmoid_f;
typedef pg8::u32x4 u32x4;

struct TrItem { const float* W; bf16* WT; int N, dpitch, dcol, item; };
__device__ __forceinline__ void tr_load(const TrItem& t, float (&tv)[32], int lane) {
    const int nblk = t.N / 32, kb = t.item / nblk, nb = t.item % nblk, k0 = 64 * kb, n0 = 32 * nb;
#pragma unroll
    for (int i = 0; i < 32; ++i) tv[i] = t.W[(size_t)(k0 + 2 * i + (lane >> 5)) * t.N + n0 + (lane & 31)];
}
__device__ __forceinline__ void tr_store(const TrItem& t, const float (&tv)[32], LAS float* scr, int lane) {
    const int nblk = t.N / 32, kb = t.item / nblk, nb = t.item % nblk, k0 = 64 * kb, n0 = 32 * nb;
#pragma unroll
    for (int i = 0; i < 32; ++i) scr[(2 * i + (lane >> 5)) * 33 + (lane & 31)] = tv[i];
    LDS_WAIT(); asm volatile("" ::: "memory");
    const int c = lane & 7;
#pragma unroll
    for (int j = 0; j < 4; ++j) { const int n = (lane >> 3) + 8 * j; const LAS float* s = scr + (8 * c) * 33 + n;
        v4u o; o.x = pk2(s[0 * 33], s[1 * 33]); o.y = pk2(s[2 * 33], s[3 * 33]); o.z = pk2(s[4 * 33], s[5 * 33]); o.w = pk2(s[6 * 33], s[7 * 33]);
        *(GAS v4u*)(t.WT + (size_t)(n0 + n) * t.dpitch + t.dcol + k0 + 8 * c) = o; }
    LDS_WAIT(); asm volatile("" ::: "memory");
}
__device__ __forceinline__ TrItem tr_item(const Args& a, int it) {
    constexpr int I_IN = (2048 / 64) * (9216 / 32), I_PA = (1024 / 64) * (2048 / 32), I_PS = (512 / 64) * (2048 / 32), I_OUT = (2048 / 64) * (2048 / 32);
    const int m = it < I_IN ? 0 : it < I_IN + I_PA ? 1 : it < I_IN + I_PA + I_PS ? 2 : it < I_IN + I_PA + I_PS + I_OUT ? 3 : 4;
    const float* W = m == 0 ? a.in[I_WIN] : m == 1 ? a.in[I_WPA] : m == 2 ? a.in[I_WPS] : m == 3 ? a.in[I_WOUT] : a.in[I_WGLU];
    const size_t wo = m == 0 ? WS_WIN : m <= 2 ? WS_WCAT : m == 3 ? WS_WOUT : WS_WGLU;
    TrItem t; t.W = W; t.WT = (bf16*)(a.ws + wo);
    t.N = m == 0 ? 9216 : m == 4 ? 512 : 2048; t.dpitch = m == 0 ? 2048 : m <= 2 ? 1536 : m == 3 ? 2048 : 512; t.dcol = m == 2 ? 1024 : 0;
    t.item = it - (m == 0 ? 0 : m == 1 ? I_IN : m == 2 ? I_IN + I_PA : m == 3 ? I_IN + I_PA + I_PS : I_IN + I_PA + I_PS + I_OUT);
    return t;
}
constexpr int TR_NITEMS = (2048 / 64) * (9216 / 32) + (1024 / 64) * (2048 / 32) + (512 / 64) * (2048 / 32) + (2048 / 64) * (2048 / 32) + (512 / 64) * (512 / 32);

__device__ __forceinline__ void ssm_disc(const Args& a, int idx, float& ar, float& ai, float& fr, float& fi) {
    const float lre = a.in[I_LRE][idx], lim = a.in[I_LIM][idx], dt = expf(a.in[I_LSTEP][idx >> 6]);
    const float mag = expf(lre * dt); ar = mag * cosf(lim * dt); ai = mag * sinf(lim * dt);
    const float den = lre * lre + lim * lim;
    fr = ((ar - 1.0f) * lre + ai * lim) / den; fi = (ai * lre - (ar - 1.0f) * lim) / den;
}
__device__ __forceinline__ void p0_prologue(const Args& a, LAS unsigned char* lds, int vcu, int G, int wave, int lane, int rep) {
    unsigned char* ws = a.ws;
    const int gw = vcu * NWAVES + wave, NGW = G * NWAVES;
#ifndef P0_PARTS
#define P0_PARTS 7
#endif
    const int parts = rep ? P0_PARTS : 7;
    {
        float* mod = (float*)(ws + WS_CTL + CTL_MOD + (size_t)rep * 393216);
        const float* wada = a.in[I_WADA]; const float* cc = a.in[I_C]; const float* cctx = a.in[I_CCTX];
        LAS float* sl = (LAS float*)lds;
        __syncthreads();
        for (int i = wave * 64 + lane; i < 9 * 2048; i += NWAVES * 64) { const float cv = i < 16384 ? cc[i] : cctx[i - 16384]; sl[i] = cv * sigmoid_f(cv); }
        __syncthreads();
        if (parts & 1) for (int wi = vcu; wi < 192; wi += G) {
            const int kc = wi / 24, nc = wi % 24, k0 = kc * 256 + wave * 32, n0 = nc * 256 + 4 * lane;
            f32x4 acc[9];
#pragma unroll
            for (int r = 0; r < 9; ++r) acc[r] = (f32x4){0.f, 0.f, 0.f, 0.f};
            {
                f32x4 w[32];
#pragma unroll
                for (int kk = 0; kk < 32; ++kk) w[kk] = *(const f32x4*)(wada + (size_t)(k0 + kk) * 6144 + n0);
#pragma unroll
                for (int q = 0; q < 8; ++q)
#pragma unroll
                    for (int r = 0; r < 9; ++r) { const f32x4 s = *(const LAS f32x4*)(sl + r * 2048 + k0 + 4 * q); acc[r] += w[4 * q] * s[0] + w[4 * q + 1] * s[1] + w[4 * q + 2] * s[2] + w[4 * q + 3] * s[3]; }
            }
            __syncthreads();
            LAS float* red = (LAS float*)lds;
#pragma unroll
            for (int r = 0; r < 9; ++r) *(LAS f32x4*)(red + (wave * 9 + r) * 256 + 4 * lane) = acc[r];
            __syncthreads();
            for (int o = wave * 64 + lane; o < 9 * 256; o += NWAVES * 64) {
                float s = 0.f;
#pragma unroll
                for (int w8 = 0; w8 < 8; ++w8) s += red[w8 * 9 * 256 + o];
                atomicAdd(mod + (o >> 8) * 6144 + nc * 256 + (o & 255), s);
            }
            __syncthreads();
            if (wi + G < 192) { for (int i = wave * 64 + lane; i < 9 * 2048; i += NWAVES * 64) { const float cv = i < 16384 ? cc[i] : cctx[i - 16384]; sl[i] = cv * sigmoid_f(cv); } __syncthreads(); }
        }
        __syncthreads();
    }
    if (parts & 2) {
        LAS float* scr = (LAS float*)(lds + wave * 16384);
        float tv[32]; int it = gw;
        TrItem cur = tr_item(a, it < TR_NITEMS ? it : 0);
        if (it < TR_NITEMS) tr_load(cur, tv, lane);
        while (it < TR_NITEMS) {
            const int itn = it + NGW; float tn[32];
            const TrItem nxt = tr_item(a, itn < TR_NITEMS ? itn : 0);
            if (itn < TR_NITEMS) tr_load(nxt, tn, lane);
            tr_store(cur, tv, scr, lane);
#pragma unroll
            for (int i = 0; i < 32; ++i) tv[i] = tn[i];
            cur = nxt; it = itn;
        }
    }
    const int gt = gw * 64 + lane;
    if (gt < 1024) {
        const int pos = gt >> 4, i = gt & 15;
        const float inv = exp2f(-(float)i * 0.8304820237218406f);
        const float ang = (float)pos * inv;
        float* rc = (float*)(ws + WS_ROPE); rc[gt] = cosf(ang); rc[1024 + gt] = sinf(ang);
    }
    if (gt >= 4096 && gt < 8192) {
        const int idx = gt - 4096;
        float ar, ai, fr, fi; ssm_disc(a, idx, ar, ai, fr, fi);
        float* P = (float*)(ws + WS_SSMP);
        P[idx] = ar; P[4096 + idx] = ai;
        const float* br = a.in[I_BRE] + (size_t)idx * 16; const float* bi = a.in[I_BIM] + (size_t)idx * 16;
#pragma unroll
        for (int c = 0; c < 16; ++c) { P[8192 + idx * 16 + c] = fr * br[c] - fi * bi[c]; P[8192 + 65536 + idx * 16 + c] = fr * bi[c] + fi * br[c]; }
        float er = 1.f, ei = 0.f; const int dg = idx >> 6, p = idx & 63;
        for (int e = 0; e <= 16; ++e) { float* q = P + SSMP_APOW + ((size_t)(dg * 17 + e) * 64 + p) * 2; q[0] = er; q[1] = ei; const float nr = er * ar - ei * ai; ei = er * ai + ei * ar; er = nr; }
    }
}

__device__ __forceinline__ void p1_ktab(const Args& a, int vcu, int G, int wave, int lane) {
    unsigned char* ws = a.ws;
    const int gt = (vcu * NWAVES + wave) * 64 + lane, NGT = G * NWAVES * 64;
    const float* P = (const float*)(ws + WS_SSMP); float* KT = (float*)(ws + WS_KTAB);
    for (int o = gt; o < 262144; o += NGT) {
        const int cp = o & 15, c = (o >> 4) & 15, lag = (o >> 8) & 15, dir = (o >> 12) & 1, g = o >> 13, dg = dir * 32 + g;
        const float* ap = P + SSMP_APOW + (size_t)(dg * 17 + lag) * 128; const float* crp = a.in[I_CRE] + (dg * 16 + c) * 64; const float* cip = a.in[I_CIM] + (dg * 16 + c) * 64;
        const float* brp = P + 8192 + (size_t)dg * 1024 + cp; const float* bip = brp + 65536;
        float acc = 0.f;
#pragma unroll 8
        for (int p = 0; p < 64; ++p) { const float er = ap[2 * p], ei = ap[2 * p + 1], cr = crp[p], ci = cip[p]; acc += (cr * er - ci * ei) * brp[p * 16] - (cr * ei + ci * er) * bip[p * 16]; }
        KT[o] = acc;
    }
}

__device__ __forceinline__ void p1_ssm_mats(const Args& a, int vcu, int G, int wave, int lane) {
    unsigned char* ws = a.ws;
    const int gt = (vcu * NWAVES + wave) * 64 + lane, NGT = G * NWAVES * 64;
    const float* P = (const float*)(ws + WS_SSMP); const float* KT = (const float*)(ws + WS_KTAB);
    bf16* BTY = (bf16*)(ws + WS_BTY); bf16* BTS = (bf16*)(ws + WS_BTS);
    for (int i = gt; i < 786432; i += NGT) {
        float v[8];
        if (i < 524288) {
            const int k8 = (i & 63) * 8, n = (i >> 6) & 255, g = i >> 14, t = n >> 4, c = n & 15;
            if (k8 < 256) {
                const int s = k8 >> 4, cp0 = k8 & 15;
                if (t != s) { const float* kp = KT + ((size_t)((g * 2 + (t > s ? 0 : 1)) * 16 + (t > s ? t - s : s - t))) * 256 + c * 16 + cp0;
#pragma unroll
                    for (int j = 0; j < 8; ++j) v[j] = kp[j];
                } else { const float* kf = KT + ((size_t)((g * 2 + 0) * 16)) * 256 + c * 16 + cp0; const float* kb = KT + ((size_t)((g * 2 + 1) * 16)) * 256 + c * 16 + cp0; const float d = a.in[I_SSMD][g * 16 + c];
#pragma unroll
                    for (int j = 0; j < 8; ++j) v[j] = kf[j] + kb[j] + ((cp0 + j == c) ? d : 0.f);
                }
            } else {
                const int kk = k8 - 256, dir = kk >> 7, part = (kk >> 6) & 1, p0 = kk & 63, e = dir ? 16 - t : t + 1, dg = dir * 32 + g;
#pragma unroll
                for (int j = 0; j < 8; ++j) { const float* q = P + SSMP_APOW + ((size_t)(dg * 17 + e) * 64 + p0 + j) * 2; const float er = q[0], ei = q[1];
                    const float cr = a.in[I_CRE][(dg * 16 + c) * 64 + p0 + j], ci = a.in[I_CIM][(dg * 16 + c) * 64 + p0 + j];
                    v[j] = part ? -(cr * ei + ci * er) : (cr * er - ci * ei); }
            }
            u32x4 w; w.x = pg8::cvt_pk_bf16(v[0], v[1]); w.y = pg8::cvt_pk_bf16(v[2], v[3]); w.z = pg8::cvt_pk_bf16(v[4], v[5]); w.w = pg8::cvt_pk_bf16(v[6], v[7]);
            *(u32x4*)(BTY + ((size_t)(g * 256 + n) * 512 + k8)) = w;
        } else {
            const int jx = i - 524288, k8 = (jx & 31) * 8, n = (jx >> 5) & 255, g = jx >> 13, s = k8 >> 4, cp0 = k8 & 15;
            const int dir = n >> 7, part = (n >> 6) & 1, p = n & 63, e = dir ? s : 15 - s, dg = dir * 32 + g, idx = dg * 64 + p;
            const float* q = P + SSMP_APOW + ((size_t)(dg * 17 + e) * 64 + p) * 2; const float er = q[0], ei = q[1];
#pragma unroll
            for (int j = 0; j < 8; ++j) { const float br = P[8192 + idx * 16 + cp0 + j], bi = P[8192 + 65536 + idx * 16 + cp0 + j]; v[j] = part ? (er * bi + ei * br) : (er * br - ei * bi); }
            u32x4 w; w.x = pg8::cvt_pk_bf16(v[0], v[1]); w.y = pg8::cvt_pk_bf16(v[2], v[3]); w.z = pg8::cvt_pk_bf16(v[4], v[5]); w.w = pg8::cvt_pk_bf16(v[6], v[7]);
            *(u32x4*)(BTS + ((size_t)(g * 256 + n) * 256 + k8)) = w;
        }
    }
}

__device__ __forceinline__ void p1_xn(const Args& a, int vcu, int G, int wave, int lane) {
    unsigned char* ws = a.ws;
    const int gw = vcu * NWAVES + wave, NGW = G * NWAVES;
    const float* mod = (const float*)(ws + WS_CTL + CTL_MOD); const float* bada = a.in[I_BADA]; const float* ng = a.in[I_NORMG];
    bf16* XN = (bf16*)(ws + WS_XN);
    f32x4 v[8]; int m = gw;
    if (m < MALL) { const f32x4* xr = (const f32x4*)(m < MLAT ? a.in[I_X] + (size_t)m * DM : a.in[I_CTX] + (size_t)(m - MLAT) * DM) + lane;
#pragma unroll
        for (int j = 0; j < 8; ++j) v[j] = xr[64 * j]; }
    while (m < MALL) {
        const int mn = m + NGW; f32x4 vn[8];
        if (mn < MALL) { const f32x4* xr = (const f32x4*)(mn < MLAT ? a.in[I_X] + (size_t)mn * DM : a.in[I_CTX] + (size_t)(mn - MLAT) * DM) + lane;
#pragma unroll
            for (int j = 0; j < 8; ++j) vn[j] = xr[64 * j]; }
        const int mr = m < MLAT ? (m >> 11) : 8;
        float s = 0.f;
#pragma unroll
        for (int j = 0; j < 8; ++j) s += (v[j][0] * v[j][0] + v[j][1] * v[j][1]) + (v[j][2] * v[j][2] + v[j][3] * v[j][3]);
        const float rstd = 1.0f / sqrtf(wave_sum(s) * (1.0f / DM) + NORM_EPS);
        unsigned long long* o8 = (unsigned long long*)(XN + (size_t)m * DM) + lane;
#pragma unroll
        for (int j = 0; j < 8; ++j) {
            const int col = 4 * lane + 256 * j;
            const f32x4 sh = *(const f32x4*)(mod + mr * 6144 + col) + *(const f32x4*)(bada + col);
            const f32x4 sc = *(const f32x4*)(mod + mr * 6144 + 2048 + col) + *(const f32x4*)(bada + 2048 + col);
            const f32x4 g = *(const f32x4*)(ng + col);
            const f32x4 h = (v[j] * rstd) * g * (sc + 1.0f) + sh;
            o8[64 * j] = (unsigned long long)pg8::cvt_pk_bf16(h[0], h[1]) | ((unsigned long long)pg8::cvt_pk_bf16(h[2], h[3]) << 32);
        }
#pragma unroll
        for (int j = 0; j < 8; ++j) v[j] = vn[j];
        m = mn;
    }
}

struct InProjOrder {
    pg8::StaticOrder so; int G, c;
    __device__ __forceinline__ void init(int G_, int c_) { so.init(MLAT, INW, G_, c_); G = G_; c = c_; }
    __device__ __forceinline__ bool next(int i, pg8::Unit& u) const {
        const long L = (long)i * G + c;
        if (L < 2304) return so.next(i, u);
        const int j = (int)(L - 2304); if (j >= 80) return false;
        const int jj = j % 10; u.pm = 64 + j / 10; u.pn = jj < 8 ? 4 + jj : 8 + jj; return true;
    }
    __device__ __forceinline__ void a_ready(const pg8::Unit&) const {}
    __device__ __forceinline__ void done(const pg8::Unit&) const {}
};

__device__ __forceinline__ void p3_attn(const Args& a, char* lds_generic, int vcu, int G, int wave) {
    unsigned char* ws = a.ws;
    const attn_body::bf16* Q = (const attn_body::bf16*)(ws + WS_Q); const attn_body::bf16* K = (const attn_body::bf16*)(ws + WS_KALL); const attn_body::bf16* V = (const attn_body::bf16*)(ws + WS_VALL);
    for (int u = vcu; u < 2048; u += G) {
        const int xcd = (u & 255) >> 5, c = u & 31, i = u >> 8;
        const int vhd = xcd * 32 + i * 4 + (c >> 3), qb = c & 7;
        const int b = vhd >> 5, h = (vhd >> 2) & 7, s = (vhd >> 1) & 1, vh = vhd & 1;
        attn_body::bf16* O = (attn_body::bf16*)(ws + (s ? WS_O2 : WS_O1));
        attn_body::attn_unit<8>(b, qb, h * 128 + s * 64, h * 128 + s * 64, h * 128 + vh * 64, h * 128 + vh * 64, Q, K, V, O, lds_generic, wave);
    }
}

__device__ __forceinline__ void p4_combine(const Args& a, int vcu, int G, int wave, int lane) {
    unsigned char* ws = a.ws;
    const int gw = vcu * NWAVES + wave, NGW = G * NWAVES;
    const float l1 = wave_sum(a.in[I_LQ1][lane] * a.in[I_LK1][lane]), l2 = wave_sum(a.in[I_LQ2][lane] * a.in[I_LK2][lane]);
    const float lam = expf(l1) - expf(l2) + LAM_INIT;
    const bf16* O1 = (const bf16*)(ws + WS_O1); const bf16* O2 = (const bf16*)(ws + WS_O2); const bf16* GA = (const bf16*)(ws + WS_GA); bf16* AS = (bf16*)(ws + WS_AS);
    const int col = 16 * lane;
    f32x4 sg[4];
#pragma unroll
    for (int j = 0; j < 4; ++j) sg[j] = *(const f32x4*)(a.in[I_SUBLN] + (col & 127) + 4 * j) * (1.0f - LAM_INIT);
    for (int tok = gw; tok < MLAT; tok += NGW) {
        f32x4 o[4], p[4], g[4];
        unpack8(*(const u32x4*)(O1 + (size_t)tok * 1024 + col), o[0], o[1]); unpack8(*(const u32x4*)(O1 + (size_t)tok * 1024 + col + 8), o[2], o[3]);
        unpack8(*(const u32x4*)(O2 + (size_t)tok * 1024 + col), p[0], p[1]); unpack8(*(const u32x4*)(O2 + (size_t)tok * 1024 + col + 8), p[2], p[3]);
        unpack8(*(const u32x4*)(GA + (size_t)tok * 1024 + col), g[0], g[1]); unpack8(*(const u32x4*)(GA + (size_t)tok * 1024 + col + 8), g[2], g[3]);
        float ss = 0.f;
#pragma unroll
        for (int j = 0; j < 4; ++j) { o[j] = o[j] - p[j] * lam; ss += (o[j][0] * o[j][0] + o[j][1] * o[j][1]) + (o[j][2] * o[j][2] + o[j][3] * o[j][3]); }
        ss += __shfl_xor(ss, 1); ss += __shfl_xor(ss, 2); ss += __shfl_xor(ss, 4);
        const float rs = 1.0f / sqrtf(ss * (1.0f / 128.0f) + NORM_EPS);
#pragma unroll
        for (int j = 0; j < 4; ++j) o[j] = o[j] * rs * sg[j] * g[j];
        *(u32x4*)(AS + (size_t)tok * 1536 + col) = pack8(o[0], o[1]); *(u32x4*)(AS + (size_t)tok * 1536 + col + 8) = pack8(o[2], o[3]);
    }
}

struct SsmOrder {
    int G, c, nrt;
    __device__ __forceinline__ bool next(int i, pg8::Unit& u) const {
        const long L = (long)i * G + c; if (L >= 32 * nrt) return false;
        const int g = (int)L / nrt, rt = (int)L % nrt; u.pm = g * 5 + rt; u.pn = g; return true;
    }
    __device__ __forceinline__ void a_ready(const pg8::Unit&) const {}
    __device__ __forceinline__ void done(const pg8::Unit&) const {}
};
__device__ __forceinline__ void p6_carry(const Args& a, int vcu, int G, int wave, int lane) {
    unsigned char* ws = a.ws;
    const int gw = vcu * NWAVES + wave, NGW = G * NWAVES;
    const float* P = (const float*)(ws + WS_SSMP);
    for (int it = gw; it < 512; it += NGW) {
        const int dir = it & 1, g = (it >> 1) & 31, b = it >> 6;
        const float* q = P + SSMP_APOW + ((size_t)((dir * 32 + g) * 17 + 16) * 64 + lane) * 2; const float ar = q[0], ai = q[1];
        const float* S = (const float*)(ws + WS_SBUF) + (size_t)g * 1280 * 256 + dir * 128 + lane;
        bf16* H = (bf16*)(ws + WS_A2) + (size_t)g * 1280 * 512 + 256 + dir * 128 + lane;
        float hr = 0.f, hi = 0.f;
#pragma unroll 8
        for (int k = 0; k < 16; ++k) { const int R = 1024 + b * 16 + (dir ? 15 - k : k); const float sr = S[(size_t)R * 256], si = S[(size_t)R * 256 + 64];
            const float nr = ar * hr - ai * hi + sr; hi = ar * hi + ai * hr + si; hr = nr; }
#pragma unroll 8
        for (int k = 0; k < 128; ++k) { const int R = b * 128 + (dir ? 127 - k : k); const float sr = S[(size_t)R * 256], si = S[(size_t)R * 256 + 64];
            H[(size_t)R * 512] = (bf16)f2bf(hr); H[(size_t)R * 512 + 64] = (bf16)f2bf(hi);
            const float nr = ar * hr - ai * hi + sr; hi = ar * hi + ai * hr + si; hr = nr; }
    }
}

#ifndef PROBE_A1
#define PROBE_A0 -1
#define PROBE_A1 -1
#define PROBE_B0 -1
#define PROBE_B1 -1
#define PROBE_OFF 0
#endif
#ifndef PROBE_BKT
#define PROBE_BKT 100
#endif
__device__ __forceinline__ void p10_final(const Args& a, int vcu, int G, int wave, int lane, float addA, float addB, int rep) {
    const int gw = vcu * NWAVES + wave, NGW = G * NWAVES;
    const float* rowsq = (const float*)(a.ws + WS_CTL + CTL_ROWSQ); const float* fg = a.in[I_FING];
    for (int m = gw; m < MLAT; m += NGW) {
        const float rstd = 1.0f / sqrtf(rowsq[m] * (1.0f / DM) + NORM_EPS);
        f32x4* o = (f32x4*)(a.out + (size_t)m * DM) + lane; f32x4* od = rep ? (f32x4*)((float*)(a.ws + WS_GM) + (size_t)m * DM) + lane : o;
#pragma unroll
        for (int j = 0; j < 8; ++j) { const f32x4 g = *(const f32x4*)(fg + 4 * lane + 256 * j); f32x4 r = o[64 * j] * rstd * g; if (PROBE_A1 >= 0) { r = r + addA; if (m == 0 && lane == 0 && j == 0) r[0] += addB; } od[64 * j] = r; }
    }
}

constexpr int N_PHASES = 12;
__global__ void __launch_bounds__(NWAVES * 64, 2) skel_fwd(Args args) {
    extern __shared__ __attribute__((aligned(16))) unsigned char lds_raw[];
    LAS unsigned char* lds = (LAS unsigned char*)lds_raw;
    volatile LAS unsigned* MISC = (volatile LAS unsigned*)(lds + MISC_OFF);
    const int tid = threadIdx.x, wave = __builtin_amdgcn_readfirstlane(tid >> 6);
    const int G = gridDim.x; const int bx = blockIdx.x; const int vcu = (G % 8 == 0) ? (bx % 8) * (G / 8) + bx / 8 : bx;
    unsigned char* ws = args.ws;
    gu32* ctl = (gu32*)(ws + WS_CTL);
    for (int u = tid; u < (LDS_BYTES - LDSCTL_OFF) / 4; u += NWAVES * 64) ((LAS unsigned*)(lds + LDSCTL_OFF))[u] = 0u;
    __syncthreads();
    XcdBarrier bar; bar.bar = (unsigned*)(ctl + CW_BAR); bar.x = 0; bar.st = nullptr;
    if (!MK_PER_PHASE) bar = xcd_barrier_post((unsigned*)(ctl + CW_BAR), MISC + 8);
    const int lo = args.ph_lo, hi = args.ph_hi;
#ifndef ONLY_PHASE
#define ONLY_PHASE -1
#endif
#define IN(k) ((ONLY_PHASE < 0 || ONLY_PHASE == (k)) && lo <= (k) && (k) < hi)
#ifndef REPEAT_PH
#define REPEAT_PH -1
#endif
#if PROBE_A1 >= 0
#define STAMP(k) do { if (bx == 0 && wave == 0 && pg8::lane_id_v() == 0) ((unsigned long long*)(ws + WS_CTL + CTL_STAMP))[k] = rt(); } while (0)
#else
#define STAMP(k) do {} while (0)
#endif
#define REP(k) for (int rep_ = 0; rep_ < ((REPEAT_PH == (k)) ? 2 : 1); ++rep_)
#ifndef EXTRA_BAR
#define EXTRA_BAR 0
#endif
#define SEAM(k) do { if (IN(k) && IN((k) + 1)) { xcd_barrier(bar, wave); if ((k) == 4) for (int eb_ = 0; eb_ < EXTRA_BAR; ++eb_) xcd_barrier(bar, wave); } } while (0)

    STAMP(0); if (IN(0)) REP(0) { const int ln = pg8::lane_id_v(); p0_prologue(args, lds, vcu, G, wave, ln, rep_); } SEAM(0);
    STAMP(1); if (IN(1)) REP(1) { const int ln = pg8::lane_id_v(); p1_xn(args, vcu, G, wave, ln); p1_ktab(args, vcu, G, wave, ln); } SEAM(1);
    STAMP(2); if (IN(2)) REP(2) {
        pg8::Gemm g{(const pg8::bf16_t*)(ws + WS_XN), (const pg8::bf16_t*)(ws + WS_WIN), MALL, INW, DM, DM, DM};
        InProjOrder S; S.init(G, bx);
        pg8::EpiInProj E{ws, QSCALE, -1};
        pg8::gemm_phase<pg8::EpiInProj, InProjOrder, PG8_ALIGN, PG8_SP2>(lds, g, S, E, wave);
    } SEAM(2);
    STAMP(3); if (IN(3)) REP(3) { p3_attn(args, (char*)lds_raw, vcu, G, wave); } SEAM(3);
    STAMP(4); if (IN(4)) REP(4) { const int ln = pg8::lane_id_v(); p4_combine(args, vcu, G, wave, ln); p1_ssm_mats(args, vcu, G, wave, ln); } SEAM(4);
    STAMP(5); if (IN(5)) REP(5) {
        pg8::Gemm g{(const pg8::bf16_t*)(ws + WS_A2), (const pg8::bf16_t*)(ws + WS_BTS), 32 * 1280, 32 * 256, 256, 512, 256};
        SsmOrder S{G, bx, 5};
        pg8::EpiS E{(float*)(ws + WS_SBUF), -1};
        pg8::gemm_phase<pg8::EpiS, SsmOrder, PG8_ALIGN, PG8_SP2>(lds, g, S, E, wave);
    } SEAM(5);
    STAMP(6); if (IN(6)) REP(6) { const int ln = pg8::lane_id_v(); p6_carry(args, vcu, G, wave, ln); } SEAM(6);
    STAMP(7); if (IN(7)) REP(7) {
        pg8::Gemm g{(const pg8::bf16_t*)(ws + WS_A2), (const pg8::bf16_t*)(ws + WS_BTY), 32 * 1280, 32 * 256, 512, 512, 512};
        SsmOrder S{G, bx, 4};
        pg8::EpiY E{(pg8::bf16_t*)(ws + WS_Y), -1};
        pg8::gemm_phase<pg8::EpiY, SsmOrder, PG8_ALIGN, PG8_SP2>(lds, g, S, E, wave);
    } SEAM(7);
    STAMP(8); if (IN(8)) REP(8) {
        pg8::Gemm g{(const pg8::bf16_t*)(ws + WS_Y), (const pg8::bf16_t*)(ws + WS_WGLU), MLAT, 512, 512, 512, 512};
        pg8::StaticOrder S; S.init(MLAT, 512, G, bx);
        pg8::EpiGlu E{(const pg8::bf16_t*)(ws + WS_Y), (const pg8::bf16_t*)(ws + WS_GS), args.in[I_BGLU], (pg8::bf16_t*)(ws + WS_AS), -1};
        pg8::gemm_phase<pg8::EpiGlu, pg8::StaticOrder, PG8_ALIGN, PG8_SP2>(lds, g, S, E, wave);
    } SEAM(8);
    STAMP(9); if (IN(9)) REP(9) {
        pg8::Gemm g{(const pg8::bf16_t*)(ws + WS_AS), (const pg8::bf16_t*)(ws + WS_WCAT), MLAT, DM, 1536, 1536, 1536};
        pg8::StaticOrder S; S.init(MLAT, DM, G, bx);
        pg8::EpiMerged E{(const pg8::bf16_t*)(ws + WS_GM), (pg8::bf16_t*)(ws + WS_MG), 16};
        pg8::gemm_phase<pg8::EpiMerged, pg8::StaticOrder, PG8_ALIGN, PG8_SP2>(lds, g, S, E, wave);
    } SEAM(9);
    STAMP(10); if (IN(10)) REP(10) {
        pg8::Gemm g{(const pg8::bf16_t*)(ws + WS_MG), (const pg8::bf16_t*)(ws + WS_WOUT), MLAT, DM, DM, DM, DM};
        pg8::StaticOrder S; S.init(MLAT, DM, G, bx);
        pg8::EpiOut E{args.in[I_X], (const float*)(ws + WS_CTL + CTL_MOD), args.in[I_BADA], args.out, (float*)(ws + WS_CTL + CTL_ROWSQ + (size_t)rep_ * 393216), -1};
        pg8::gemm_phase<pg8::EpiOut, pg8::StaticOrder, PG8_ALIGN, PG8_SP2>(lds, g, S, E, wave);
    } SEAM(10);
    STAMP(11); if (IN(11)) REP(11) { const int ln = pg8::lane_id_v(); float addA = 0.f, addB = 0.f;
#if PROBE_A1 >= 0
        { const unsigned long long* st = (const unsigned long long*)(ws + WS_CTL + CTL_STAMP);
          const long long da = (long long)(st[PROBE_A1] - st[PROBE_A0]) / 100 + PROBE_OFF, db = (long long)(st[PROBE_B1] - st[PROBE_B0]) / 100 + PROBE_OFF;
          addA = (float)((da / PROBE_BKT) * PROBE_BKT) * 1e-3f; addB = (float)((db / PROBE_BKT) * PROBE_BKT) * 1e-2f; }
#endif
        p10_final(args, vcu, G, wave, ln, addA, addB, rep_); }
#undef IN
#undef SEAM
}

extern "C" void kernel_launch(void* const* d_in, const int* in_sizes, int n_in, void* d_out, int out_size, void* d_ws, size_t ws_size, hipStream_t stream) {
    static int grid = 0;
    if (grid == 0) {
        if (n_in != 27 || out_size != MLAT * DM || ws_size < WS_END) { fprintf(stderr, "kernel_launch: unexpected shapes (n_in %d, out %d, ws %zu); nothing launched\n", n_in, out_size, ws_size); grid = -1; return; }
        int dev = 0, cus = 0, per_cu = 0;
        if (hipGetDevice(&dev) != hipSuccess || hipDeviceGetAttribute(&cus, hipDeviceAttributeMultiprocessorCount, dev) != hipSuccess) { grid = -1; return; }
        if (hipFuncSetAttribute((const void*)skel_fwd, hipFuncAttributeMaxDynamicSharedMemorySize, LDS_BYTES) != hipSuccess) { fprintf(stderr, "kernel_launch: hipFuncSetAttribute failed\n"); grid = -1; return; }
        if (hipOccupancyMaxActiveBlocksPerMultiprocessor(&per_cu, (const void*)skel_fwd, NWAVES * 64, LDS_BYTES) != hipSuccess || per_cu < 1) { fprintf(stderr, "kernel_launch: occupancy query says %d blocks per CU\n", per_cu); }
        (void)hipGetLastError();
        grid = cus;
    }
    if (grid < 0) return;
    if (hipMemsetAsync((char*)d_ws + WS_CTL, 0, CTL_ZERO_BYTES, stream) != hipSuccess) { fprintf(stderr, "kernel_launch: hipMemsetAsync failed\n"); return; }
    Args a{};
    for (int i = 0; i < 27; ++i) a.in[i] = (const float*)d_in[i];
    a.out = (float*)d_out; a.ws = (unsigned char*)d_ws;
#if MK_PER_PHASE
    for (int p = 0; p < N_PHASES; ++p) { a.ph_lo = p; a.ph_hi = p + 1; a.li = 0; hipLaunchKernelGGL(skel_fwd, dim3(grid), dim3(NWAVES * 64), LDS_BYTES, stream, a); }
#else
    a.ph_lo = 0; a.ph_hi = N_PHASES; a.li = 0;
    hipLaunchKernelGGL(skel_fwd, dim3(grid), dim3(NWAVES * 64), LDS_BYTES, stream, a);
#endif
    const hipError_t le = hipPeekAtLastError();
    if (le != hipSuccess) fprintf(stderr, "kernel_launch: launch failed: %s\n", hipGetErrorName(le));
}
```

```cpp
#include <hip/hip_runtime.h>
#include <hip/hip_bf16.h>
#include <cstdio>
#include <cstdint>
#include <cmath>

constexpr size_t MiB = 1u << 20;
constexpr size_t WS_CTL = 0, CTL_ZERO_BYTES = 1 * MiB;
constexpr int CW_BAR = 4096;
constexpr size_t CTL_MOD = 262144, CTL_ROWSQ = 524288, CTL_STAMP = 65536;
constexpr size_t WS_WIN = 2 * MiB;
constexpr size_t WS_WCAT = 38 * MiB;
constexpr size_t WS_WOUT = 44 * MiB;
constexpr size_t WS_WGLU = 52 * MiB;
constexpr size_t WS_ROPE = 52 * MiB + 512 * 1024;
constexpr size_t WS_SSMP = 53 * MiB;
constexpr int SSMP_APOW = 8192 + 131072;
constexpr size_t WS_KTAB = 55 * MiB;
constexpr size_t WS_BTY = 57 * MiB;
constexpr size_t WS_BTS = 65 * MiB;
constexpr size_t WS_A2 = 70 * MiB;
constexpr size_t WS_GS = 110 * MiB;
constexpr size_t WS_GA = 126 * MiB;
constexpr size_t WS_Q = 158 * MiB;
constexpr size_t WS_KALL = 190 * MiB;
constexpr size_t WS_VALL = 226 * MiB;
constexpr size_t WS_GM = 262 * MiB;
constexpr size_t WS_XN = 390 * MiB;
constexpr size_t WS_O1 = 390 * MiB, WS_O2 = 422 * MiB;
constexpr size_t WS_SBUF = 390 * MiB;
constexpr size_t WS_MG = 390 * MiB;
constexpr size_t WS_Y = 462 * MiB;
constexpr size_t WS_AS = 158 * MiB;
constexpr size_t WS_END = 478 * MiB;

namespace pg8 {
#define PG8_LAS __attribute__((address_space(3)))
typedef unsigned short bf16_t;
typedef short bf16x8 __attribute__((ext_vector_type(8)));
typedef float f32x4 __attribute__((ext_vector_type(4)));
typedef unsigned u32x4 __attribute__((ext_vector_type(4)));
constexpr int BM = 256, BK = 64, HALF = 128, HTB = HALF * BK * 2  , STAGE_BYTES = 8 * HTB, NXCD = 8, WGM = 8;

__host__ __device__ __forceinline__ int lds_byte(int r, int c) { const int st = (r >> 4) * 2 + (c >> 5), rr = r & 15, cc = c & 31, ob = rr * 64 + cc * 2; return st * 1024 + (ob ^ (((ob >> 9) & 1) << 5)); }
__host__ __device__ __forceinline__ void stage_rc(int b, int& R, int& C) { const int st = b / 1024, sb = b % 1024, swz = sb ^ (((sb >> 9) & 1) << 5); R = (st >> 1) * 16 + swz / 64; C = (st & 1) * 32 + (swz % 64) / 2; }
__host__ __device__ __forceinline__ int perm32(int rho) { const int n = rho >> 4, i = rho & 15; return 8 * (i >> 2) + 4 * n + (i & 3); }

struct Unit { int pm, pn; };
struct Gemm { const bf16_t* A; const bf16_t* Bt; int M, N, K, lda, ldb; };

struct StaticOrder {
    int nM, nN, nwg, G, c;
    __host__ __device__ void init(int M, int N, int G_, int c_) { nM = M / BM; nN = N / BM; nwg = nM * nN; G = G_; c = c_; }
    __host__ __device__ bool next(int i, Unit& u) const {
        const long L = (long)i * G + c; if (L >= nwg) return false;
        int wgid = (int)L; { const int q = nwg / NXCD, r = nwg % NXCD, xcd = wgid % NXCD, off = wgid / NXCD; wgid = (xcd < r ? xcd * (q + 1) : r * (q + 1) + (xcd - r) * q) + off; }
        const int nig = WGM * nN, gid = wgid / nig, fm = gid * WGM, gsz = (nM - fm) < WGM ? (nM - fm) : WGM;
        u.pm = fm + ((wgid % nig) % gsz); u.pn = (wgid % nig) / gsz; return true;
    }
    __device__ __forceinline__ void a_ready(const Unit&) const {}
    __device__ __forceinline__ void done(const Unit&) const {}
};


__device__ __forceinline__ unsigned cvt_pk_bf16(float lo, float hi) { unsigned r; asm volatile("v_cvt_pk_bf16_f32 %0, %1, %2" : "=v"(r) : "v"(lo), "v"(hi)); return r; }
__device__ __forceinline__ int lane_id_v() { int l; asm volatile("v_mbcnt_lo_u32_b32 %0, -1, 0\n\tv_mbcnt_hi_u32_b32 %0, -1, %0" : "=v"(l)); return l; }
__device__ __forceinline__ float bf_lo(unsigned u) { return __uint_as_float(u << 16); }
__device__ __forceinline__ float bf_hi(unsigned u) { return __uint_as_float(u & 0xffff0000u); }
__device__ __forceinline__ void unpack8(const u32x4 w, f32x4& a, f32x4& b) { a = (f32x4){bf_lo(w.x), bf_hi(w.x), bf_lo(w.y), bf_hi(w.y)}; b = (f32x4){bf_lo(w.z), bf_hi(w.z), bf_lo(w.w), bf_hi(w.w)}; }
__device__ __forceinline__ u32x4 pack8(const f32x4 a, const f32x4 b) { u32x4 w; w.x = cvt_pk_bf16(a[0], a[1]); w.y = cvt_pk_bf16(a[2], a[3]); w.z = cvt_pk_bf16(b[0], b[1]); w.w = cvt_pk_bf16(b[2], b[3]); return w; }
__device__ __forceinline__ float sigmoid_f(float x) { return __builtin_amdgcn_rcpf(1.0f + __builtin_amdgcn_exp2f(-1.4426950408889634f * x)); }
__device__ __forceinline__ f32x4 sigmoid4(f32x4 v) { return (f32x4){sigmoid_f(v[0]), sigmoid_f(v[1]), sigmoid_f(v[2]), sigmoid_f(v[3])}; }
__device__ __forceinline__ f32x4 silu4(f32x4 v) { return v * sigmoid4(v); }
__device__ __forceinline__ f32x4 shflx32(f32x4 v) { return (f32x4){__shfl_xor(v[0], 32), __shfl_xor(v[1], 32), __shfl_xor(v[2], 32), __shfl_xor(v[3], 32)}; }

struct EpiInProj {
    static constexpr bool PERM = true, AFTER_DRAIN = false, HAS_MID = false;
    unsigned char* ws; float c2; int tmid;
    __device__ __forceinline__ void mid(f32x4 (&)[2][2][4][2], const Unit&, int, int, int, int) const {}
    __device__ __forceinline__ void operator()(const f32x4 (&acc)[2][2][4][2], const Unit& u, int wr, int wc, int fr, int fq) const {
        const int pn = u.pn, pm = u.pm;
        const bool isctx = pm >= 64;
        const int b = isctx ? pm - 64 : pm >> 3;
        const int t0 = isctx ? 0 : (pm & 7) * 256;
        const int colw = wc * 32 + 8 * fq;
        if (pn < 8) {
            const bool isq = pn < 4;
            bf16_t* base = (bf16_t*)(ws + (isq ? WS_Q : WS_KALL));
            const float* rope_c = (const float*)(ws + WS_ROPE); const float* rope_s = rope_c + 1024;
            const int ct = (isq ? pn : pn - 4) * 256 + colw;
            const float sgn = fq < 2 ? -1.f : 1.f, osc = isq ? c2 : 1.f;
#pragma unroll
            for (int ai = 0; ai < 2; ++ai)
#pragma unroll
                for (int m = 0; m < 4; ++m) {
                    const int rl = ai * HALF + wr * 64 + m * 16 + fr, t = t0 + rl;
                    const size_t grow = isq ? (size_t)(b * 2048 + t) : (size_t)(b * 2304 + (isctx ? 2048 : 0) + t);
                    f32x4 c0 = (f32x4){1.f, 1.f, 1.f, 1.f}, c1 = c0, s0 = (f32x4){0.f, 0.f, 0.f, 0.f}, s1 = s0;
                    if (!isctx) { const int pos = (wc & 1) ? (t & 63) : (t >> 6); const float* pc = rope_c + pos * 16 + 8 * (fq & 1); const float* ps = rope_s + pos * 16 + 8 * (fq & 1);
                        c0 = *(const f32x4*)pc; c1 = *(const f32x4*)(pc + 4); s0 = *(const f32x4*)ps * sgn; s1 = *(const f32x4*)(ps + 4) * sgn; }
#pragma unroll
                    for (int bj = 0; bj < 2; ++bj) {
                        const f32x4 v0 = acc[ai][bj][m][0], v1 = acc[ai][bj][m][1];
                        const f32x4 p0 = shflx32(v0), p1 = shflx32(v1);
                        const f32x4 o0 = (v0 * c0 + p0 * s0) * osc, o1 = (v1 * c1 + p1 * s1) * osc;
                        *(u32x4*)(base + grow * 1024 + ct + bj * HALF) = pack8(o0, o1);
                    }
                    asm volatile("" ::: "memory");
                }
        } else if (pn < 12) {
            const int ct = (pn - 8) * 256 + colw;
#pragma unroll
            for (int ai = 0; ai < 2; ++ai)
#pragma unroll
                for (int m = 0; m < 4; ++m) {
                    const int rl = ai * HALF + wr * 64 + m * 16 + fr, t = t0 + rl;
                    const size_t grow = (size_t)(b * 2304 + (isctx ? 2048 : 0) + t);
#pragma unroll
                    for (int bj = 0; bj < 2; ++bj) *(u32x4*)((bf16_t*)(ws + WS_VALL) + grow * 1024 + ct + bj * HALF) = pack8(acc[ai][bj][m][0], acc[ai][bj][m][1]);
                }
        } else if (pn == 16 || pn == 17) {
#pragma unroll
            for (int ai = 0; ai < 2; ++ai)
#pragma unroll
                for (int m = 0; m < 4; ++m) {
                    const int rl = ai * HALF + wr * 64 + m * 16 + fr, t = t0 + rl;
                    const int R = isctx ? 1024 + b * 16 + (t >> 4) : b * 128 + (t >> 4), tl = t & 15;
#pragma unroll
                    for (int bj = 0; bj < 2; ++bj) {
                        const int g = (pn - 16) * 16 + bj * 8 + wc * 2 + (fq >> 1), c0 = 8 * (fq & 1);
                        *(u32x4*)((bf16_t*)(ws + WS_A2) + ((size_t)(g * 1280 + R) * 512 + tl * 16 + c0)) = pack8(acc[ai][bj][m][0], acc[ai][bj][m][1]);
                    }
                }
        } else {
            size_t boff; int pitch, ct; bool sil;
            if (pn < 16) { boff = WS_GA; pitch = 1024; ct = (pn - 12) * 256; sil = true; }
            else if (pn < 20) { boff = WS_GS; pitch = 512; ct = (pn - 18) * 256; sil = true; }
            else { boff = WS_GM; pitch = 4096; ct = (pn - 20) * 256; sil = false; }
            bf16_t* base = (bf16_t*)(ws + boff);
            ct += colw;
#pragma unroll
            for (int ai = 0; ai < 2; ++ai)
#pragma unroll
                for (int m = 0; m < 4; ++m) {
                    const size_t grow = (size_t)pm * 256 + ai * HALF + wr * 64 + m * 16 + fr;
#pragma unroll
                    for (int bj = 0; bj < 2; ++bj) {
                        const f32x4 v0 = acc[ai][bj][m][0], v1 = acc[ai][bj][m][1];
                        const f32x4 g0 = sigmoid4(v0), g1 = sigmoid4(v1);
                        const f32x4 o0 = sil ? v0 * g0 : g0, o1 = sil ? v1 * g1 : g1;
                        *(u32x4*)(base + grow * pitch + ct + bj * HALF) = pack8(o0, o1);
                    }
                    asm volatile("" ::: "memory");
                }
        }
    }
};

struct EpiGlu {
    static constexpr bool PERM = true, AFTER_DRAIN = false, HAS_MID = false;
    const bf16_t *Y, *GS; const float* bglu; bf16_t* AS; int tmid;
    __device__ __forceinline__ void mid(f32x4 (&)[2][2][4][2], const Unit&, int, int, int, int) const {}
    __device__ __forceinline__ void operator()(const f32x4 (&acc)[2][2][4][2], const Unit& u, int wr, int wc, int fr, int fq) const {
        const int col0 = u.pn * BM + wc * 32 + 8 * fq;
        f32x4 bv[2][2];
#pragma unroll
        for (int bj = 0; bj < 2; ++bj)
#pragma unroll
            for (int n = 0; n < 2; ++n) bv[bj][n] = *(const f32x4*)(bglu + col0 + bj * HALF + 4 * n);
#pragma unroll
        for (int ai = 0; ai < 2; ++ai)
#pragma unroll
            for (int m = 0; m < 4; ++m) {
                const size_t row = (size_t)u.pm * BM + ai * HALF + wr * 64 + m * 16 + fr;
#pragma unroll
                for (int bj = 0; bj < 2; ++bj) {
                    const int col = col0 + bj * HALF;
                    f32x4 y0, y1, g0, g1; unpack8(*(const u32x4*)(Y + row * 512 + col), y0, y1); unpack8(*(const u32x4*)(GS + row * 512 + col), g0, g1);
                    const f32x4 o0 = y0 * sigmoid4(acc[ai][bj][m][0] + bv[bj][0]) * g0, o1 = y1 * sigmoid4(acc[ai][bj][m][1] + bv[bj][1]) * g1;
                    *(u32x4*)(AS + row * 1536 + 1024 + col) = pack8(o0, o1);
                }
                asm volatile("" ::: "memory");
            }
    }
};

struct EpiMerged {
    static constexpr bool PERM = true, AFTER_DRAIN = false, HAS_MID = true;
    const bf16_t* GM; bf16_t* MG; int tmid;
    __device__ __forceinline__ void mid(f32x4 (&acc)[2][2][4][2], const Unit& u, int wr, int wc, int fr, int fq) const {
        unsigned opq = 0; asm volatile("" : "+v"(opq));
        const unsigned col0 = u.pn * BM + wc * 32 + 8 * fq + opq;
#pragma unroll
        for (int ai = 0; ai < 2; ++ai)
#pragma unroll
            for (int m = 0; m < 4; ++m) {
                const unsigned row = u.pm * BM + ai * HALF + wr * 64 + m * 16 + fr;
#pragma unroll
                for (int bj = 0; bj < 2; ++bj) {
                    const unsigned col = col0 + bj * HALF;
                    f32x4 a0, a1, s0, s1; unpack8(*(const u32x4*)(GM + (row * 4096u + col)), a0, a1); unpack8(*(const u32x4*)(GM + (row * 4096u + 2048u + col)), s0, s1);
#pragma unroll
                    for (int e = 0; e < 4; ++e) { acc[ai][bj][m][0][e] *= a0[e] * __builtin_amdgcn_rcpf(fmaxf(s0[e], 1e-30f)); acc[ai][bj][m][1][e] *= a1[e] * __builtin_amdgcn_rcpf(fmaxf(s1[e], 1e-30f)); }
                }
                asm volatile("" ::: "memory");
            }
    }
    __device__ __forceinline__ void operator()(const f32x4 (&acc)[2][2][4][2], const Unit& u, int wr, int wc, int fr, int fq) const {
        const int col0 = u.pn * BM + wc * 32 + 8 * fq;
#pragma unroll
        for (int ai = 0; ai < 2; ++ai)
#pragma unroll
            for (int m = 0; m < 4; ++m) {
                const size_t row = (size_t)u.pm * BM + ai * HALF + wr * 64 + m * 16 + fr;
#pragma unroll
                for (int bj = 0; bj < 2; ++bj) {
                    const int col = col0 + bj * HALF;
                    f32x4 s0, s1; unpack8(*(const u32x4*)(GM + row * 4096 + 2048 + col), s0, s1);
                    *(u32x4*)(MG + row * 2048 + col) = pack8(acc[ai][bj][m][0] * s0, acc[ai][bj][m][1] * s1);
                }
                asm volatile("" ::: "memory");
            }
    }
};

struct EpiOut {
    static constexpr bool PERM = false, AFTER_DRAIN = false, HAS_MID = false;
    const float *x, *mod, *bada; float* out; float* rowsq; int tmid;
    __device__ __forceinline__ void mid(f32x4 (&)[2][2][4][2], const Unit&, int, int, int, int) const {}
    __device__ __forceinline__ void operator()(const f32x4 (&acc)[2][2][4][2], const Unit& u, int wr, int wc, int fr, int fq) const {
        const int col0 = u.pn * BM + wc * 32 + 4 * fq, b = u.pm >> 3;
        f32x4 gv[2][2];
#pragma unroll
        for (int bj = 0; bj < 2; ++bj)
#pragma unroll
            for (int n = 0; n < 2; ++n) gv[bj][n] = *(const f32x4*)(mod + b * 6144 + 4096 + col0 + bj * HALF + n * 16) + *(const f32x4*)(bada + 4096 + col0 + bj * HALF + n * 16);
#pragma unroll
        for (int ai = 0; ai < 2; ++ai)
#pragma unroll
            for (int m = 0; m < 4; ++m) {
                const size_t row = (size_t)u.pm * BM + ai * HALF + wr * 64 + m * 16 + fr; float ss = 0.f;
#pragma unroll
                for (int bj = 0; bj < 2; ++bj)
#pragma unroll
                    for (int n = 0; n < 2; ++n) {
                        const size_t off = row * 2048 + col0 + bj * HALF + n * 16;
                        const f32x4 o = *(const f32x4*)(x + off) + gv[bj][n] * acc[ai][bj][m][n];
                        *(f32x4*)(out + off) = o; ss += (o[0] * o[0] + o[1] * o[1]) + (o[2] * o[2] + o[3] * o[3]);
                    }
                ss += __shfl_xor(ss, 16); ss += __shfl_xor(ss, 32);
                if (fq == 0) atomicAdd(rowsq + row, ss);
                asm volatile("" ::: "memory");
            }
    }
};

__device__ __forceinline__ float gelu_tanh(float x) {
    const float z = 0.7978845608028654f * (x + 0.044715f * x * x * x);
    const float th = 1.0f - 2.0f * __builtin_amdgcn_rcpf(1.0f + __builtin_amdgcn_exp2f(2.8853900817779268f * z));
    return 0.5f * x * (1.0f + th);
}
struct EpiS {
    static constexpr bool PERM = false, AFTER_DRAIN = false, HAS_MID = false;
    float* S; int tmid;
    __device__ __forceinline__ void mid(f32x4 (&)[2][2][4][2], const Unit&, int, int, int, int) const {}
    __device__ __forceinline__ void operator()(const f32x4 (&acc)[2][2][4][2], const Unit& u, int wr, int wc, int fr, int fq) const {
        const int col0 = wc * 32 + 4 * fq;
#pragma unroll
        for (int ai = 0; ai < 2; ++ai)
#pragma unroll
            for (int m = 0; m < 4; ++m) { float* rowp = S + ((size_t)u.pm * BM + ai * HALF + wr * 64 + m * 16 + fr) * 256 + col0;
#pragma unroll
                for (int bj = 0; bj < 2; ++bj)
#pragma unroll
                    for (int n = 0; n < 2; ++n) *(f32x4*)(rowp + bj * HALF + n * 16) = acc[ai][bj][m][n]; }
    }
};
struct EpiY {
    static constexpr bool PERM = true, AFTER_DRAIN = false, HAS_MID = false;
    bf16_t* Y; int tmid;
    __device__ __forceinline__ void mid(f32x4 (&)[2][2][4][2], const Unit&, int, int, int, int) const {}
    __device__ __forceinline__ void operator()(const f32x4 (&acc)[2][2][4][2], const Unit& u, int wr, int wc, int fr, int fq) const {
        const int g = u.pn, rt = u.pm - 5 * g;
#pragma unroll
        for (int ai = 0; ai < 2; ++ai)
#pragma unroll
            for (int m = 0; m < 4; ++m) {
                const int R = rt * 256 + ai * HALF + wr * 64 + m * 16 + fr, b = R >> 7, k = R & 127;
#pragma unroll
                for (int bj = 0; bj < 2; ++bj) {
                    const int col8 = bj * HALF + wc * 32 + 8 * fq, t = col8 >> 4, c0 = col8 & 15;
                    f32x4 y0 = acc[ai][bj][m][0], y1 = acc[ai][bj][m][1];
#pragma unroll
                    for (int e = 0; e < 4; ++e) { y0[e] = gelu_tanh(y0[e]); y1[e] = gelu_tanh(y1[e]); }
                    *(u32x4*)(Y + ((size_t)(b * 2048 + k * 16 + t) * 512 + g * 16 + c0)) = pack8(y0, y1);
                }
                asm volatile("" ::: "memory");
            }
    }
};
template <class Epi, class Sched, bool ALIGN_EPI = false, bool SP2 = false>
__device__ __forceinline__ void gemm_phase(PG8_LAS unsigned char* lds, const Gemm g, const Sched& S, const Epi& E, const int wid) {
    const int lane = lane_id_v(), tid = wid * 64 + lane, wr = wid >> 2, wc = wid & 3, fr = lane & 15, fq = lane >> 4;
    const int K = g.K, nt = K / BK;
    unsigned voffA[2], voffB[2];
#pragma unroll
    for (int i = 0; i < 2; ++i) { int R, C; stage_rc(tid * 16 + i * 8192, R, C); const int Rb = Epi::PERM ? ((R & ~31) + perm32(R & 31)) : R;
        voffA[i] = (unsigned)(R * g.lda + C) * 2u; voffB[i] = (unsigned)(Rb * g.ldb + C) * 2u; }
    const size_t kstep = (size_t)(BK * 2);
    const size_t hstepA = (size_t)HALF * g.lda * 2, hstepB = (size_t)HALF * g.ldb * 2;
    const size_t tstepA = 2 * hstepA, tstepB = 2 * hstepB;
    const unsigned ldsw = (unsigned)wid * 1024u;
    const int aoff = lds_byte(wr * 64 + fr, fq * 8), boff = lds_byte(wc * 32 + fr, fq * 8);
#define PG8_SA(b, h) (((b) * 2 + (h)) * HTB)
#define PG8_SB(b, h) ((4 + (b) * 2 + (h)) * HTB)
#define PG8_STAGE(bufoff, gbase, voff) do { _Pragma("unroll") for (int _i = 0; _i < 2; ++_i) \
        __builtin_amdgcn_global_load_lds((const unsigned*)((const char*)(gbase) + (voff)[_i]), (PG8_LAS unsigned*)(lds + (bufoff) + ldsw + _i * 8192), 16, 0, 0); } while (0)
#define PG8_LDA(dst, b, h) do { _Pragma("unroll") for (int m = 0; m < 4; ++m) _Pragma("unroll") for (int k = 0; k < 2; ++k) dst[m][k] = *(const PG8_LAS bf16x8*)(lds + PG8_SA(b, h) + aoff + m * 2048 + k * 1024); } while (0)
#define PG8_LDB(dst, b, h) do { _Pragma("unroll") for (int n = 0; n < 2; ++n) _Pragma("unroll") for (int k = 0; k < 2; ++k) dst[n][k] = *(const PG8_LAS bf16x8*)(lds + PG8_SB(b, h) + boff + n * 2048 + k * 1024); } while (0)
#define PG8_MMA(ai, bj, At, Bt) do { __builtin_amdgcn_s_setprio(1); _Pragma("unroll") for (int m = 0; m < 4; ++m) _Pragma("unroll") for (int n = 0; n < 2; ++n) _Pragma("unroll") for (int k = 0; k < 2; ++k) \
        acc[ai][bj][m][n] = __builtin_amdgcn_mfma_f32_16x16x32_bf16(Bt[n][k], At[m][k], acc[ai][bj][m][n], 0, 0, 0); __builtin_amdgcn_s_setprio(0); } while (0)
#define PG8_WAIT_V(n) asm volatile("s_waitcnt vmcnt(" #n ")" ::: "memory")
#define PG8_WAIT_L(n) asm volatile("s_waitcnt lgkmcnt(" #n ")" ::: "memory")
#define PG8_BAR __builtin_amdgcn_s_barrier()
#define PG8_SCHED __builtin_amdgcn_sched_barrier(0)
    Unit cur, nxt; int ui = 0;
    if (!S.next(0, cur)) return;
    f32x4 acc[2][2][4][2];
#pragma unroll
    for (int a = 0; a < 2; ++a)
#pragma unroll
        for (int b = 0; b < 2; ++b)
#pragma unroll
            for (int m = 0; m < 4; ++m)
#pragma unroll
                for (int n = 0; n < 2; ++n) acc[a][b][m][n] = (f32x4){0.f, 0.f, 0.f, 0.f};
    bf16x8 At[4][2], B0[2][2], B1[2][2];
    const char* cA = (const char*)g.A + (size_t)cur.pm * tstepA; const char* cB = (const char*)g.Bt + (size_t)cur.pn * tstepB;
    S.a_ready(cur);
    if constexpr (SP2) {
        PG8_STAGE(PG8_SB(0, 0), cB, voffB); PG8_STAGE(PG8_SB(0, 1), cB + hstepB, voffB); PG8_STAGE(PG8_SA(0, 0), cA, voffA); PG8_STAGE(PG8_SA(0, 1), cA + hstepA, voffA);
        if (wr == 1) PG8_BAR;
        PG8_WAIT_V(2); PG8_BAR;
        PG8_STAGE(PG8_SB(1, 0), cB + kstep, voffB); PG8_STAGE(PG8_SA(1, 0), cA + kstep, voffA); PG8_STAGE(PG8_SB(1, 1), cB + hstepB + kstep, voffB);
        PG8_WAIT_V(6); PG8_BAR;
    } else {
        PG8_STAGE(PG8_SB(0, 0), cB, voffB); PG8_STAGE(PG8_SA(0, 0), cA, voffA); PG8_STAGE(PG8_SB(0, 1), cB + hstepB, voffB); PG8_STAGE(PG8_SA(0, 1), cA + hstepA, voffA);
        if (wr == 1) PG8_BAR;
        PG8_WAIT_V(4); PG8_BAR;
        PG8_STAGE(PG8_SB(1, 0), cB + kstep, voffB); PG8_STAGE(PG8_SA(1, 0), cA + kstep, voffA); PG8_STAGE(PG8_SB(1, 1), cB + hstepB + kstep, voffB);
        PG8_WAIT_V(6); PG8_BAR;
    }
    for (;;) {
        const bool has_next = S.next(ui + 1, nxt);
        const char* nA = has_next ? (const char*)g.A + (size_t)nxt.pm * tstepA : cA; const char* nB = has_next ? (const char*)g.Bt + (size_t)nxt.pn * tstepB : cB;
        for (int t = 0; t < nt; t += 2) {
            const bool last = (t == nt - 2);
            const char* a1 = cA + (size_t)(t + 1) * kstep;
            const char* a2 = last ? nA : cA + (size_t)(t + 2) * kstep; const char* b2 = last ? nB : cB + (size_t)(t + 2) * kstep;
            const char* a3 = a2 + kstep; const char* b3 = b2 + kstep;
            if (last && has_next) S.a_ready(nxt);
            if constexpr (Epi::HAS_MID) { if (t == E.tmid) E.mid(acc, cur, wr, wc, fr, fq); }
            if constexpr (SP2) {
            PG8_LDB(B0, 0, 0); PG8_LDB(B1, 0, 1); PG8_SCHED; PG8_LDA(At, 0, 0); PG8_STAGE(PG8_SA(1, 1), a1 + hstepA, voffA);
            PG8_WAIT_V(8); PG8_WAIT_L(0); PG8_BAR; PG8_MMA(0, 0, At, B0); PG8_MMA(0, 1, At, B1); PG8_BAR; PG8_SCHED;
            PG8_LDA(At, 0, 1); PG8_STAGE(PG8_SB(0, 0), b2, voffB); PG8_STAGE(PG8_SB(0, 1), b2 + hstepB, voffB); PG8_STAGE(PG8_SA(0, 0), a2, voffA);
            PG8_WAIT_V(8); PG8_WAIT_L(0); PG8_BAR; PG8_MMA(1, 0, At, B0); PG8_MMA(1, 1, At, B1); PG8_BAR; PG8_SCHED;
            PG8_LDB(B0, 1, 0); PG8_LDB(B1, 1, 1); PG8_SCHED; PG8_LDA(At, 1, 0); PG8_STAGE(PG8_SA(0, 1), a2 + hstepA, voffA);
            PG8_WAIT_V(8); PG8_WAIT_L(0); PG8_BAR; PG8_MMA(0, 0, At, B0); PG8_MMA(0, 1, At, B1); PG8_BAR; PG8_SCHED;
            PG8_LDA(At, 1, 1); PG8_STAGE(PG8_SB(1, 0), b3, voffB); PG8_STAGE(PG8_SB(1, 1), b3 + hstepB, voffB); PG8_STAGE(PG8_SA(1, 0), a3, voffA);
            PG8_WAIT_V(8); PG8_WAIT_L(0); PG8_BAR; PG8_MMA(1, 0, At, B0); PG8_MMA(1, 1, At, B1); PG8_BAR; PG8_SCHED;
            } else {
            PG8_LDB(B0, 0, 0); PG8_SCHED; PG8_LDA(At, 0, 0); PG8_STAGE(PG8_SA(1, 1), a1 + hstepA, voffA);
            PG8_WAIT_L(8); PG8_BAR; PG8_WAIT_L(0); PG8_MMA(0, 0, At, B0); PG8_BAR; PG8_SCHED;
            PG8_LDB(B1, 0, 1); PG8_STAGE(PG8_SB(0, 0), b2, voffB);
            PG8_BAR; PG8_WAIT_L(0); PG8_MMA(0, 1, At, B1); PG8_BAR;
            PG8_LDA(At, 0, 1); PG8_STAGE(PG8_SA(0, 0), a2, voffA);
            PG8_BAR; PG8_WAIT_L(0); PG8_MMA(1, 0, At, B0); PG8_BAR; PG8_SCHED;
            PG8_STAGE(PG8_SB(0, 1), b2 + hstepB, voffB);
            PG8_WAIT_V(6); PG8_BAR; PG8_MMA(1, 1, At, B1); PG8_BAR;
            PG8_LDB(B0, 1, 0); PG8_SCHED; PG8_LDA(At, 1, 0); PG8_STAGE(PG8_SA(0, 1), a2 + hstepA, voffA);
            PG8_WAIT_L(8); PG8_BAR; PG8_WAIT_L(0); PG8_MMA(0, 0, At, B0); PG8_BAR; PG8_SCHED;
            PG8_LDB(B1, 1, 1); PG8_STAGE(PG8_SB(1, 0), b3, voffB);
            PG8_BAR; PG8_WAIT_L(0); PG8_MMA(0, 1, At, B1); PG8_BAR;
            PG8_LDA(At, 1, 1); PG8_STAGE(PG8_SA(1, 0), a3, voffA);
            PG8_BAR; PG8_WAIT_L(0); PG8_MMA(1, 0, At, B0); PG8_BAR; PG8_SCHED;
            PG8_STAGE(PG8_SB(1, 1), b3 + hstepB, voffB);
            PG8_WAIT_V(6); PG8_BAR; PG8_MMA(1, 1, At, B1); PG8_BAR;
            }
        }
        if constexpr (ALIGN_EPI) { if (wr == 0) PG8_BAR; }
        if constexpr (!Epi::AFTER_DRAIN) { E(acc, cur, wr, wc, fr, fq); S.done(cur); }
        if (!has_next) break;
#pragma unroll
        for (int a = 0; a < 2; ++a)
#pragma unroll
            for (int b = 0; b < 2; ++b)
#pragma unroll
                for (int m = 0; m < 4; ++m)
#pragma unroll
                    for (int n = 0; n < 2; ++n) acc[a][b][m][n] = (f32x4){0.f, 0.f, 0.f, 0.f};
        cur = nxt; cA = nA; cB = nB; ++ui;
        if constexpr (ALIGN_EPI) { if (wr == 1) PG8_BAR; }
    }
    PG8_WAIT_V(0);
    if constexpr (!ALIGN_EPI) { if (wr == 0) PG8_BAR; }
    PG8_BAR;
    if constexpr (Epi::AFTER_DRAIN) { E.fused(acc, cur, wr, wc, fr, fq, lds, wid, lane); S.done(cur); }
#undef PG8_SA
#undef PG8_SB
#undef PG8_STAGE
#undef PG8_LDA
#undef PG8_LDB
#undef PG8_MMA
#undef PG8_WAIT_V
#undef PG8_WAIT_L
#undef PG8_BAR
#undef PG8_SCHED
}
}

#ifndef PG8_SP2
#define PG8_SP2 true
#endif
#ifndef PG8_ALIGN
#define PG8_ALIGN true
#endif
#define GAS __attribute__((address_space(1)))
#define LAS __attribute__((address_space(3)))
typedef unsigned short bf16;
typedef unsigned v4u __attribute__((ext_vector_type(4)));
typedef float f32x4 __attribute__((ext_vector_type(4)));
typedef short bf16x8 __attribute__((ext_vector_type(8)));
typedef GAS unsigned gu32;
typedef GAS unsigned long long gu64;
#define RLX_AGENT __ATOMIC_RELAXED, __HIP_MEMORY_SCOPE_AGENT
#define LDS_WAIT() asm volatile("s_waitcnt lgkmcnt(0)" ::: "memory")
#define VM_WAIT() asm volatile("s_waitcnt vmcnt(0)" ::: "memory")
__device__ __forceinline__ unsigned long long rt() { return __builtin_amdgcn_s_memrealtime(); }
__device__ __forceinline__ unsigned f2bf(float f) { unsigned u = __builtin_bit_cast(unsigned, f); return (u + 0x7fffu + ((u >> 16) & 1u)) >> 16; }
__device__ __forceinline__ unsigned pk2(float lo, float hi) { return f2bf(lo) | (f2bf(hi) << 16); }

#define XB_TMO      128
#define XB_XCNT(j)  (256  + 64 * (j))
#define XB_XSUB(j)  (1280 + 64 * (j))
#define XB_XGEN(j)  (2304 + 64 * (j))
#define XB_TOP      3328
#define XB_TOPGEN   3392
#define XCD_BAR_WORDS 3456
#define XB_SPIN_CAP (1u << 18)

__device__ __forceinline__ unsigned xb_ld(unsigned* p)              { return __hip_atomic_load(p, __ATOMIC_RELAXED, __HIP_MEMORY_SCOPE_AGENT); }
__device__ __forceinline__ unsigned xb_add(unsigned* p, unsigned v) { return __hip_atomic_fetch_add(p, v, __ATOMIC_RELAXED, __HIP_MEMORY_SCOPE_AGENT); }
__device__ __forceinline__ unsigned xb_xcc_id() { return (unsigned)__builtin_amdgcn_s_getreg((3 << 11) | 20) & 0xFu; }
#define XB_SPIN(cond, bar) do { unsigned _sp = 0; while (cond) { __builtin_amdgcn_s_sleep(1); \
    if ((++_sp & 255u) == 0u) { if (xb_ld(&(bar)[XB_TMO])) break; if (_sp > XB_SPIN_CAP) { atomicAdd(&(bar)[XB_TMO], 1u); break; } } } } while (0)

struct XcdBarrier {
    unsigned* bar; unsigned x;
    volatile LAS unsigned* st;
};

__device__ __forceinline__ XcdBarrier xcd_barrier_post(unsigned* bar, volatile LAS unsigned* st) {
    XcdBarrier b; b.bar = bar; b.x = xb_xcc_id(); b.st = st;
    if (threadIdx.x == 0) (void)xb_add(&bar[XB_XCNT(b.x)], 1u);
    return b;
}
__device__ __forceinline__ void xcd_barrier_complete(unsigned* bar, unsigned x, unsigned& nloc, unsigned& nx) {
    const unsigned G = gridDim.x * gridDim.y * gridDim.z;
    unsigned sum, cnt, mine, sp = 0u;
    for (;;) {
        sum = 0u; cnt = 0u; mine = 0u;
#pragma unroll
        for (unsigned j = 0; j < 16; ++j) { const unsigned c = xb_ld(&bar[XB_XCNT(j)]); sum += c; cnt += (c > 0u) ? 1u : 0u; mine = (j == x) ? c : mine; }
        if (sum == G) break;
        __builtin_amdgcn_s_sleep(1);
        if ((++sp & 255u) == 0u) { if (xb_ld(&bar[XB_TMO])) break; if (sp > XB_SPIN_CAP) { atomicAdd(&bar[XB_TMO], 1u); break; } }
    }
    nloc = mine > 0u ? mine : 1u; nx = cnt > 0u ? cnt : 1u;
}

__device__ __forceinline__ void xcd_barrier(const XcdBarrier& b, const int wave) {
    asm volatile("s_waitcnt vmcnt(0)" ::: "memory");
    __syncthreads();
    if (wave == 0 && pg8::lane_id_v() == 0) {
        unsigned* bar = b.bar;
        __builtin_amdgcn_s_waitcnt(0);
        unsigned nloc = b.st[0], nx = b.st[1];
        if (nloc == 0u) { xcd_barrier_complete(bar, b.x, nloc, nx); b.st[0] = nloc; b.st[1] = nx; }
        const unsigned old = xb_add(&bar[XB_XSUB(b.x)], 1u);
        const unsigned gen = old / nloc;
        if (old + 1u == (gen + 1u) * nloc) {
            __builtin_amdgcn_fence(__ATOMIC_RELEASE, "agent");
            asm volatile("s_waitcnt vmcnt(0)" ::: "memory");
            const unsigned og = xb_add(&bar[XB_TOP], 1u);
            const unsigned tg = og / nx;
            if (og + 1u == (tg + 1u) * nx) xb_add(&bar[XB_TOPGEN], 1u);
            else XB_SPIN(xb_ld(&bar[XB_TOPGEN]) == tg, bar);
            __builtin_amdgcn_fence(__ATOMIC_ACQUIRE, "agent");
            xb_add(&bar[XB_XGEN(b.x)], 1u);
            asm volatile("s_waitcnt vmcnt(0)" ::: "memory");
        } else {
            XB_SPIN(xb_ld(&bar[XB_XGEN(b.x)]) == gen, bar);
            __builtin_amdgcn_fence(__ATOMIC_ACQUIRE, "agent");
            asm volatile("s_waitcnt vmcnt(0)" ::: "memory");
        }
    }
    __syncthreads();
}

#include <hip/hip_bf16.h>
#include <cmath>
namespace attn_body {
using bf16=__hip_bfloat16;
using bf16x8=__attribute__((ext_vector_type(8)))short;
using s16x4=__attribute__((ext_vector_type(4)))short;
using f32x16=__attribute__((ext_vector_type(16)))float;
using u32x4=__attribute__((ext_vector_type(4)))unsigned;
constexpr int D=64,DM=1024,SEQQ=2048,SEQKV=2304;
constexpr int NW=8,QBLK=32,QB=QBLK*NW,KVBLK=64,NQB=SEQQ/QB;
constexpr int ATTN_PITCH=DM, ATTN_UNIT_ROWS=QB;
__device__ __forceinline__ int crow(int r,int hi){return (r&3)+8*(r>>2)+4*hi;}
#define SBAR() __builtin_amdgcn_sched_barrier(0)
__device__ __forceinline__ void cmask(f32x16&p0,f32x16&p1,int jb,int qrel,int hi){
  const float NEG=-INFINITY; int kb=64*jb+4*hi;
  #pragma unroll
  for(int r=0;r<16;++r){int kv=kb+(r&3)+8*(r>>2); if(kv>qrel)p0[r]=NEG; if(kv+32>qrel)p1[r]=NEG;}
}

constexpr int NSLOT=3, SLOTB=8192;
constexpr int LDS_K=0, LDS_V=NSLOT*SLOTB, LDS_WS=3*NSLOT*SLOTB, LDS_OST=0, LDS_BYTES=LDS_WS+NW*64*4;
constexpr float C2=0.125f*1.4426950408889634f;
__device__ __forceinline__ void glds16(const void*gsrc,unsigned lds_dst){unsigned keep;
  asm volatile("s_mov_b32 %0, m0\n\ts_mov_b32 m0, %2\n\ts_nop 0\n\tglobal_load_lds_dwordx4 %1, off\n\ts_mov_b32 m0, %0":"=&s"(keep):"v"(gsrc),"s"(lds_dst):"memory");}
__device__ __forceinline__ float max3f(float a,float b,float c){float r;asm("v_max3_f32 %0, %1, %2, %3":"=v"(r):"v"(a),"v"(b),"v"(c));return r;}
__device__ __forceinline__ float max2f(float a,float b){float r;asm("v_max_f32_e32 %0, %1, %2":"=v"(r):"v"(a),"v"(b));return r;}
__device__ __forceinline__ float fadd_s(float a,float b){float r;asm("v_add_f32_e32 %0, %1, %2":"=v"(r):"v"(a),"v"(b));return r;}
__device__ __forceinline__ float fsub_s(float a,float b){float r;asm("v_sub_f32_e32 %0, %1, %2":"=v"(r):"v"(a),"v"(b));return r;}
typedef float f32x2_t __attribute__((ext_vector_type(2))); typedef __bf16 bf16x2_t __attribute__((ext_vector_type(2)));
__device__ __forceinline__ unsigned cvtpk_s(float lo,float hi){f32x2_t v={lo,hi};bf16x2_t b=__builtin_convertvector(v,bf16x2_t);return __builtin_bit_cast(unsigned,b);}
#define WAIT_BAR(N) asm volatile("s_waitcnt vmcnt(" #N ") lgkmcnt(0)\n\ts_barrier":::"memory")

__device__ __forceinline__ void qkt(f32x16&p0,f32x16&p1,const char*Kslot,const bf16x8*qr,const f32x16&negm,int r32,int hi){
  const char*kb=Kslot+hi*1024+r32*16;
  #pragma unroll
  for(int d0=0;d0<4;++d0){
    const bf16x8 b0=*reinterpret_cast<const bf16x8*>(kb+d0*2048);
    const bf16x8 b1=*reinterpret_cast<const bf16x8*>(kb+d0*2048+512);
    if(d0==0){p0=__builtin_amdgcn_mfma_f32_32x32x16_bf16(b0,qr[0],negm,0,0,0);p1=__builtin_amdgcn_mfma_f32_32x32x16_bf16(b1,qr[0],negm,0,0,0);}
    else{p0=__builtin_amdgcn_mfma_f32_32x32x16_bf16(b0,qr[d0],p0,0,0,0);p1=__builtin_amdgcn_mfma_f32_32x32x16_bf16(b1,qr[d0],p1,0,0,0);}}
}
typedef __attribute__((address_space(3))) const char* lds_cptr;
typedef short v4i16_t __attribute__((ext_vector_type(4)));
__device__ __forceinline__ void kload8(bf16x8*kf,lds_cptr kp){
  kf[0]=*(const __attribute__((address_space(3))) bf16x8*)(kp);      kf[1]=*(const __attribute__((address_space(3))) bf16x8*)(kp+512);
  kf[2]=*(const __attribute__((address_space(3))) bf16x8*)(kp+2048); kf[3]=*(const __attribute__((address_space(3))) bf16x8*)(kp+2560);
  kf[4]=*(const __attribute__((address_space(3))) bf16x8*)(kp+4096); kf[5]=*(const __attribute__((address_space(3))) bf16x8*)(kp+4608);
  kf[6]=*(const __attribute__((address_space(3))) bf16x8*)(kp+6144); kf[7]=*(const __attribute__((address_space(3))) bf16x8*)(kp+6656);
}
__device__ __forceinline__ void kload2(bf16x8*kf,lds_cptr kp,int j){ kf[2*j]=*(const __attribute__((address_space(3))) bf16x8*)(kp+j*2048); kf[2*j+1]=*(const __attribute__((address_space(3))) bf16x8*)(kp+j*2048+512); }
__device__ __forceinline__ s16x4 vtr(lds_cptr p){ return __builtin_bit_cast(s16x4,__builtin_amdgcn_ds_read_tr16_b64_v4i16((__attribute__((address_space(3))) v4i16_t*)p)); }
__device__ __forceinline__ float rowmax(const f32x16&p0,const f32x16&p1){
  float a=max3f(p0[0],p0[1],p1[0]),b=max3f(p0[2],p0[3],p1[1]);a=max3f(a,p1[2],p1[3]);
  #pragma unroll
  for(int r=4;r<16;r+=4){a=max3f(a,p0[r],p0[r+1]);b=max3f(b,p0[r+2],p0[r+3]);a=max3f(a,p1[r],p1[r+1]);b=max3f(b,p1[r+2],p1[r+3]);}
  const float m=max2f(a,b);
  auto rr=__builtin_amdgcn_permlane32_swap(__float_as_uint(m),__float_as_uint(m),false,false);
  return max2f(__uint_as_float(rr[0]),__uint_as_float(rr[1]));
}
__device__ __forceinline__ void pv(f32x16*o,int vb,bf16x8 pa0,bf16x8 pa1,bf16x8 pa2,bf16x8 pa3){
  #pragma unroll
  for(int d0=0;d0<4;++d0){s16x4 lo[4],hi[4];
    #pragma unroll
    for(int ks=0;ks<4;++ks){
      asm volatile("ds_read_b64_tr_b16 %0,%1 offset:%c2":"=&v"(lo[ks]):"v"(vb),"i"(d0*4096+ks*1024):"memory");
      asm volatile("ds_read_b64_tr_b16 %0,%1 offset:%c2":"=&v"(hi[ks]):"v"(vb),"i"(d0*4096+ks*1024+512):"memory");}
    asm volatile("s_waitcnt lgkmcnt(0)":::"memory");SBAR();
    #define PK(k) (bf16x8){lo[k][0],lo[k][1],lo[k][2],lo[k][3],hi[k][0],hi[k][1],hi[k][2],hi[k][3]}
    o[d0]=__builtin_amdgcn_mfma_f32_32x32x16_bf16(pa0,PK(0),o[d0],0,0,0);
    o[d0]=__builtin_amdgcn_mfma_f32_32x32x16_bf16(pa1,PK(1),o[d0],0,0,0);
    o[d0]=__builtin_amdgcn_mfma_f32_32x32x16_bf16(pa2,PK(2),o[d0],0,0,0);
    o[d0]=__builtin_amdgcn_mfma_f32_32x32x16_bf16(pa3,PK(3),o[d0],0,0,0);
    #undef PK
  }
}

#ifndef ATTN_STORE16
#define ATTN_STORE16(p,v) (*(u32x4*)(p)=(v))
#endif
template<int THRL> __device__ __forceinline__ void attn_unit(int b,int qb,int qcol,int kcol,int vcol,int ocol,const bf16*Q,const bf16*__restrict__ K,const bf16*__restrict__ V,bf16*O,char*shm,const int wid){
  const int lane=pg8::lane_id_v(),r32=lane&31,hi=lane>>5;
  const long rowq=(long)b*SEQQ, rowkv=(long)b*SEQKV; const int q0=qb*QB;
  const bf16*Qw=Q+(rowq+q0+wid*QBLK)*DM+qcol;
  const bf16*Kh=K+rowkv*DM+kcol,*Vh=V+rowkv*DM+vcol;
  const unsigned lds0=(unsigned)(uintptr_t)shm;
  float*wsf=(float*)(shm+LDS_WS)+wid*64;
  const bf16*ksrc=Kh+(long)lane*DM+wid*8;
  const bf16*vsrc=Vh+(long)(16*(wid&3)+(lane>>2))*DM+(wid>>2)*32+(lane&3)*8;
  const unsigned kdst=lds0+LDS_K+wid*1024, vdst=lds0+LDS_V+wid*1024;
  #define DMA_K(t,slot) glds16(ksrc+(long)(t)*KVBLK*DM,(unsigned)__builtin_amdgcn_readfirstlane(kdst+(slot)))
  #define DMA_V(t,slot) do{ glds16(vsrc+(long)(t)*KVBLK*DM,(unsigned)__builtin_amdgcn_readfirstlane(vdst+2*(slot))); glds16(vsrc+(long)(t)*KVBLK*DM+64,(unsigned)__builtin_amdgcn_readfirstlane(vdst+2*(slot)+8192)); }while(0)
  const int vb0=(int)(lds0+LDS_V)+((lane>>4)&1)*32+(lane&3)*8+(4*hi+((lane&15)>>2))*64;
  const char*Kbase=shm+LDS_K; bf16x8 kf[8];
  const lds_cptr shm3=(lds_cptr)shm; const lds_cptr kp0=shm3+LDS_K+hi*1024+r32*16; const lds_cptr vp0=shm3+LDS_V+((lane>>4)&1)*32+(lane&3)*8+(4*hi+((lane&15)>>2))*64;
  constexpr int NT=SEQKV/KVBLK;
  DMA_K(0,0);DMA_V(0,0);DMA_K(1,SLOTB);
  bf16x8 qr[4];
  #pragma unroll
  for(int d0=0;d0<4;++d0)qr[d0]=*reinterpret_cast<const bf16x8*>(&Qw[(long)r32*DM+d0*16+hi*8]);
  float mhat=0.f,l_reg=0.f;f32x16 o[4];o[0]=f32x16{};o[1]=f32x16{};o[2]=f32x16{};o[3]=f32x16{};f32x16 negm=f32x16{};asm volatile("":"+v"(negm));
    #define CMASK(P0,P1,t) do{}while(0)
  bool resc=false;
  #define START(P0,P1) do{ const float rm=rowmax(P0,P1); resc=false; \
    { const float dl=rm; mhat=fadd_s(mhat,dl); \
      _Pragma("unroll") for(int r=0;r<16;++r){P0[r]=fsub_s(P0[r],dl);P1[r]=fsub_s(P1[r],dl);} \
      _Pragma("unroll") for(int r=0;r<16;++r)negm[r]=-mhat; asm volatile("":"+v"(negm)); } \
    _Pragma("unroll") for(int r=0;r<16;++r)P0[r]=__builtin_amdgcn_exp2f(P0[r]); }while(0)
  #define RESC() do{ if(resc){ asm volatile("s_waitcnt lgkmcnt(0)":::"memory"); \
      _Pragma("unroll") for(int d_=0;d_<4;++d_) _Pragma("unroll") for(int r=0;r<16;++r)o[d_][r]*=wsf[crow(r,hi)]; } }while(0)
  f32x16 pA0,pA1,pB0,pB1;
  int sl_prev=0,sl_cur=0,sl_next=SLOTB;
  #define ROT() do{sl_prev=sl_cur;sl_cur=sl_next;sl_next=(sl_next==(NSLOT-1)*SLOTB)?0:sl_next+SLOTB;}while(0)
  DMA_K(2,2*SLOTB);
  WAIT_BAR(3);
  qkt(pA0,pA1,Kbase,qr,negm,r32,hi);asm volatile("s_nop 15\n\ts_nop 7":"+v"(pA0),"+v"(pA1));CMASK(pA0,pA1,0);
  START(pA0,pA1);
  _Pragma("unroll") for(int r=0;r<16;++r)pA1[r]=__builtin_amdgcn_exp2f(pA1[r]);
  WAIT_BAR(0);
  DMA_K(3,0);DMA_V(1,SLOTB);
  ROT();
  kload8(kf,kp0+sl_cur);
  WAIT_BAR(3);
  s16x4 valo[4],vahi[4],vblo[4],vbhi[4]; u32x4 pw0,pw1,pw2,pw3;
  #define PKW(P,B) cvtpk_s(P[B],P[B+1])
  #define PAF(k) __builtin_bit_cast(bf16x8,pw##k)
  #define VFA(i) (bf16x8){valo[i][0],valo[i][1],valo[i][2],valo[i][3],vahi[i][0],vahi[i][1],vahi[i][2],vahi[i][3]}
  #define VFB(i) (bf16x8){vblo[i][0],vblo[i][1],vblo[i][2],vblo[i][3],vbhi[i][0],vbhi[i][1],vbhi[i][2],vbhi[i][3]}
  #define PIN(x) asm volatile("":"+v"(x))
  #define MX3(a,b,c) __builtin_fmaxf(__builtin_fmaxf((a),(b)),(c))
  #define GAPA(MF,A0,A1,A2,A3,W0,W1,PW) do{ MF; sacc+=A0; sacc+=A1; sacc+=A2; sacc+=A3; PIN(sacc); W0; W1; PIN(PW); SBAR(); }while(0)
  #define EX(v) __builtin_amdgcn_exp2f(v)
  #define GAPB(MF,X,B) do{ MF; X[B]=EX(X[B]); X[B+1]=EX(X[B+1]); PIN(X); SBAR(); }while(0)
  #define VRA(d0,ks) do{ valo[d0]=vtr(vp_+((d0)*4096+(ks)*1024)); vahi[d0]=vtr(vp_+((d0)*4096+(ks)*1024+512)); }while(0)
  #define VRB(d0,ks) do{ vblo[d0]=vtr(vp_+((d0)*4096+(ks)*1024)); vbhi[d0]=vtr(vp_+((d0)*4096+(ks)*1024+512)); }while(0)
  #define KRD(G,j) do{ if(G){ kload2(kf,kp0+sl_next,j); SBAR(); } }while(0)
  #define STEP(C0,C1,P0,P1,t,GK,GV,GL) do{ SBAR(); \
    const lds_cptr vp_=vp0+2*sl_prev; \
    float sacc=(P0[0]+P0[1]); \
    GAPA(C0=__builtin_amdgcn_mfma_f32_32x32x16_bf16(kf[0],qr[0],negm,0,0,0), P0[2],P0[3],P0[4],P0[5],     pw0[0]=PKW(P0,0), pw0[1]=PKW(P0,2), pw0); \
    GAPA(C1=__builtin_amdgcn_mfma_f32_32x32x16_bf16(kf[1],qr[0],negm,0,0,0), P0[6],P0[7],P0[8],P0[9],     pw0[2]=PKW(P0,4), pw0[3]=PKW(P0,6), pw0); \
    GAPA(C0=__builtin_amdgcn_mfma_f32_32x32x16_bf16(kf[2],qr[1],C0,0,0,0),   P0[10],P0[11],P0[12],P0[13], pw1[0]=PKW(P0,8), pw1[1]=PKW(P0,10), pw1); \
    GAPA(C1=__builtin_amdgcn_mfma_f32_32x32x16_bf16(kf[3],qr[1],C1,0,0,0),   P0[14],P0[15],P1[0],P1[1],   pw1[2]=PKW(P0,12),pw1[3]=PKW(P0,14), pw1); \
    GAPA(C0=__builtin_amdgcn_mfma_f32_32x32x16_bf16(kf[4],qr[2],C0,0,0,0),   P1[2],P1[3],P1[4],P1[5],     pw2[0]=PKW(P1,0), pw2[1]=PKW(P1,2), pw2); \
    GAPA(C1=__builtin_amdgcn_mfma_f32_32x32x16_bf16(kf[5],qr[2],C1,0,0,0),   P1[6],P1[7],P1[8],P1[9],     pw2[2]=PKW(P1,4), pw2[3]=PKW(P1,6), pw2); \
    GAPA(C0=__builtin_amdgcn_mfma_f32_32x32x16_bf16(kf[6],qr[3],C0,0,0,0),   P1[10],P1[11],P1[12],P1[13], pw3[0]=PKW(P1,8), pw3[1]=PKW(P1,10), pw3); \
    GAPA(C1=__builtin_amdgcn_mfma_f32_32x32x16_bf16(kf[7],qr[3],C1,0,0,0),   P1[14],P1[15],0.f,0.f,       pw3[2]=PKW(P1,12),pw3[3]=PKW(P1,14), pw3); \
    l_reg+=sacc; \
    VRA(0,0); VRA(1,0); VRA(2,0); VRA(3,0); SBAR();               \
    if(GK){DMA_K((t)+3,sl_cur);} if(GV){DMA_V((t)+1,sl_next);} \
    CMASK(C0,C1,t); \
    { float a=MX3(C0[0],C0[1],C1[0]),b=MX3(C0[2],C0[3],C1[1]); a=MX3(a,C1[2],C1[3]); \
      _Pragma("unroll") for(int r=4;r<16;r+=4){a=MX3(a,C0[r],C0[r+1]);b=MX3(b,C0[r+2],C0[r+3]);a=MX3(a,C1[r],C1[r+1]);b=MX3(b,C1[r+2],C1[r+3]);} \
      float rm=__builtin_fmaxf(a,b); { auto rr=__builtin_amdgcn_permlane32_swap(__float_as_uint(rm),__float_as_uint(rm),false,false); rm=__builtin_fmaxf(__uint_as_float(rr[0]),__uint_as_float(rr[1])); } \
      resc=false; \
      if(__builtin_expect(__any(rm>(float)THRL),0)){ const float dl=__builtin_fmaxf(rm,0.f); mhat+=dl; \
        _Pragma("unroll") for(int r=0;r<16;++r){C0[r]-=dl;C1[r]-=dl;} \
        _Pragma("unroll") for(int r=0;r<16;++r)negm[r]=-mhat; asm volatile("":"+v"(negm)); \
        const float f=__builtin_amdgcn_exp2f(-dl); l_reg*=f; if(hi==0)wsf[r32]=f; resc=true; } } \
    SBAR(); \
    VRB(0,1); GAPB(o[0]=__builtin_amdgcn_mfma_f32_32x32x16_bf16(PAF(0),VFA(0),o[0],0,0,0), C0,0); \
    VRB(1,1); GAPB(o[1]=__builtin_amdgcn_mfma_f32_32x32x16_bf16(PAF(0),VFA(1),o[1],0,0,0), C0,2); \
    VRB(2,1); GAPB(o[2]=__builtin_amdgcn_mfma_f32_32x32x16_bf16(PAF(0),VFA(2),o[2],0,0,0), C0,4); \
    VRB(3,1); GAPB(o[3]=__builtin_amdgcn_mfma_f32_32x32x16_bf16(PAF(0),VFA(3),o[3],0,0,0), C0,6); \
    VRA(0,2); GAPB(o[0]=__builtin_amdgcn_mfma_f32_32x32x16_bf16(PAF(1),VFB(0),o[0],0,0,0), C0,8); \
    VRA(1,2); GAPB(o[1]=__builtin_amdgcn_mfma_f32_32x32x16_bf16(PAF(1),VFB(1),o[1],0,0,0), C0,10); \
    VRA(2,2); KRD(GL,0); GAPB(o[2]=__builtin_amdgcn_mfma_f32_32x32x16_bf16(PAF(1),VFB(2),o[2],0,0,0), C0,12); \
    VRA(3,2); KRD(GL,1); GAPB(o[3]=__builtin_amdgcn_mfma_f32_32x32x16_bf16(PAF(1),VFB(3),o[3],0,0,0), C0,14); \
    VRB(0,3); GAPB(o[0]=__builtin_amdgcn_mfma_f32_32x32x16_bf16(PAF(2),VFA(0),o[0],0,0,0), C1,0); \
    VRB(1,3); GAPB(o[1]=__builtin_amdgcn_mfma_f32_32x32x16_bf16(PAF(2),VFA(1),o[1],0,0,0), C1,2); \
    VRB(2,3); KRD(GL,2); GAPB(o[2]=__builtin_amdgcn_mfma_f32_32x32x16_bf16(PAF(2),VFA(2),o[2],0,0,0), C1,4); \
    VRB(3,3); KRD(GL,3); GAPB(o[3]=__builtin_amdgcn_mfma_f32_32x32x16_bf16(PAF(2),VFA(3),o[3],0,0,0), C1,6); \
    GAPB(o[0]=__builtin_amdgcn_mfma_f32_32x32x16_bf16(PAF(3),VFB(0),o[0],0,0,0), C1,8); \
    GAPB(o[1]=__builtin_amdgcn_mfma_f32_32x32x16_bf16(PAF(3),VFB(1),o[1],0,0,0), C1,10); \
    GAPB(o[2]=__builtin_amdgcn_mfma_f32_32x32x16_bf16(PAF(3),VFB(2),o[2],0,0,0), C1,12); \
    GAPB(o[3]=__builtin_amdgcn_mfma_f32_32x32x16_bf16(PAF(3),VFB(3),o[3],0,0,0), C1,14); \
    }while(0)
  int t=1;
  #undef CMASK
  #define CMASK(P0,P1,t) do{}while(0)
  for(;t+5<NT;t+=2){
    STEP(pB0,pB1,pA0,pA1,t,true,true,true);     WAIT_BAR(3); RESC(); ROT();
    STEP(pA0,pA1,pB0,pB1,t+1,true,true,true);   WAIT_BAR(3); RESC(); ROT();
  }
  #undef CMASK
  #define CMASK(P0,P1,t) do{}while(0)
  #define ENDW(tt) do{ if((tt)+3<NT){WAIT_BAR(3);} else if((tt)+2<NT){WAIT_BAR(2);} else {WAIT_BAR(0);} }while(0)
  for(;t+1<NT;t+=2){
    STEP(pB0,pB1,pA0,pA1,t,(t+3<NT),(t+1<NT),(t+1<NT));       ENDW(t);   RESC(); ROT();
    STEP(pA0,pA1,pB0,pB1,t+1,(t+4<NT),(t+2<NT),(t+2<NT));     ENDW(t+1); RESC(); ROT();
  }
  STEP(pB0,pB1,pA0,pA1,NT-1,false,false,false); RESC();
  { float sacc=pB0[0]+pB0[1]; _Pragma("unroll") for(int r=2;r<16;++r)sacc+=pB0[r]; _Pragma("unroll") for(int r=0;r<16;++r)sacc+=pB1[r]; l_reg+=sacc;
    pw0=(u32x4){PKW(pB0,0),PKW(pB0,2),PKW(pB0,4),PKW(pB0,6)};pw1=(u32x4){PKW(pB0,8),PKW(pB0,10),PKW(pB0,12),PKW(pB0,14)};pw2=(u32x4){PKW(pB1,0),PKW(pB1,2),PKW(pB1,4),PKW(pB1,6)};pw3=(u32x4){PKW(pB1,8),PKW(pB1,10),PKW(pB1,12),PKW(pB1,14)};
    SBAR(); pv(o,vb0+2*sl_cur,PAF(0),PAF(1),PAF(2),PAF(3)); }
  #undef PKW
  #undef PAF
  #undef VFA
  #undef VFB
  #undef PIN
  #undef MX3
  #undef GAPA
  #undef GAPB
  #undef EX
  #undef VRA
  #undef VRB
  #undef KRD
  #undef STEP
  #undef ENDW
  {auto rr=__builtin_amdgcn_permlane32_swap(__float_as_uint(l_reg),__float_as_uint(l_reg),false,false);l_reg=__uint_as_float(rr[0])+__uint_as_float(rr[1]);}
  if(hi==0)wsf[32+r32]=l_reg;asm volatile("s_waitcnt lgkmcnt(0)":::"memory");
  float rli[16];
  #pragma unroll
  for(int r=0;r<16;++r)rli[r]=__builtin_amdgcn_rcpf(wsf[32+crow(r,hi)]);
  bf16*Ow=O+(rowq+q0+wid*QBLK)*DM+ocol;
  asm volatile("s_waitcnt lgkmcnt(0)\n\ts_barrier":::"memory");
  { bf16*stg=(bf16*)(shm+LDS_OST)+wid*4096;
    #pragma unroll
    for(int r=0;r<16;++r){const int orow=crow(r,hi);
      #pragma unroll
      for(int d0=0;d0<4;++d0)stg[orow*128+d0*32+r32]=__float2bfloat16(o[d0][r]*rli[r]);}
    asm volatile("s_waitcnt lgkmcnt(0)":::"memory");
    #pragma unroll
    for(int i=0;i<8;++i){const int row=i*4+(lane>>4),ch=lane&15; const u32x4 v=*(const u32x4*)(stg+row*128+ch*8); ATTN_STORE16(Ow+(long)row*DM+ch*8,v);} }
  asm volatile("s_waitcnt lgkmcnt(0)\n\ts_barrier":::"memory");
  #undef DMA_K
  #undef DMA_V
  #undef CMASK
  #undef START
  #undef RESC
  #undef ROT
}
constexpr int ATTN_LDS_BYTES=LDS_BYTES;
#undef SBAR
#undef WAIT_BAR
}

constexpr int NWAVES = 8;
#ifndef MK_PER_PHASE
#define MK_PER_PHASE 0
#endif

constexpr int BATCH = 8, SEQ = 2048, DM = 2048, CTXL = 256;
constexpr int MLAT = BATCH * SEQ, MCTX = BATCH * CTXL, MALL = MLAT + MCTX;
constexpr int INW = 9216, KVROWS = SEQ + CTXL;
constexpr float NORM_EPS = 1e-6f, LAM_INIT = 0.2f;
constexpr float QSCALE = 0.125f * 1.4426950408889634f;

constexpr int RING_BYTES = 131072;
constexpr int LDSCTL_OFF = RING_BYTES, MISC_OFF = LDSCTL_OFF + 320;
constexpr int LDS_BYTES = 147456;

struct Args { const float* in[27]; float* out; unsigned char* ws; int ph_lo, ph_hi, li, pad; };
enum In { I_X = 0, I_C, I_CTX, I_CCTX, I_WADA, I_BADA, I_NORMG, I_WIN, I_LQ1, I_LK1, I_LQ2, I_LK2, I_SUBLN, I_LRE, I_LIM, I_LSTEP, I_BRE, I_BIM, I_CRE, I_CIM, I_SSMD, I_WGLU, I_BGLU, I_WPA, I_WPS, I_WOUT, I_FING };

__device__ __forceinline__ float wave_sum(float v) {
#pragma unroll
    for (int o = 1; o < 64; o <<= 1) v += __shfl_xor(v, o);
    return v;
}
using pg8::bf_lo; using pg8::bf_hi; using pg8::unpack8; using pg8::pack8; using pg8::sigmoid_f;
typedef pg8::u32x4 u32x4;

struct TrItem { const float* W; bf16* WT; int N, dpitch, dcol, item; };
__device__ __forceinline__ void tr_load(const TrItem& t, float (&tv)[32], int lane) {
    const int nblk = t.N / 32, kb = t.item / nblk, nb = t.item % nblk, k0 = 64 * kb, n0 = 32 * nb;
#pragma unroll
    for (int i = 0; i < 32; ++i) tv[i] = t.W[(size_t)(k0 + 2 * i + (lane >> 5)) * t.N + n0 + (lane & 31)];
}
__device__ __forceinline__ void tr_store(const TrItem& t, const float (&tv)[32], LAS float* scr, int lane) {
    const int nblk = t.N / 32, kb = t.item / nblk, nb = t.item % nblk, k0 = 64 * kb, n0 = 32 * nb;
#pragma unroll
    for (int i = 0; i < 32; ++i) scr[(2 * i + (lane >> 5)) * 33 + (lane & 31)] = tv[i];
    LDS_WAIT(); asm volatile("" ::: "memory");
    const int c = lane & 7;
#pragma unroll
    for (int j = 0; j < 4; ++j) { const int n = (lane >> 3) + 8 * j; const LAS float* s = scr + (8 * c) * 33 + n;
        v4u o; o.x = pk2(s[0 * 33], s[1 * 33]); o.y = pk2(s[2 * 33], s[3 * 33]); o.z = pk2(s[4 * 33], s[5 * 33]); o.w = pk2(s[6 * 33], s[7 * 33]);
        *(GAS v4u*)(t.WT + (size_t)(n0 + n) * t.dpitch + t.dcol + k0 + 8 * c) = o; }
    LDS_WAIT(); asm volatile("" ::: "memory");
}
__device__ __forceinline__ TrItem tr_item(const Args& a, int it) {
    constexpr int I_IN = (2048 / 64) * (9216 / 32), I_PA = (1024 / 64) * (2048 / 32), I_PS = (512 / 64) * (2048 / 32), I_OUT = (2048 / 64) * (2048 / 32);
    const int m = it < I_IN ? 0 : it < I_IN + I_PA ? 1 : it < I_IN + I_PA + I_PS ? 2 : it < I_IN + I_PA + I_PS + I_OUT ? 3 : 4;
    const float* W = m == 0 ? a.in[I_WIN] : m == 1 ? a.in[I_WPA] : m == 2 ? a.in[I_WPS] : m == 3 ? a.in[I_WOUT] : a.in[I_WGLU];
    const size_t wo = m == 0 ? WS_WIN : m <= 2 ? WS_WCAT : m == 3 ? WS_WOUT : WS_WGLU;
    TrItem t; t.W = W; t.WT = (bf16*)(a.ws + wo);
    t.N = m == 0 ? 9216 : m == 4 ? 512 : 2048; t.dpitch = m == 0 ? 2048 : m <= 2 ? 1536 : m == 3 ? 2048 : 512; t.dcol = m == 2 ? 1024 : 0;
    t.item = it - (m == 0 ? 0 : m == 1 ? I_IN : m == 2 ? I_IN + I_PA : m == 3 ? I_IN + I_PA + I_PS : I_IN + I_PA + I_PS + I_OUT);
    return t;
}
constexpr int TR_NITEMS = (2048 / 64) * (9216 / 32) + (1024 / 64) * (2048 / 32) + (512 / 64) * (2048 / 32) + (2048 / 64) * (2048 / 32) + (512 / 64) * (512 / 32);

__device__ __forceinline__ void ssm_disc(const Args& a, int idx, float& ar, float& ai, float& fr, float& fi) {
    const float lre = a.in[I_LRE][idx], lim = a.in[I_LIM][idx], dt = expf(a.in[I_LSTEP][idx >> 6]);
    const float mag = expf(lre * dt); ar = mag * cosf(lim * dt); ai = mag * sinf(lim * dt);
    const float den = lre * lre + lim * lim;
    fr = ((ar - 1.0f) * lre + ai * lim) / den; fi = (ai * lre - (ar - 1.0f) * lim) / den;
}
__device__ __forceinline__ void p0_prologue(const Args& a, LAS unsigned char* lds, int vcu, int G, int wave, int lane, int rep) {
    unsigned char* ws = a.ws;
    const int gw = vcu * NWAVES + wave, NGW = G * NWAVES;
#ifndef P0_PARTS
#define P0_PARTS 7
#endif
    const int parts = rep ? P0_PARTS : 7;
    {
        float* mod = (float*)(ws + WS_CTL + CTL_MOD + (size_t)rep * 393216);
        const float* wada = a.in[I_WADA]; const float* cc = a.in[I_C]; const float* cctx = a.in[I_CCTX];
        LAS float* sl = (LAS float*)lds;
        __syncthreads();
        { float cv[36];
#pragma unroll
          for (int j = 0; j < 36; ++j) { const int i = wave * 64 + lane + 512 * j; cv[j] = i < 16384 ? cc[i] : cctx[i - 16384]; }
#pragma unroll
          for (int j = 0; j < 36; ++j) sl[wave * 64 + lane + 512 * j] = cv[j] * sigmoid_f(cv[j]); }
        __syncthreads();
        if (parts & 1) for (int wi = vcu; wi < 192; wi += G) {
            const int kc = wi / 24, nc = wi % 24, k0 = kc * 256 + wave * 32, n0 = nc * 256 + 4 * lane;
            f32x4 acc[9];
#pragma unroll
            for (int r = 0; r < 9; ++r) acc[r] = (f32x4){0.f, 0.f, 0.f, 0.f};
            {
                f32x4 w[32];
#pragma unroll
                for (int kk = 0; kk < 32; ++kk) w[kk] = *(const f32x4*)(wada + (size_t)(k0 + kk) * 6144 + n0);
#pragma unroll
                for (int q = 0; q < 8; ++q)
#pragma unroll
                    for (int r = 0; r < 9; ++r) { const f32x4 s = *(const LAS f32x4*)(sl + r * 2048 + k0 + 4 * q); acc[r] += w[4 * q] * s[0] + w[4 * q + 1] * s[1] + w[4 * q + 2] * s[2] + w[4 * q + 3] * s[3]; }
            }
            __syncthreads();
            LAS float* red = (LAS float*)lds;
#pragma unroll
            for (int r = 0; r < 9; ++r) *(LAS f32x4*)(red + (wave * 9 + r) * 256 + 4 * lane) = acc[r];
            __syncthreads();
            for (int o = wave * 64 + lane; o < 9 * 256; o += NWAVES * 64) {
                float s = 0.f;
#pragma unroll
                for (int w8 = 0; w8 < 8; ++w8) s += red[w8 * 9 * 256 + o];
                atomicAdd(mod + (o >> 8) * 6144 + nc * 256 + (o & 255), s);
            }
            __syncthreads();
            if (wi + G < 192) { for (int i = wave * 64 + lane; i < 9 * 2048; i += NWAVES * 64) { const float cv = i < 16384 ? cc[i] : cctx[i - 16384]; sl[i] = cv * sigmoid_f(cv); } __syncthreads(); }
        }
        __syncthreads();
    }
    if (parts & 2) {
        LAS float* scr = (LAS float*)(lds + wave * 16384);
        float tv[32]; int it = gw;
        TrItem cur = tr_item(a, it < TR_NITEMS ? it : 0);
        if (it < TR_NITEMS) tr_load(cur, tv, lane);
        while (it < TR_NITEMS) {
            const int itn = it + NGW; float tn[32];
            const TrItem nxt = tr_item(a, itn < TR_NITEMS ? itn : 0);
            if (itn < TR_NITEMS) tr_load(nxt, tn, lane);
            tr_store(cur, tv, scr, lane);
#pragma unroll
            for (int i = 0; i < 32; ++i) tv[i] = tn[i];
            cur = nxt; it = itn;
        }
    }
    const int gt = gw * 64 + lane;
    if (gt < 1024) {
        const int pos = gt >> 4, i = gt & 15;
        const float inv = exp2f(-(float)i * 0.8304820237218406f);
        const float ang = (float)pos * inv;
        float* rc = (float*)(ws + WS_ROPE); rc[gt] = cosf(ang); rc[1024 + gt] = sinf(ang);
    }
    if (gt >= 4096 && gt < 8192) {
        const int idx = gt - 4096;
        float ar, ai, fr, fi; ssm_disc(a, idx, ar, ai, fr, fi);
        float* P = (float*)(ws + WS_SSMP);
        P[idx] = ar; P[4096 + idx] = ai;
        const float* br = a.in[I_BRE] + (size_t)idx * 16; const float* bi = a.in[I_BIM] + (size_t)idx * 16;
#pragma unroll
        for (int c = 0; c < 16; ++c) { P[8192 + idx * 16 + c] = fr * br[c] - fi * bi[c]; P[8192 + 65536 + idx * 16 + c] = fr * bi[c] + fi * br[c]; }
        float er = 1.f, ei = 0.f; const int dg = idx >> 6, p = idx & 63;
        for (int e = 0; e <= 16; ++e) { float* q = P + SSMP_APOW + ((size_t)(dg * 17 + e) * 64 + p) * 2; q[0] = er; q[1] = ei; const float nr = er * ar - ei * ai; ei = er * ai + ei * ar; er = nr; }
    }
}

__device__ __forceinline__ void p1_ktab(const Args& a, int vcu, int G, int wave, int lane) {
    unsigned char* ws = a.ws;
    const int gt = (vcu * NWAVES + wave) * 64 + lane, NGT = G * NWAVES * 64;
    const float* P = (const float*)(ws + WS_SSMP); float* KT = (float*)(ws + WS_KTAB);
    for (int o = gt; o < 262144; o += NGT) {
        const int cp = o & 15, c = (o >> 4) & 15, lag = (o >> 8) & 15, dir = (o >> 12) & 1, g = o >> 13, dg = dir * 32 + g;
        const float* ap = P + SSMP_APOW + (size_t)(dg * 17 + lag) * 128; const float* crp = a.in[I_CRE] + (dg * 16 + c) * 64; const float* cip = a.in[I_CIM] + (dg * 16 + c) * 64;
        const float* brp = P + 8192 + (size_t)dg * 1024 + cp; const float* bip = brp + 65536;
        float acc = 0.f;
#pragma unroll 8
        for (int p = 0; p < 64; ++p) { const float er = ap[2 * p], ei = ap[2 * p + 1], cr = crp[p], ci = cip[p]; acc += (cr * er - ci * ei) * brp[p * 16] - (cr * ei + ci * er) * bip[p * 16]; }
        KT[o] = acc;
    }
}

__device__ __forceinline__ void p1_ssm_mats(const Args& a, int vcu, int G, int wave, int lane) {
    unsigned char* ws = a.ws;
    const int gt = (vcu * NWAVES + wave) * 64 + lane, NGT = G * NWAVES * 64;
    const float* P = (const float*)(ws + WS_SSMP); const float* KT = (const float*)(ws + WS_KTAB);
    bf16* BTY = (bf16*)(ws + WS_BTY); bf16* BTS = (bf16*)(ws + WS_BTS);
    for (int i = gt; i < 786432; i += NGT) {
        float v[8];
        if (i < 524288) {
            const int k8 = (i & 63) * 8, n = (i >> 6) & 255, g = i >> 14, t = n >> 4, c = n & 15;
            if (k8 < 256) {
                const int s = k8 >> 4, cp0 = k8 & 15;
                if (t != s) { const float* kp = KT + ((size_t)((g * 2 + (t > s ? 0 : 1)) * 16 + (t > s ? t - s : s - t))) * 256 + c * 16 + cp0;
#pragma unroll
                    for (int j = 0; j < 8; ++j) v[j] = kp[j];
                } else { const float* kf = KT + ((size_t)((g * 2 + 0) * 16)) * 256 + c * 16 + cp0; const float* kb = KT + ((size_t)((g * 2 + 1) * 16)) * 256 + c * 16 + cp0; const float d = a.in[I_SSMD][g * 16 + c];
#pragma unroll
                    for (int j = 0; j < 8; ++j) v[j] = kf[j] + kb[j] + ((cp0 + j == c) ? d : 0.f);
                }
            } else {
                const int kk = k8 - 256, dir = kk >> 7, part = (kk >> 6) & 1, p0 = kk & 63, e = dir ? 16 - t : t + 1, dg = dir * 32 + g;
#pragma unroll
                for (int j = 0; j < 8; ++j) { const float* q = P + SSMP_APOW + ((size_t)(dg * 17 + e) * 64 + p0 + j) * 2; const float er = q[0], ei = q[1];
                    const float cr = a.in[I_CRE][(dg * 16 + c) * 64 + p0 + j], ci = a.in[I_CIM][(dg * 16 + c) * 64 + p0 + j];
                    v[j] = part ? -(cr * ei + ci * er) : (cr * er - ci * ei); }
            }
            u32x4 w; w.x = pg8::cvt_pk_bf16(v[0], v[1]); w.y = pg8::cvt_pk_bf16(v[2], v[3]); w.z = pg8::cvt_pk_bf16(v[4], v[5]); w.w = pg8::cvt_pk_bf16(v[6], v[7]);
            *(u32x4*)(BTY + ((size_t)(g * 256 + n) * 512 + k8)) = w;
        } else {
            const int jx = i - 524288, k8 = (jx & 31) * 8, n = (jx >> 5) & 255, g = jx >> 13, s = k8 >> 4, cp0 = k8 & 15;
            const int dir = n >> 7, part = (n >> 6) & 1, p = n & 63, e = dir ? s : 15 - s, dg = dir * 32 + g, idx = dg * 64 + p;
            const float* q = P + SSMP_APOW + ((size_t)(dg * 17 + e) * 64 + p) * 2; const float er = q[0], ei = q[1];
#pragma unroll
            for (int j = 0; j < 8; ++j) { const float br = P[8192 + idx * 16 + cp0 + j], bi = P[8192 + 65536 + idx * 16 + cp0 + j]; v[j] = part ? (er * bi + ei * br) : (er * br - ei * bi); }
            u32x4 w; w.x = pg8::cvt_pk_bf16(v[0], v[1]); w.y = pg8::cvt_pk_bf16(v[2], v[3]); w.z = pg8::cvt_pk_bf16(v[4], v[5]); w.w = pg8::cvt_pk_bf16(v[6], v[7]);
            *(u32x4*)(BTS + ((size_t)(g * 256 + n) * 256 + k8)) = w;
        }
    }
}

__device__ __forceinline__ void p1_xn(const Args& a, int vcu, int G, int wave, int lane) {
    unsigned char* ws = a.ws;
    const int gw = vcu * NWAVES + wave, NGW = G * NWAVES;
    const float* mod = (const float*)(ws + WS_CTL + CTL_MOD); const float* bada = a.in[I_BADA]; const float* ng = a.in[I_NORMG];
    bf16* XN = (bf16*)(ws + WS_XN);
    f32x4 v[8]; int m = gw;
    if (m < MALL) { const f32x4* xr = (const f32x4*)(m < MLAT ? a.in[I_X] + (size_t)m * DM : a.in[I_CTX] + (size_t)(m - MLAT) * DM) + lane;
#pragma unroll
        for (int j = 0; j < 8; ++j) v[j] = xr[64 * j]; }
    while (m < MALL) {
        const int mn = m + NGW; f32x4 vn[8];
        if (mn < MALL) { const f32x4* xr = (const f32x4*)(mn < MLAT ? a.in[I_X] + (size_t)mn * DM : a.in[I_CTX] + (size_t)(mn - MLAT) * DM) + lane;
#pragma unroll
            for (int j = 0; j < 8; ++j) vn[j] = xr[64 * j]; }
        const int mr = m < MLAT ? (m >> 11) : 8;
        float s = 0.f;
#pragma unroll
        for (int j = 0; j < 8; ++j) s += (v[j][0] * v[j][0] + v[j][1] * v[j][1]) + (v[j][2] * v[j][2] + v[j][3] * v[j][3]);
        const float rstd = 1.0f / sqrtf(wave_sum(s) * (1.0f / DM) + NORM_EPS);
        unsigned long long* o8 = (unsigned long long*)(XN + (size_t)m * DM) + lane;
#pragma unroll
        for (int j = 0; j < 8; ++j) {
            const int col = 4 * lane + 256 * j;
            const f32x4 sh = *(const f32x4*)(mod + mr * 6144 + col) + *(const f32x4*)(bada + col);
            const f32x4 sc = *(const f32x4*)(mod + mr * 6144 + 2048 + col) + *(const f32x4*)(bada + 2048 + col);
            const f32x4 g = *(const f32x4*)(ng + col);
            const f32x4 h = (v[j] * rstd) * g * (sc + 1.0f) + sh;
            o8[64 * j] = (unsigned long long)pg8::cvt_pk_bf16(h[0], h[1]) | ((unsigned long long)pg8::cvt_pk_bf16(h[2], h[3]) << 32);
        }
#pragma unroll
        for (int j = 0; j < 8; ++j) v[j] = vn[j];
        m = mn;
    }
}

struct InProjOrder {
    pg8::StaticOrder so; int G, c;
    __device__ __forceinline__ void init(int G_, int c_) { so.init(MLAT, INW, G_, c_); G = G_; c = c_; }
    __device__ __forceinline__ bool next(int i, pg8::Unit& u) const {
        const long L = (long)i * G + c;
        if (L < 2304) return so.next(i, u);
        const int j = (int)(L - 2304); if (j >= 80) return false;
        const int jj = j % 10; u.pm = 64 + j / 10; u.pn = jj < 8 ? 4 + jj : 8 + jj; return true;
    }
    __device__ __forceinline__ void a_ready(const pg8::Unit&) const {}
    __device__ __forceinline__ void done(const pg8::Unit&) const {}
};

__device__ __forceinline__ void p3_attn(const Args& a, char* lds_generic, int vcu, int G, int wave) {
    unsigned char* ws = a.ws;
    const attn_body::bf16* Q = (const attn_body::bf16*)(ws + WS_Q); const attn_body::bf16* K = (const attn_body::bf16*)(ws + WS_KALL); const attn_body::bf16* V = (const attn_body::bf16*)(ws + WS_VALL);
    for (int u = vcu; u < 1024; u += G) {
        const int xcd = (u & 255) >> 5, c = u & 31, i = u >> 8;
        const int vhd = xcd * 16 + i * 4 + (c >> 3), qb = c & 7;
        const int b = vhd >> 4, h = (vhd >> 1) & 7, s = vhd & 1;
        attn_body::bf16* O = (attn_body::bf16*)(ws + (s ? WS_O2 : WS_O1));
        attn_body::attn_unit<8>(b, qb, h * 128 + s * 64, h * 128 + s * 64, h * 128, h * 128, Q, K, V, O, lds_generic, wave);
    }
}

__device__ __forceinline__ void p4_combine(const Args& a, int vcu, int G, int wave, int lane) {
    unsigned char* ws = a.ws;
    const int gw = vcu * NWAVES + wave, NGW = G * NWAVES;
    const float l1 = wave_sum(a.in[I_LQ1][lane] * a.in[I_LK1][lane]), l2 = wave_sum(a.in[I_LQ2][lane] * a.in[I_LK2][lane]);
    const float lam = expf(l1) - expf(l2) + LAM_INIT;
    const bf16* O1 = (const bf16*)(ws + WS_O1); const bf16* O2 = (const bf16*)(ws + WS_O2); const bf16* GA = (const bf16*)(ws + WS_GA); bf16* AS = (bf16*)(ws + WS_AS);
    const int col = 16 * lane;
    f32x4 sg[4];
#pragma unroll
    for (int j = 0; j < 4; ++j) sg[j] = *(const f32x4*)(a.in[I_SUBLN] + (col & 127) + 4 * j) * (1.0f - LAM_INIT);
    for (int tok = gw; tok < MLAT; tok += NGW) {
        f32x4 o[4], p[4], g[4];
        unpack8(*(const u32x4*)(O1 + (size_t)tok * 1024 + col), o[0], o[1]); unpack8(*(const u32x4*)(O1 + (size_t)tok * 1024 + col + 8), o[2], o[3]);
        unpack8(*(const u32x4*)(O2 + (size_t)tok * 1024 + col), p[0], p[1]); unpack8(*(const u32x4*)(O2 + (size_t)tok * 1024 + col + 8), p[2], p[3]);
        unpack8(*(const u32x4*)(GA + (size_t)tok * 1024 + col), g[0], g[1]); unpack8(*(const u32x4*)(GA + (size_t)tok * 1024 + col + 8), g[2], g[3]);
        float ss = 0.f;
#pragma unroll
        for (int j = 0; j < 4; ++j) { o[j] = o[j] - p[j] * lam; ss += (o[j][0] * o[j][0] + o[j][1] * o[j][1]) + (o[j][2] * o[j][2] + o[j][3] * o[j][3]); }
        ss += __shfl_xor(ss, 1); ss += __shfl_xor(ss, 2); ss += __shfl_xor(ss, 4);
        const float rs = 1.0f / sqrtf(ss * (1.0f / 128.0f) + NORM_EPS);
#pragma unroll
        for (int j = 0; j < 4; ++j) o[j] = o[j] * rs * sg[j] * g[j];
        *(u32x4*)(AS + (size_t)tok * 1536 + col) = pack8(o[0], o[1]); *(u32x4*)(AS + (size_t)tok * 1536 + col + 8) = pack8(o[2], o[3]);
    }
}

struct SsmOrder {
    int G, c, nrt;
    __device__ __forceinline__ bool next(int i, pg8::Unit& u) const {
        const long L = (long)i * G + c; if (L >= 32 * nrt) return false;
        const int g = (int)L / nrt, rt = (int)L % nrt; u.pm = g * 5 + rt; u.pn = g; return true;
    }
    __device__ __forceinline__ void a_ready(const pg8::Unit&) const {}
    __device__ __forceinline__ void done(const pg8::Unit&) const {}
};
__device__ __forceinline__ void p6_carry(const Args& a, int vcu, int G, int wave, int lane) {
    unsigned char* ws = a.ws;
    const int gw = vcu * NWAVES + wave, NGW = G * NWAVES;
    const float* P = (const float*)(ws + WS_SSMP);
    for (int it = gw; it < 512; it += NGW) {
        const int dir = it & 1, g = (it >> 1) & 31, b = it >> 6;
        const float* q = P + SSMP_APOW + ((size_t)((dir * 32 + g) * 17 + 16) * 64 + lane) * 2; const float ar = q[0], ai = q[1];
        const float* S = (const float*)(ws + WS_SBUF) + (size_t)g * 1280 * 256 + dir * 128 + lane;
        bf16* H = (bf16*)(ws + WS_A2) + (size_t)g * 1280 * 512 + 256 + dir * 128 + lane;
        float hr = 0.f, hi = 0.f;
#pragma unroll 8
        for (int k = 0; k < 16; ++k) { const int R = 1024 + b * 16 + (dir ? 15 - k : k); const float sr = S[(size_t)R * 256], si = S[(size_t)R * 256 + 64];
            const float nr = ar * hr - ai * hi + sr; hi = ar * hi + ai * hr + si; hr = nr; }
#pragma unroll 8
        for (int k = 0; k < 128; ++k) { const int R = b * 128 + (dir ? 127 - k : k); const float sr = S[(size_t)R * 256], si = S[(size_t)R * 256 + 64];
            H[(size_t)R * 512] = (bf16)f2bf(hr); H[(size_t)R * 512 + 64] = (bf16)f2bf(hi);
            const float nr = ar * hr - ai * hi + sr; hi = ar * hi + ai * hr + si; hr = nr; }
    }
}

#ifndef PROBE_A1
#define PROBE_A0 -1
#define PROBE_A1 -1
#define PROBE_B0 -1
#define PROBE_B1 -1
#define PROBE_OFF 0
#endif
#ifndef PROBE_BKT
#define PROBE_BKT 100
#endif
__device__ __forceinline__ void p10_final(const Args& a, int vcu, int G, int wave, int lane, float addA, float addB, int rep) {
    const int gw = vcu * NWAVES + wave, NGW = G * NWAVES;
    const float* rowsq = (const float*)(a.ws + WS_CTL + CTL_ROWSQ); const float* fg = a.in[I_FING];
    for (int m = gw; m < MLAT; m += NGW) {
        const float rstd = 1.0f / sqrtf(rowsq[m] * (1.0f / DM) + NORM_EPS);
        f32x4* o = (f32x4*)(a.out + (size_t)m * DM) + lane; f32x4* od = rep ? (f32x4*)((float*)(a.ws + WS_GM) + (size_t)m * DM) + lane : o;
#pragma unroll
        for (int j = 0; j < 8; ++j) { const f32x4 g = *(const f32x4*)(fg + 4 * lane + 256 * j); f32x4 r = o[64 * j] * rstd * g; if (PROBE_A1 >= 0) { r = r + addA; if (m == 0 && lane == 0 && j == 0) r[0] += addB; } od[64 * j] = r; }
    }
}

constexpr int N_PHASES = 12;
__global__ void __launch_bounds__(NWAVES * 64, 2) skel_fwd(Args args) {
    extern __shared__ __attribute__((aligned(16))) unsigned char lds_raw[];
    LAS unsigned char* lds = (LAS unsigned char*)lds_raw;
    volatile LAS unsigned* MISC = (volatile LAS unsigned*)(lds + MISC_OFF);
    const int tid = threadIdx.x, wave = __builtin_amdgcn_readfirstlane(tid >> 6);
    const int G = gridDim.x; const int bx = blockIdx.x; const int vcu = (G % 8 == 0) ? (bx % 8) * (G / 8) + bx / 8 : bx;
    unsigned char* ws = args.ws;
    gu32* ctl = (gu32*)(ws + WS_CTL);
    for (int u = tid; u < (LDS_BYTES - LDSCTL_OFF) / 4; u += NWAVES * 64) ((LAS unsigned*)(lds + LDSCTL_OFF))[u] = 0u;
    __syncthreads();
    XcdBarrier bar; bar.bar = (unsigned*)(ctl + CW_BAR); bar.x = 0; bar.st = nullptr;
    if (!MK_PER_PHASE) bar = xcd_barrier_post((unsigned*)(ctl + CW_BAR), MISC + 8);
    const int lo = args.ph_lo, hi = args.ph_hi;
#ifndef ONLY_PHASE
#define ONLY_PHASE -1
#endif
#define IN(k) ((ONLY_PHASE < 0 || ONLY_PHASE == (k)) && lo <= (k) && (k) < hi)
#ifndef REPEAT_PH
#define REPEAT_PH -1
#endif
#if PROBE_A1 >= 0
#define STAMP(k) do { if (bx == 0 && wave == 0 && pg8::lane_id_v() == 0) ((unsigned long long*)(ws + WS_CTL + CTL_STAMP))[k] = rt(); } while (0)
#else
#define STAMP(k) do {} while (0)
#endif
#define REP(k) for (int rep_ = 0; rep_ < ((REPEAT_PH == (k)) ? 2 : 1); ++rep_)
#ifndef EXTRA_BAR
#define EXTRA_BAR 0
#endif
#define SEAM(k) do { if (IN(k) && IN((k) + 1)) { xcd_barrier(bar, wave); if ((k) == 4) for (int eb_ = 0; eb_ < EXTRA_BAR; ++eb_) xcd_barrier(bar, wave); } } while (0)

    STAMP(0); if (IN(0)) REP(0) { const int ln = pg8::lane_id_v(); p0_prologue(args, lds, vcu, G, wave, ln, rep_); } SEAM(0);
    STAMP(1); if (IN(1)) REP(1) { const int ln = pg8::lane_id_v(); p1_xn(args, vcu, G, wave, ln); p1_ktab(args, vcu, G, wave, ln); } SEAM(1);
    STAMP(2); if (IN(2)) REP(2) {
        pg8::Gemm g{(const pg8::bf16_t*)(ws + WS_XN), (const pg8::bf16_t*)(ws + WS_WIN), MALL, INW, DM, DM, DM};
        InProjOrder S; S.init(G, bx);
        pg8::EpiInProj E{ws, QSCALE, -1};
        pg8::gemm_phase<pg8::EpiInProj, InProjOrder, PG8_ALIGN, PG8_SP2>(lds, g, S, E, wave);
    } SEAM(2);
    STAMP(3); if (IN(3)) REP(3) { p3_attn(args, (char*)lds_raw, vcu, G, wave); } SEAM(3);
    STAMP(4); if (IN(4)) REP(4) { const int ln = pg8::lane_id_v(); p4_combine(args, vcu, G, wave, ln); p1_ssm_mats(args, vcu, G, wave, ln); } SEAM(4);
    STAMP(5); if (IN(5)) REP(5) {
        pg8::Gemm g{(const pg8::bf16_t*)(ws + WS_A2), (const pg8::bf16_t*)(ws + WS_BTS), 32 * 1280, 32 * 256, 256, 512, 256};
        SsmOrder S{G, bx, 5};
        pg8::EpiS E{(float*)(ws + WS_SBUF), -1};
        pg8::gemm_phase<pg8::EpiS, SsmOrder, PG8_ALIGN, PG8_SP2>(lds, g, S, E, wave);
    } SEAM(5);
    STAMP(6); if (IN(6)) REP(6) { const int ln = pg8::lane_id_v(); p6_carry(args, vcu, G, wave, ln); } SEAM(6);
    STAMP(7); if (IN(7)) REP(7) {
        pg8::Gemm g{(const pg8::bf16_t*)(ws + WS_A2), (const pg8::bf16_t*)(ws + WS_BTY), 32 * 1280, 32 * 256, 512, 512, 512};
        SsmOrder S{G, bx, 4};
        pg8::EpiY E{(pg8::bf16_t*)(ws + WS_Y), -1};
        pg8::gemm_phase<pg8::EpiY, SsmOrder, PG8_ALIGN, PG8_SP2>(lds, g, S, E, wave);
    } SEAM(7);
    STAMP(8); if (IN(8)) REP(8) {
        pg8::Gemm g{(const pg8::bf16_t*)(ws + WS_Y), (const pg8::bf16_t*)(ws + WS_WGLU), MLAT, 512, 512, 512, 512};
        pg8::StaticOrder S; S.init(MLAT, 512, G, bx);
        pg8::EpiGlu E{(const pg8::bf16_t*)(ws + WS_Y), (const pg8::bf16_t*)(ws + WS_GS), args.in[I_BGLU], (pg8::bf16_t*)(ws + WS_AS), -1};
        pg8::gemm_phase<pg8::EpiGlu, pg8::StaticOrder, PG8_ALIGN, PG8_SP2>(lds, g, S, E, wave);
    } SEAM(8);
    STAMP(9); if (IN(9)) REP(9) {
        pg8::Gemm g{(const pg8::bf16_t*)(ws + WS_AS), (const pg8::bf16_t*)(ws + WS_WCAT), MLAT, DM, 1536, 1536, 1536};
        pg8::StaticOrder S; S.init(MLAT, DM, G, bx);
        pg8::EpiMerged E{(const pg8::bf16_t*)(ws + WS_GM), (pg8::bf16_t*)(ws + WS_MG), 16};
        pg8::gemm_phase<pg8::EpiMerged, pg8::StaticOrder, PG8_ALIGN, PG8_SP2>(lds, g, S, E, wave);
    } SEAM(9);
    STAMP(10); if (IN(10)) REP(10) {
        pg8::Gemm g{(const pg8::bf16_t*)(ws + WS_MG), (const pg8::bf16_t*)(ws + WS_WOUT), MLAT, DM, DM, DM, DM};
        pg8::StaticOrder S; S.init(MLAT, DM, G, bx);
        pg8::EpiOut E{args.in[I_X], (const float*)(ws + WS_CTL + CTL_MOD), args.in[I_BADA], args.out, (float*)(ws + WS_CTL + CTL_ROWSQ + (size_t)rep_ * 393216), -1};
        pg8::gemm_phase<pg8::EpiOut, pg8::StaticOrder, PG8_ALIGN, PG8_SP2>(lds, g, S, E, wave);
    } SEAM(10);
    STAMP(11); if (IN(11)) REP(11) { const int ln = pg8::lane_id_v(); float addA = 0.f, addB = 0.f;
#if PROBE_A1 >= 0
        { const unsigned long long* st = (const unsigned long long*)(ws + WS_CTL + CTL_STAMP);
          const long long da = (long long)(st[PROBE_A1] - st[PROBE_A0]) / 100 + PROBE_OFF, db = (long long)(st[PROBE_B1] - st[PROBE_B0]) / 100 + PROBE_OFF;
          addA = (float)((da / PROBE_BKT) * PROBE_BKT) * 1e-3f; addB = (float)((db / PROBE_BKT) * PROBE_BKT) * 1e-2f; }
#endif
        p10_final(args, vcu, G, wave, ln, addA, addB, rep_); }
#undef IN
#undef SEAM
}

extern "C" void kernel_launch(void* const* d_in, const int* in_sizes, int n_in, void* d_out, int out_size, void* d_ws, size_t ws_size, hipStream_t stream) {
    static int grid = 0;
    if (grid == 0) {
        if (n_in != 27 || out_size != MLAT * DM || ws_size < WS_END) { fprintf(stderr, "kernel_launch: unexpected shapes (n_in %d, out %d, ws %zu); nothing launched\n", n_in, out_size, ws_size); grid = -1; return; }
        int dev = 0, cus = 0, per_cu = 0;
        if (hipGetDevice(&dev) != hipSuccess || hipDeviceGetAttribute(&cus, hipDeviceAttributeMultiprocessorCount, dev) != hipSuccess) { grid = -1; return; }
        if (hipFuncSetAttribute((const void*)skel_fwd, hipFuncAttributeMaxDynamicSharedMemorySize, LDS_BYTES) != hipSuccess) { fprintf(stderr, "kernel_launch: hipFuncSetAttribute failed\n"); grid = -1; return; }
        if (hipOccupancyMaxActiveBlocksPerMultiprocessor(&per_cu, (const void*)skel_fwd, NWAVES * 64, LDS_BYTES) != hipSuccess || per_cu < 1) { fprintf(stderr, "kernel_launch: occupancy query says %d blocks per CU\n", per_cu); }
        (void)hipGetLastError();
        grid = cus;
    }
    if (grid < 0) return;
    if (hipMemsetAsync((char*)d_ws + WS_CTL, 0, CTL_ZERO_BYTES, stream) != hipSuccess) { fprintf(stderr, "kernel_launch: hipMemsetAsync failed\n"); return; }
    Args a{};
    for (int i = 0; i < 27; ++i) a.in[i] = (const float*)d_in[i];
    a.out = (float*)d_out; a.ws = (unsigned char*)d_ws;
#if MK_PER_PHASE
    for (int p = 0; p < N_PHASES; ++p) { a.ph_lo = p; a.ph_hi = p + 1; a.li = 0; hipLaunchKernelGGL(skel_fwd, dim3(grid), dim3(NWAVES * 64), LDS_BYTES, stream, a); }
#else
    a.ph_lo = 0; a.ph_hi = N_PHASES; a.li = 0;
    hipLaunchKernelGGL(skel_fwd, dim3(grid), dim3(NWAVES * 64), LDS_BYTES, stream, a);
#endif
    const hipError_t le = hipPeekAtLastError();
    if (le != hipSuccess) fprintf(stderr, "kernel_launch: launch failed: %s\n", hipGetErrorName(le));
}
```
